# Optimizing an MI355X kernel written in HIP

```python
import math
import jax, jax.numpy as jnp
from jax import lax
import numpy as np


D_MODEL = 1024
BATCH = 8
SEQ = 2048
DEPTH = 2

A_HEADS = 4
A_QK_DIM = 64
A_WIDTH = A_HEADS * 2 * A_QK_DIM
Q_BLOCK = 128
N_BUCKETS = 32
MAX_DISTANCE = 128
B_HEADS = 4
B_HEAD_DIM = 64
B_WIDTH = B_HEADS * B_HEAD_DIM
B_DECAY_LORA = 64
B_AAA_LORA = 64
B_GATE_LORA = 128
B_LNX_EPS = 64e-5
C_GROUPS = 4
C_GROUP_DIM = 64
C_WIDTH = C_GROUPS * C_GROUP_DIM
CHUNK = 128
A_COLS = 3 * A_WIDTH
B_COLS = 3 * B_WIDTH + B_DECAY_LORA + B_AAA_LORA + B_GATE_LORA
C_COLS = 2 * C_WIDTH
IN_COLS = A_COLS + B_COLS + C_COLS
MIX_WIDTH = A_WIDTH + B_WIDTH + C_WIDTH
N_EXPERTS = 64
TOP_K = 8
N_GROUPS = 8
TOPK_GROUPS = 4
EXPERTS_PER_GROUP = N_EXPERTS // N_GROUPS
D_EXPERT = 256
D_SHARED = 256
ROUTED_SCALE = 2.5
EXPERT_BLOCK = 256
RMS_EPS = 1e-6

kernel_name = 'hybrid_diffattn_rwkv7_gmlp_moe_block'


def rmsnorm(x, g):
    xf = x.astype(jnp.float32)
    y = xf * lax.rsqrt(jnp.mean(xf * xf, axis=-1, keepdims=True) + RMS_EPS) * g.astype(jnp.float32)
    return y.astype(x.dtype)


def layernorm(x, g, b, eps=1e-5):
    xf = x.astype(jnp.float32)
    mu = jnp.mean(xf, axis=-1, keepdims=True)
    var = jnp.mean((xf - mu) ** 2, axis=-1, keepdims=True)
    y = (xf - mu) * lax.rsqrt(var + eps) * g.astype(jnp.float32) + b.astype(jnp.float32)
    return y.astype(x.dtype)


def t5_bucket(dist):
    n = jnp.maximum(dist, 0)
    max_exact = N_BUCKETS // 2
    nf = jnp.maximum(n, 1).astype(jnp.float32)
    large = max_exact + (jnp.log(nf / max_exact) / math.log(MAX_DISTANCE / max_exact)
                         * (N_BUCKETS - max_exact)).astype(jnp.int32)
    large = jnp.minimum(large, N_BUCKETS - 1)
    return jnp.where(n < max_exact, n, large)


def diff_attention(pa, table, lam_par, subln_g, lambda_init):
    Bn, S, _ = pa.shape
    q = pa[..., :A_WIDTH].reshape(Bn, S, A_HEADS, 2, A_QK_DIM)
    k = pa[..., A_WIDTH:2 * A_WIDTH].reshape(Bn, S, A_HEADS, 2, A_QK_DIM)
    v = pa[..., 2 * A_WIDTH:].reshape(Bn, S, A_HEADS, 2 * A_QK_DIM)
    lp = lam_par.astype(jnp.float32)
    lam = jnp.exp(jnp.sum(lp[0] * lp[1])) - jnp.exp(jnp.sum(lp[2] * lp[3])) + lambda_init
    scale = A_QK_DIM ** -0.5
    outs = []
    for i in range(S // Q_BLOCK):
        q0 = i * Q_BLOCK
        L = q0 + Q_BLOCK
        dist = jnp.arange(q0, L)[:, None] - jnp.arange(L)[None, :]
        bias = jnp.transpose(table[t5_bucket(dist)].astype(jnp.float32), (2, 0, 1))
        logits = jnp.einsum('bqhmd,bkhmd->bmhqk', q[:, q0:L], k[:, :L]).astype(jnp.float32) * scale + bias
        logits = jnp.where(dist >= 0, logits, -jnp.inf)
        probs = jax.nn.softmax(logits, axis=-1)
        attn = (probs[:, 0] - lam * probs[:, 1]).astype(v.dtype)
        outs.append(jnp.einsum('bhqk,bkhe->bqhe', attn, v[:, :L]))
    o = jnp.concatenate(outs, axis=1)
    o = rmsnorm(o, subln_g) * (1.0 - lambda_init)
    return o.reshape(Bn, S, A_WIDTH)


def _rwkv7_step(state, inp):
    r, w, k, v, a, b = inp
    sa = jnp.einsum('bhij,bhj->bhi', state, a)
    state = state * w[:, :, None, :] + sa[..., None] * b[:, :, None, :] + v[..., None] * k[:, :, None, :]
    y = jnp.einsum('bhij,bhj->bhi', state, r)
    return state, y


def rwkv7_time_mix(pb, mu, w0, w2, a0, a2, g2, k_k, k_a, r_k, lnx_g, lnx_b):
    Bn, S, _ = pb.shape
    prev = jnp.pad(pb[:, :-1], ((0, 0), (1, 0), (0, 0)))
    p = pb + (prev - pb) * mu
    o1, o2, o3 = B_WIDTH, 2 * B_WIDTH, 3 * B_WIDTH
    o4 = o3 + B_DECAY_LORA
    o5 = o4 + B_AAA_LORA
    r, k, v = p[..., :o1], p[..., o1:o2], p[..., o2:o3]
    wd, ad, gd = p[..., o3:o4], p[..., o4:o5], p[..., o5:]
    w = -jax.nn.softplus(-(w0 + jnp.tanh(wd) @ w2)) - 0.5
    decay = jnp.exp(-jnp.exp(w.astype(jnp.float32)))
    a = jax.nn.sigmoid(a0 + ad @ a2)
    g = jax.nn.sigmoid(gd) @ g2
    hs = lambda t: t.reshape(Bn, S, B_HEADS, B_HEAD_DIM).astype(jnp.float32)
    kk = hs(k * k_k)
    kk = kk * lax.rsqrt(jnp.maximum(jnp.sum(kk * kk, axis=-1, keepdims=True), 1e-24))
    k = k * (1 + (a - 1) * k_a)
    rh, kh, vh, ah, wh = hs(r), hs(k), hs(v), hs(a), hs(decay)
    xs = tuple(jnp.moveaxis(t, 1, 0) for t in (rh, wh, kh, vh, -kk, kk * ah))
    state0 = jnp.zeros((Bn, B_HEADS, B_HEAD_DIM, B_HEAD_DIM), jnp.float32)
    _, y = lax.scan(_rwkv7_step, state0, xs)
    y = jnp.moveaxis(y, 0, 1)
    mean = jnp.mean(y, axis=-1, keepdims=True)
    var = jnp.mean((y - mean) ** 2, axis=-1, keepdims=True)
    y = ((y - mean) * lax.rsqrt(var + B_LNX_EPS)).reshape(Bn, S, B_WIDTH) * lnx_g.astype(jnp.float32) \
        + lnx_b.astype(jnp.float32)
    bonus = jnp.sum(rh * kh * r_k.astype(jnp.float32), axis=-1, keepdims=True) * vh
    y = y + bonus.reshape(Bn, S, B_WIDTH)
    return (y * g.astype(jnp.float32)).astype(pb.dtype)


def chunk_gmlp(pc, ln_g, ln_b, w_s, b_s):
    Bn, S, _ = pc.shape
    z = jax.nn.gelu(pc)
    u, v = z[..., :C_WIDTH], z[..., C_WIDTH:]
    v = layernorm(v, ln_g, ln_b)
    vc = v.reshape(Bn, S // CHUNK, CHUNK, C_GROUPS, C_GROUP_DIM)
    ws = w_s * jnp.tril(jnp.ones((CHUNK, CHUNK), w_s.dtype))
    sv = jnp.einsum('gts,bcsgd->bctgd', ws, vc) + jnp.transpose(b_s)[None, None, :, :, None]
    return u * sv.reshape(Bn, S, C_WIDTH)


def moe_ffn(h, w_router, e_bias, w1, w3, w2, ws1, ws3, ws2):
    Bn, S, D = h.shape
    T = Bn * S
    xt = h.reshape(T, D)
    scores = jax.nn.sigmoid((xt @ w_router).astype(jnp.float32))
    biased = scores + e_bias.astype(jnp.float32)
    grp_score = jnp.sum(lax.top_k(biased.reshape(T, N_GROUPS, EXPERTS_PER_GROUP), 2)[0], axis=-1)
    _, top_g = lax.top_k(grp_score, TOPK_GROUPS)
    gmask = jnp.any(top_g[:, :, None] == jnp.arange(N_GROUPS)[None, None, :], axis=1)
    masked = jnp.where(jnp.repeat(gmask, EXPERTS_PER_GROUP, axis=1), biased, -jnp.inf)
    _, top_idx = lax.top_k(masked, TOP_K)
    top_s = jnp.take_along_axis(scores, top_idx, axis=1)
    top_w = top_s / (jnp.sum(top_s, axis=-1, keepdims=True) + 1e-20) * ROUTED_SCALE
    M = T * TOP_K
    flat_e = top_idx.reshape(M)
    flat_w = top_w.reshape(M)
    order = jnp.argsort(flat_e)
    se = flat_e[order]
    counts = jnp.bincount(flat_e, length=N_EXPERTS)
    padded = (counts + EXPERT_BLOCK - 1) // EXPERT_BLOCK * EXPERT_BLOCK
    pad_end = jnp.cumsum(padded)
    pad_start = pad_end - padded
    grp_start = jnp.cumsum(counts) - counts
    dest = pad_start[se] + jnp.arange(M) - grp_start[se]
    n_blocks = -(-M // EXPERT_BLOCK) + N_EXPERTS
    P = n_blocks * EXPERT_BLOCK
    row_tok = jnp.zeros((P,), jnp.int32).at[dest].set((order // TOP_K).astype(jnp.int32))
    row_w = jnp.zeros((P,), jnp.float32).at[dest].set(flat_w[order])
    blk_e = jnp.minimum(jnp.searchsorted(pad_end, jnp.arange(n_blocks) * EXPERT_BLOCK, side='right'),
                        N_EXPERTS - 1)

    def expert_block(args):
        tok, e = args
        xb = xt[tok]
        hb = jax.nn.silu(xb @ w1[e]) * (xb @ w3[e])
        return hb @ w2[e]

    yb = lax.map(expert_block, (row_tok.reshape(n_blocks, EXPERT_BLOCK), blk_e))
    routed = jnp.zeros_like(xt).at[row_tok].add((yb.reshape(P, D) * row_w[:, None]).astype(xt.dtype))
    shared = (jax.nn.silu(xt @ ws1) * (xt @ ws3)) @ ws2
    return (routed + shared).reshape(Bn, S, D)


def setup_inputs(seed: int = 0) -> dict:
    key = jax.random.key(seed)
    ks = jax.random.split(key, 40)
    L, D, E, F = DEPTH, D_MODEL, N_EXPERTS, D_EXPERT
    nrm = lambda k, shape, s: jax.random.normal(k, shape, jnp.float32) * s
    gain = lambda k, shape: 1.0 + 0.01 * jax.random.normal(k, shape, jnp.float32)
    return {
        'x': nrm(ks[0], (BATCH, SEQ, D), 1.0),
        'c': nrm(ks[1], (BATCH, D), 1.0),
        'w_ada': nrm(ks[2], (L, D, 6 * D), 0.5 * D ** -0.5),
        'b_ada': nrm(ks[3], (L, 6 * D), 0.01),
        'norm_pre_mix': gain(ks[4], (L, D)),
        'norm_post_mix': gain(ks[5], (L, D)),
        'norm_pre_ffn': gain(ks[6], (L, D)),
        'norm_post_ffn': gain(ks[7], (L, D)),
        'w_in': nrm(ks[8], (L, D, IN_COLS), D ** -0.5),
        'w_out': nrm(ks[9], (L, MIX_WIDTH, D), MIX_WIDTH ** -0.5),
        'rel_bias_table': nrm(ks[10], (N_BUCKETS, A_HEADS), 0.5),
        'diff_lambda': nrm(ks[11], (L, 4, A_QK_DIM), 0.1),
        'diff_subln': gain(ks[12], (L, 2 * A_QK_DIM)),
        'rwkv_mu': jax.random.uniform(ks[13], (L, B_COLS), jnp.float32),
        'rwkv_w0': jax.random.uniform(ks[14], (L, B_WIDTH), jnp.float32, -6.0, 0.0),
        'rwkv_w2': nrm(ks[15], (L, B_DECAY_LORA, B_WIDTH), 0.1 * B_DECAY_LORA ** -0.5),
        'rwkv_a0': nrm(ks[16], (L, B_WIDTH), 0.1),
        'rwkv_a2': nrm(ks[17], (L, B_AAA_LORA, B_WIDTH), 0.1 * B_AAA_LORA ** -0.5),
        'rwkv_g2': nrm(ks[18], (L, B_GATE_LORA, B_WIDTH), B_GATE_LORA ** -0.5),
        'rwkv_k_k': 0.85 + nrm(ks[19], (L, B_WIDTH), 0.01),
        'rwkv_k_a': gain(ks[20], (L, B_WIDTH)),
        'rwkv_r_k': nrm(ks[21], (L, B_HEADS, B_HEAD_DIM), 0.1),
        'rwkv_lnx_g': gain(ks[22], (L, B_WIDTH)),
        'rwkv_lnx_b': nrm(ks[23], (L, B_WIDTH), 0.01),
        'gmlp_ln_g': gain(ks[24], (L, C_WIDTH)),
        'gmlp_ln_b': nrm(ks[25], (L, C_WIDTH), 0.01),
        'gmlp_w_s': nrm(ks[26], (L, C_GROUPS, CHUNK, CHUNK), 0.5 * CHUNK ** -0.5),
        'gmlp_b_s': gain(ks[27], (L, C_GROUPS, CHUNK)),
        'router_w': nrm(ks[28], (L, D, E), D ** -0.5),
        'router_bias': nrm(ks[29], (L, E), 0.01),
        'exp_w1': nrm(ks[30], (L, E, D, F), D ** -0.5),
        'exp_w3': nrm(ks[31], (L, E, D, F), D ** -0.5),
        'exp_w2': nrm(ks[32], (L, E, F, D), F ** -0.5),
        'shared_w1': nrm(ks[33], (L, D, D_SHARED), D ** -0.5),
        'shared_w3': nrm(ks[34], (L, D, D_SHARED), D ** -0.5),
        'shared_w2': nrm(ks[35], (L, D_SHARED, D), D_SHARED ** -0.5),
    }


def reference(x, c, w_ada, b_ada, norm_pre_mix, norm_post_mix, norm_pre_ffn, norm_post_ffn,
              w_in, w_out, rel_bias_table, diff_lambda, diff_subln,
              rwkv_mu, rwkv_w0, rwkv_w2, rwkv_a0, rwkv_a2, rwkv_g2, rwkv_k_k, rwkv_k_a, rwkv_r_k,
              rwkv_lnx_g, rwkv_lnx_b, gmlp_ln_g, gmlp_ln_b, gmlp_w_s, gmlp_b_s,
              router_w, router_bias, exp_w1, exp_w3, exp_w2, shared_w1, shared_w3, shared_w2):
    cond = jax.nn.silu(c)
    for l in range(DEPTH):
        mod = cond @ w_ada[l] + b_ada[l]
        sh1, sc1, g1, sh2, sc2, g2 = jnp.split(mod[:, None, :], 6, axis=-1)
        h = rmsnorm(x, norm_pre_mix[l]) * (1 + sc1) + sh1
        proj = h @ w_in[l]
        pa = proj[..., :A_COLS]
        pb = proj[..., A_COLS:A_COLS + B_COLS]
        pc = proj[..., A_COLS + B_COLS:]
        lambda_init = 0.8 - 0.6 * math.exp(-0.3 * l)
        ya = diff_attention(pa, rel_bias_table, diff_lambda[l], diff_subln[l], lambda_init)
        yb = rwkv7_time_mix(pb, rwkv_mu[l], rwkv_w0[l], rwkv_w2[l], rwkv_a0[l], rwkv_a2[l], rwkv_g2[l],
                            rwkv_k_k[l], rwkv_k_a[l], rwkv_r_k[l], rwkv_lnx_g[l], rwkv_lnx_b[l])
        yc = chunk_gmlp(pc, gmlp_ln_g[l], gmlp_ln_b[l], gmlp_w_s[l], gmlp_b_s[l])
        y = jnp.concatenate([ya, yb, yc], axis=-1) @ w_out[l]
        x = x + g1 * rmsnorm(y, norm_post_mix[l])
        h = rmsnorm(x, norm_pre_ffn[l]) * (1 + sc2) + sh2
        y = moe_ffn(h, router_w[l], router_bias[l], exp_w1[l], exp_w3[l], exp_w2[l],
                    shared_w1[l], shared_w3[l], shared_w2[l])
        x = x + g2 * rmsnorm(y, norm_post_ffn[l])
    return x
```

```cpp
#include <hip/hip_runtime.h>
#include <cstdio>
#include <cstdint>
#include <cmath>

namespace {
constexpr int D = 1024, BATCH = 8, SEQ = 2048, T = BATCH * SEQ, DEPTH = 2;
constexpr int A_HEADS = 4, A_QK = 64, A_WIDTH = 512;
constexpr int B_WIDTH = 256, B_COLS = 1024, C_WIDTH = 256, CHUNK = 128;
constexpr int A_COLS = 1536, IN_COLS = 3072;
constexpr int NE = 64, TOPK = 8, DE = 256;
constexpr int EBLK = 256;
constexpr int NBLK = T * TOPK / EBLK + NE;
constexpr int P = NBLK * EBLK;

__device__ __forceinline__ float wave_sum(float v) {
#pragma unroll
    for (int o = 1; o < 64; o <<= 1) v += __shfl_xor(v, o);
    return v;
}
__device__ __forceinline__ float wave_max(float v) {
#pragma unroll
    for (int o = 1; o < 64; o <<= 1) v = fmaxf(v, __shfl_xor(v, o));
    return v;
}
__device__ __forceinline__ float sigmoidf_(float x) { return 1.f / (1.f + __expf(-x)); }
__device__ __forceinline__ float siluf_(float x) { return x / (1.f + __expf(-x)); }
__device__ __forceinline__ float gelu_tanh(float x) {
    const float u = 0.7978845608028654f * (x + 0.044715f * x * x * x);
    return 0.5f * x * (1.f + tanhf(u));
}

__global__ void k_mod(const float* __restrict__ c, const float* __restrict__ w_ada, const float* __restrict__ b_ada, float* __restrict__ mod) {
    const int n = blockIdx.x * 256 + threadIdx.x, b = blockIdx.y, l = blockIdx.z;
    float acc = b_ada[l * 6 * D + n];
    const float* w = w_ada + (size_t)l * D * 6 * D + n;
    const float* cr = c + b * D;
    for (int k = 0; k < D; ++k) acc += siluf_(cr[k]) * w[(size_t)k * 6 * D];
    mod[((size_t)l * BATCH + b) * 6 * D + n] = acc;
}

__device__ __forceinline__ float block_sum256(float v, float* red) {
    v = wave_sum(v);
    __syncthreads();
    if ((threadIdx.x & 63) == 0) red[threadIdx.x >> 6] = v;
    __syncthreads();
    return red[0] + red[1] + red[2] + red[3];
}
__global__ void k_norm_mod(const float* __restrict__ x, const float* __restrict__ g, const float* __restrict__ mod_l, int sh_idx, int sc_idx, float* __restrict__ h) {
    __shared__ float red[4];
    const int row = blockIdx.x, b = row / SEQ, tid = threadIdx.x;
    const float4 v = ((const float4*)(x + (size_t)row * D))[tid];
    const float ss = block_sum256(v.x * v.x + v.y * v.y + v.z * v.z + v.w * v.w, red);
    const float rs = rsqrtf(ss / D + 1e-6f);
    const float* m = mod_l + (size_t)b * 6 * D;
    const float4 gg = ((const float4*)g)[tid], sc = ((const float4*)(m + sc_idx * D))[tid], sh = ((const float4*)(m + sh_idx * D))[tid];
    float4 o;
    o.x = v.x * rs * gg.x * (1.f + sc.x) + sh.x; o.y = v.y * rs * gg.y * (1.f + sc.y) + sh.y;
    o.z = v.z * rs * gg.z * (1.f + sc.z) + sh.z; o.w = v.w * rs * gg.w * (1.f + sc.w) + sh.w;
    ((float4*)(h + (size_t)row * D))[tid] = o;
}
__global__ void k_resid(const float* __restrict__ xin, const float* __restrict__ y, const float* __restrict__ g, const float* __restrict__ mod_l, int gate_idx, float* __restrict__ xout) {
    __shared__ float red[4];
    const int row = blockIdx.x, b = row / SEQ, tid = threadIdx.x;
    const float4 v = ((const float4*)(y + (size_t)row * D))[tid];
    const float ss = block_sum256(v.x * v.x + v.y * v.y + v.z * v.z + v.w * v.w, red);
    const float rs = rsqrtf(ss / D + 1e-6f);
    const float4 gg = ((const float4*)g)[tid], gt = ((const float4*)(mod_l + (size_t)b * 6 * D + gate_idx * D))[tid];
    const float4 xi = ((const float4*)(xin + (size_t)row * D))[tid];
    float4 o;
    o.x = xi.x + gt.x * v.x * rs * gg.x; o.y = xi.y + gt.y * v.y * rs * gg.y;
    o.z = xi.z + gt.z * v.z * rs * gg.z; o.w = xi.w + gt.w * v.w * rs * gg.w;
    ((float4*)(xout + (size_t)row * D))[tid] = o;
}

template <int MODE>
__global__ __launch_bounds__(256) void k_gemm(const float* __restrict__ A, int lda, const float* __restrict__ B, const float* __restrict__ B2, int ldb, size_t estride,
                                               float* __restrict__ C, int ldc, int K, const int* __restrict__ gather, const int* __restrict__ blk_e, const float* __restrict__ roww) {
    __shared__ float As[16][68];
    __shared__ float Bs[16][68];
    __shared__ float Bs2[MODE == 1 ? 16 : 1][68];
    const int tid = threadIdx.x, tx = tid & 15, ty = tid >> 4;
    const int m0 = blockIdx.y * 64, n0 = blockIdx.x * 64;
    if (blk_e) {
        const int e = blk_e[m0 / EBLK];
        if (e < 0) return;
        B += (size_t)e * estride; if (MODE == 1) B2 += (size_t)e * estride;
    }
    const int ar = tid >> 2, akq = (tid & 3) * 4;
    int arow = m0 + ar;
    if (MODE == 1 && gather) arow = gather[m0 + ar];
    const float* ap = arow >= 0 ? A + (size_t)arow * lda + akq : nullptr;
    const int bk = tid >> 4, bn = (tid & 15) * 4;
    float acc[4][4], acc2[4][4];
#pragma unroll
    for (int i = 0; i < 4; ++i)
#pragma unroll
        for (int j = 0; j < 4; ++j) { acc[i][j] = 0.f; acc2[i][j] = 0.f; }
    for (int k0 = 0; k0 < K; k0 += 16) {
        float4 av = ap ? *(const float4*)(ap + k0) : make_float4(0.f, 0.f, 0.f, 0.f);
        As[akq + 0][ar] = av.x; As[akq + 1][ar] = av.y; As[akq + 2][ar] = av.z; As[akq + 3][ar] = av.w;
        *(float4*)&Bs[bk][bn] = *(const float4*)(B + (size_t)(k0 + bk) * ldb + n0 + bn);
        if (MODE == 1) *(float4*)&Bs2[bk][bn] = *(const float4*)(B2 + (size_t)(k0 + bk) * ldb + n0 + bn);
        __syncthreads();
#pragma unroll
        for (int kk = 0; kk < 16; ++kk) {
            const float4 a = *(const float4*)&As[kk][ty * 4];
            const float4 b = *(const float4*)&Bs[kk][tx * 4];
            const float aa[4] = {a.x, a.y, a.z, a.w}, bb[4] = {b.x, b.y, b.z, b.w};
#pragma unroll
            for (int i = 0; i < 4; ++i)
#pragma unroll
                for (int j = 0; j < 4; ++j) acc[i][j] += aa[i] * bb[j];
            if (MODE == 1) {
                const float4 b2 = *(const float4*)&Bs2[kk][tx * 4];
                const float bb2[4] = {b2.x, b2.y, b2.z, b2.w};
#pragma unroll
                for (int i = 0; i < 4; ++i)
#pragma unroll
                    for (int j = 0; j < 4; ++j) acc2[i][j] += aa[i] * bb2[j];
            }
        }
        __syncthreads();
    }
#pragma unroll
    for (int i = 0; i < 4; ++i) {
        const int m = m0 + ty * 4 + i;
        if (MODE == 0) {
            *(float4*)(C + (size_t)m * ldc + n0 + tx * 4) = make_float4(acc[i][0], acc[i][1], acc[i][2], acc[i][3]);
        } else if (MODE == 1) {
            *(float4*)(C + (size_t)m * ldc + n0 + tx * 4) = make_float4(siluf_(acc[i][0]) * acc2[i][0], siluf_(acc[i][1]) * acc2[i][1], siluf_(acc[i][2]) * acc2[i][2], siluf_(acc[i][3]) * acc2[i][3]);
        } else {
            const int tok = gather ? gather[m] : m;
            if (tok >= 0) {
                const float w = roww ? roww[m] : 1.f;
#pragma unroll
                for (int j = 0; j < 4; ++j) atomicAdd(C + (size_t)tok * ldc + n0 + tx * 4 + j, acc[i][j] * w);
            }
        }
    }
}

__device__ __forceinline__ int t5_bucket(int n) {
    if (n < 16) return n;
    int large = 16 + (int)(logf((float)n / 16.f) / logf(8.f) * 16.f);
    return large < 31 ? large : 31;
}
__global__ __launch_bounds__(256) void k_attn(const float* __restrict__ proj, const float* __restrict__ table, const float* __restrict__ lam_par, const float* __restrict__ subln,
                                              float lambda_init, float* __restrict__ mix) {
    __shared__ float sl[4][SEQ];
    const int wid = threadIdx.x >> 6, lane = threadIdx.x & 63;
    const int gw = blockIdx.x * 4 + wid;
    const int q = gw % SEQ, h = (gw / SEQ) % A_HEADS, b = gw / (SEQ * A_HEADS);
    float* s = sl[wid];
    float l01 = lam_par[lane] * lam_par[64 + lane], l23 = lam_par[128 + lane] * lam_par[192 + lane];
    l01 = wave_sum(l01); l23 = wave_sum(l23);
    const float lam = __expf(l01) - __expf(l23) + lambda_init;
    const size_t rowq = (size_t)(b * SEQ + q) * IN_COLS;
    float o[2][2];
    for (int m = 0; m < 2; ++m) {
        const float* qp = proj + rowq + h * 128 + m * 64;
        float mx = -INFINITY;
        for (int j = lane; j <= q; j += 64) {
            const float* kp = proj + (size_t)(b * SEQ + j) * IN_COLS + A_WIDTH + h * 128 + m * 64;
            float dot = 0.f;
#pragma unroll 4
            for (int d = 0; d < 64; d += 4) {
                const float4 kv = *(const float4*)(kp + d), qv = *(const float4*)(qp + d);
                dot += kv.x * qv.x + kv.y * qv.y + kv.z * qv.z + kv.w * qv.w;
            }
            const float lg = dot * 0.125f + table[t5_bucket(q - j) * A_HEADS + h];
            s[j] = lg; mx = fmaxf(mx, lg);
        }
        mx = wave_max(mx);
        float sum = 0.f;
        for (int j = lane; j <= q; j += 64) { const float p = __expf(s[j] - mx); s[j] = p; sum += p; }
        sum = wave_sum(sum);
        __syncthreads();
        float a0 = 0.f, a1 = 0.f;
        const float* vp = proj + (size_t)(b * SEQ) * IN_COLS + 2 * A_WIDTH + h * 128 + lane;
        for (int j = 0; j <= q; ++j) { const float p = s[j]; a0 += p * vp[(size_t)j * IN_COLS]; a1 += p * vp[(size_t)j * IN_COLS + 64]; }
        o[m][0] = a0 / sum; o[m][1] = a1 / sum;
        __syncthreads();
    }
    const float r0 = o[0][0] - lam * o[1][0], r1 = o[0][1] - lam * o[1][1];
    const float ss = wave_sum(r0 * r0 + r1 * r1);
    const float rs = rsqrtf(ss / 128.f + 1e-6f) * (1.f - lambda_init);
    float* mp = mix + (size_t)(b * SEQ + q) * D + h * 128;
    mp[lane] = r0 * rs * subln[lane]; mp[lane + 64] = r1 * rs * subln[lane + 64];
}

__global__ __launch_bounds__(256) void k_rwkv_prep(const float* __restrict__ proj, const float* __restrict__ mu, const float* __restrict__ w0, const float* __restrict__ w2, const float* __restrict__ a0,
                                                   const float* __restrict__ a2, const float* __restrict__ g2, const float* __restrict__ k_k, const float* __restrict__ k_a,
                                                   float* __restrict__ R, float* __restrict__ Wd, float* __restrict__ Kk, float* __restrict__ V, float* __restrict__ Aa, float* __restrict__ Bb, float* __restrict__ G) {
    __shared__ float p[B_COLS];
    const int t = blockIdx.x, c = threadIdx.x, s = t % SEQ;
    for (int i = c; i < B_COLS; i += 256) {
        const float cur = proj[(size_t)t * IN_COLS + A_COLS + i];
        const float prev = s > 0 ? proj[(size_t)(t - 1) * IN_COLS + A_COLS + i] : 0.f;
        p[i] = cur + (prev - cur) * mu[i];
    }
    __syncthreads();
    if (c < 64) p[768 + c] = tanhf(p[768 + c]);
    if (c >= 128) p[896 + c - 128] = sigmoidf_(p[896 + c - 128]);
    __syncthreads();
    float zw = w0[c], za = a0[c], g = 0.f;
    for (int k = 0; k < 64; ++k) { zw += p[768 + k] * w2[k * 256 + c]; za += p[832 + k] * a2[k * 256 + c]; }
    for (int k = 0; k < 128; ++k) g += p[896 + k] * g2[k * 256 + c];
    const float sp = (-zw > 20.f) ? -zw : log1pf(__expf(-zw));
    const float wl = -sp - 0.5f;
    const float decay = __expf(-__expf(wl));
    const float a = sigmoidf_(za);
    const float r = p[c], k = p[256 + c], v = p[512 + c];
    float kk = k * k_k[c];
    const float ss = wave_sum(kk * kk);
    kk = kk * rsqrtf(fmaxf(ss, 1e-24f));
    const float kmod = k * (1.f + (a - 1.f) * k_a[c]);
    const size_t o = (size_t)t * 256 + c;
    R[o] = r; Wd[o] = decay; Kk[o] = kmod; V[o] = v; Aa[o] = -kk; Bb[o] = kk * a; G[o] = g;
}
__global__ __launch_bounds__(64) void k_rwkv_scan(const float* __restrict__ R, const float* __restrict__ Wd, const float* __restrict__ Kk, const float* __restrict__ V,
                                                  const float* __restrict__ Aa, const float* __restrict__ Bb, float* __restrict__ Y) {
    const int bh = blockIdx.x, b = bh >> 2, h = bh & 3, lane = threadIdx.x;
    float st[64];
#pragma unroll
    for (int j = 0; j < 64; ++j) st[j] = 0.f;
    for (int t = 0; t < SEQ; ++t) {
        const size_t base = (size_t)(b * SEQ + t) * 256 + h * 64;
        const float v = V[base + lane];
        const float* ap = Aa + base; const float* bp = Bb + base; const float* wp = Wd + base; const float* kp = Kk + base; const float* rp = R + base;
        float sa = 0.f;
#pragma unroll
        for (int j = 0; j < 64; ++j) sa += st[j] * ap[j];
        float y = 0.f;
#pragma unroll
        for (int j = 0; j < 64; ++j) { st[j] = st[j] * wp[j] + sa * bp[j] + v * kp[j]; y += st[j] * rp[j]; }
        Y[base + lane] = y;
    }
}
__global__ __launch_bounds__(256) void k_rwkv_post(const float* __restrict__ Y, const float* __restrict__ R, const float* __restrict__ Kk, const float* __restrict__ V, const float* __restrict__ G,
                                                   const float* __restrict__ r_k, const float* __restrict__ lnx_g, const float* __restrict__ lnx_b, float* __restrict__ mix) {
    const int t = blockIdx.x, c = threadIdx.x;
    const size_t o = (size_t)t * 256 + c;
    const float y = Y[o];
    const float mean = wave_sum(y) * (1.f / 64.f);
    const float d = y - mean;
    const float var = wave_sum(d * d) * (1.f / 64.f);
    const float yn = d * rsqrtf(var + 64e-5f) * lnx_g[c] + lnx_b[c];
    const float bonus = wave_sum(R[o] * Kk[o] * r_k[c]) * V[o];
    mix[(size_t)t * D + A_WIDTH + c] = (yn + bonus) * G[o];
}

__global__ __launch_bounds__(256) void k_gmlp_a(const float* __restrict__ proj, const float* __restrict__ ln_g, const float* __restrict__ ln_b, float* __restrict__ U, float* __restrict__ VN) {
    __shared__ float red[4];
    const int t = blockIdx.x, c = threadIdx.x;
    const float* pc = proj + (size_t)t * IN_COLS + A_COLS + B_COLS;
    const float u = gelu_tanh(pc[c]), v = gelu_tanh(pc[256 + c]);
    const float mean = block_sum256(v, red) * (1.f / 256.f);
    const float d = v - mean;
    const float var = block_sum256(d * d, red) * (1.f / 256.f);
    U[(size_t)t * 256 + c] = u;
    VN[(size_t)t * 256 + c] = d * rsqrtf(var + 1e-5f) * ln_g[c] + ln_b[c];
}
__global__ __launch_bounds__(256) void k_gmlp_b(const float* __restrict__ U, const float* __restrict__ VN, const float* __restrict__ w_s, const float* __restrict__ b_s, float* __restrict__ mix) {
    const int t = blockIdx.x, c = threadIdx.x, g = c >> 6, tt = t % CHUNK, t0 = t - tt;
    const float* w = w_s + ((size_t)g * CHUNK + tt) * CHUNK;
    float acc = b_s[g * CHUNK + tt];
    for (int s = 0; s <= tt; ++s) acc += w[s] * VN[(size_t)(t0 + s) * 256 + c];
    mix[(size_t)t * D + A_WIDTH + B_WIDTH + c] = U[(size_t)t * 256 + c] * acc;
}

__global__ __launch_bounds__(256) void k_route(const float* __restrict__ h, const float* __restrict__ wr, const float* __restrict__ ebias, int* __restrict__ top_idx, float* __restrict__ top_w, int* __restrict__ counts) {
    const int wid = threadIdx.x >> 6, lane = threadIdx.x & 63;
    const int t = blockIdx.x * 4 + wid;
    const float* hr = h + (size_t)t * D;
    float acc = 0.f;
    for (int k = 0; k < D; ++k) acc += hr[k] * wr[k * NE + lane];
    const float s = sigmoidf_(acc);
    const float bz = s + ebias[lane];
    int rk = 0;
    const int gbase = lane & ~7;
#pragma unroll
    for (int j = 0; j < 8; ++j) { const float o = __shfl(bz, gbase + j); rk += (o > bz || (o == bz && (gbase + j) < lane)) ? 1 : 0; }
    float gs = rk < 2 ? bz : 0.f;
    gs += __shfl_xor(gs, 1); gs += __shfl_xor(gs, 2); gs += __shfl_xor(gs, 4);
    int grk = 0;
    const int myg = lane >> 3;
#pragma unroll
    for (int g = 0; g < 8; ++g) { const float o = __shfl(gs, g * 8); grk += (o > gs || (o == gs && g < myg)) ? 1 : 0; }
    const float masked = grk < 4 ? bz : -INFINITY;
    int rank = 0;
    for (int j = 0; j < 64; ++j) { const float o = __shfl(masked, j); rank += (o > masked || (o == masked && j < lane)) ? 1 : 0; }
    const bool sel = rank < TOPK;
    const float ssum = wave_sum(sel ? s : 0.f);
    if (sel) {
        top_idx[t * TOPK + rank] = lane;
        top_w[t * TOPK + rank] = s / (ssum + 1e-20f) * 2.5f;
        atomicAdd(&counts[lane], 1);
    }
}
__global__ void k_offsets(const int* __restrict__ counts, int* __restrict__ pad_start, int* __restrict__ cursor, int* __restrict__ blk_e) {
    __shared__ int ps[NE + 1];
    if (threadIdx.x == 0) {
        int acc = 0;
        for (int e = 0; e < NE; ++e) { ps[e] = acc; acc += (counts[e] + EBLK - 1) / EBLK * EBLK; }
        ps[NE] = acc;
    }
    __syncthreads();
    if (threadIdx.x < NE) { pad_start[threadIdx.x] = ps[threadIdx.x]; cursor[threadIdx.x] = 0; }
    for (int i = threadIdx.x; i < NBLK; i += blockDim.x) {
        int e = -1;
        for (int j = 0; j < NE; ++j) if (i * EBLK >= ps[j] && i * EBLK < ps[j + 1]) e = j;
        blk_e[i] = e;
    }
}
__global__ void k_scatter(const int* __restrict__ top_idx, const float* __restrict__ top_w, const int* __restrict__ pad_start, int* __restrict__ cursor, int* __restrict__ row_tok, float* __restrict__ row_w) {
    const int i = blockIdx.x * 256 + threadIdx.x;
    const int e = top_idx[i];
    const int pos = pad_start[e] + atomicAdd(&cursor[e], 1);
    row_tok[pos] = i / TOPK; row_w[pos] = top_w[i];
}
}

extern "C" void kernel_launch(void* const* d_in, const int* in_sizes, int n_in, void* d_out, int out_size, void* d_ws, size_t ws_size, hipStream_t stream) {
    const float* x = (const float*)d_in[0]; const float* c = (const float*)d_in[1];
    const float* w_ada = (const float*)d_in[2]; const float* b_ada = (const float*)d_in[3];
    const float* n_pre_mix = (const float*)d_in[4]; const float* n_post_mix = (const float*)d_in[5];
    const float* n_pre_ffn = (const float*)d_in[6]; const float* n_post_ffn = (const float*)d_in[7];
    const float* w_in = (const float*)d_in[8]; const float* w_out = (const float*)d_in[9];
    const float* table = (const float*)d_in[10]; const float* diff_lambda = (const float*)d_in[11]; const float* diff_subln = (const float*)d_in[12];
    const float* mu = (const float*)d_in[13]; const float* w0 = (const float*)d_in[14]; const float* w2 = (const float*)d_in[15];
    const float* a0 = (const float*)d_in[16]; const float* a2 = (const float*)d_in[17]; const float* g2 = (const float*)d_in[18];
    const float* k_k = (const float*)d_in[19]; const float* k_a = (const float*)d_in[20]; const float* r_k = (const float*)d_in[21];
    const float* lnx_g = (const float*)d_in[22]; const float* lnx_b = (const float*)d_in[23];
    const float* gln_g = (const float*)d_in[24]; const float* gln_b = (const float*)d_in[25]; const float* gw_s = (const float*)d_in[26]; const float* gb_s = (const float*)d_in[27];
    const float* router_w = (const float*)d_in[28]; const float* router_b = (const float*)d_in[29];
    const float* e_w1 = (const float*)d_in[30]; const float* e_w3 = (const float*)d_in[31]; const float* e_w2 = (const float*)d_in[32];
    const float* s_w1 = (const float*)d_in[33]; const float* s_w3 = (const float*)d_in[34]; const float* s_w2 = (const float*)d_in[35];
    float* out = (float*)d_out;

    char* ws = (char*)d_ws;
    size_t off = 0;
    auto carve = [&](size_t bytes) { char* p = ws + off; off += (bytes + 255) & ~(size_t)255; return p; };
    float* MOD = (float*)carve((size_t)DEPTH * BATCH * 6 * D * 4);
    int* CNT = (int*)carve(NE * 4); int* PADS = (int*)carve(NE * 4); int* CUR = (int*)carve(NE * 4); int* BLKE = (int*)carve(NBLK * 4);
    int* TOPI = (int*)carve((size_t)T * TOPK * 4); float* TOPW = (float*)carve((size_t)T * TOPK * 4);
    int* ROWT = (int*)carve((size_t)P * 4); float* ROWW = (float*)carve((size_t)P * 4);
    float* H = (float*)carve((size_t)T * D * 4);
    float* MIX = (float*)carve((size_t)T * D * 4);
    float* PROJ = (float*)carve((size_t)T * IN_COLS * 4);
    float* RW = (float*)carve((size_t)T * 256 * 4 * 8);
    float* HBS = (float*)carve((size_t)T * DE * 4);
    if (off > ws_size) { fprintf(stderr, "kernel_launch: workspace too small: need %zu have %zu\n", off, ws_size); return; }
    float* Y = PROJ;
    float* HB = PROJ + (size_t)T * D;
    float* R_ = RW, *W_ = RW + (size_t)T * 256, *K_ = RW + (size_t)T * 256 * 2, *V_ = RW + (size_t)T * 256 * 3, *A_ = RW + (size_t)T * 256 * 4, *B_ = RW + (size_t)T * 256 * 5, *G_ = RW + (size_t)T * 256 * 6, *YS = RW + (size_t)T * 256 * 7;
    float* GU = H;
    float* GVN = H + (size_t)T * 256;

    hipLaunchKernelGGL(k_mod, dim3(6 * D / 256, BATCH, DEPTH), dim3(256), 0, stream, c, w_ada, b_ada, MOD);
    const float* xin = x;
    for (int l = 0; l < DEPTH; ++l) {
        const float* mod_l = MOD + (size_t)l * BATCH * 6 * D;
        const float lambda_init = 0.8f - 0.6f * expf(-0.3f * (float)l);
        hipLaunchKernelGGL(k_norm_mod, dim3(T), dim3(256), 0, stream, xin, n_pre_mix + l * D, mod_l, 0, 1, H);
        hipLaunchKernelGGL(k_gemm<0>, dim3(IN_COLS / 64, T / 64), dim3(256), 0, stream, (const float*)H, D, w_in + (size_t)l * D * IN_COLS, (const float*)nullptr, IN_COLS, (size_t)0, PROJ, IN_COLS, D,
                           (const int*)nullptr, (const int*)nullptr, (const float*)nullptr);
        hipLaunchKernelGGL(k_attn, dim3(T * A_HEADS / 4), dim3(256), 0, stream, (const float*)PROJ, table, diff_lambda + l * 256, diff_subln + l * 128, lambda_init, MIX);
        hipLaunchKernelGGL(k_rwkv_prep, dim3(T), dim3(256), 0, stream, (const float*)PROJ, mu + l * B_COLS, w0 + l * 256, w2 + l * 64 * 256, a0 + l * 256, a2 + l * 64 * 256, g2 + l * 128 * 256,
                           k_k + l * 256, k_a + l * 256, R_, W_, K_, V_, A_, B_, G_);
        hipLaunchKernelGGL(k_rwkv_scan, dim3(BATCH * 4), dim3(64), 0, stream, (const float*)R_, (const float*)W_, (const float*)K_, (const float*)V_, (const float*)A_, (const float*)B_, YS);
        hipLaunchKernelGGL(k_rwkv_post, dim3(T), dim3(256), 0, stream, (const float*)YS, (const float*)R_, (const float*)K_, (const float*)V_, (const float*)G_, r_k + l * 256, lnx_g + l * 256, lnx_b + l * 256, MIX);
        hipLaunchKernelGGL(k_gmlp_a, dim3(T), dim3(256), 0, stream, (const float*)PROJ, gln_g + l * 256, gln_b + l * 256, GU, GVN);
        hipLaunchKernelGGL(k_gmlp_b, dim3(T), dim3(256), 0, stream, (const float*)GU, (const float*)GVN, gw_s + (size_t)l * 4 * CHUNK * CHUNK, gb_s + l * 4 * CHUNK, MIX);
        hipLaunchKernelGGL(k_gemm<0>, dim3(D / 64, T / 64), dim3(256), 0, stream, (const float*)MIX, D, w_out + (size_t)l * D * D, (const float*)nullptr, D, (size_t)0, Y, D, D,
                           (const int*)nullptr, (const int*)nullptr, (const float*)nullptr);
        hipLaunchKernelGGL(k_resid, dim3(T), dim3(256), 0, stream, xin, (const float*)Y, n_post_mix + l * D, mod_l, 2, out);
        hipLaunchKernelGGL(k_norm_mod, dim3(T), dim3(256), 0, stream, (const float*)out, n_pre_ffn + l * D, mod_l, 3, 4, H);
        hipMemsetAsync(CNT, 0, NE * 4, stream);
        hipMemsetAsync(ROWT, 0xFF, (size_t)P * 4, stream);
        hipMemsetAsync(MIX, 0, (size_t)T * D * 4, stream);
        hipLaunchKernelGGL(k_route, dim3(T / 4), dim3(256), 0, stream, (const float*)H, router_w + (size_t)l * D * NE, router_b + l * NE, TOPI, TOPW, CNT);
        hipLaunchKernelGGL(k_offsets, dim3(1), dim3(64), 0, stream, (const int*)CNT, PADS, CUR, BLKE);
        hipLaunchKernelGGL(k_scatter, dim3(T * TOPK / 256), dim3(256), 0, stream, (const int*)TOPI, (const float*)TOPW, (const int*)PADS, CUR, ROWT, ROWW);
        hipLaunchKernelGGL(k_gemm<1>, dim3(DE / 64, P / 64), dim3(256), 0, stream, (const float*)H, D, e_w1 + (size_t)l * NE * D * DE, e_w3 + (size_t)l * NE * D * DE, DE, (size_t)D * DE, HB, DE, D,
                           (const int*)ROWT, (const int*)BLKE, (const float*)nullptr);
        hipLaunchKernelGGL(k_gemm<2>, dim3(D / 64, P / 64), dim3(256), 0, stream, (const float*)HB, DE, e_w2 + (size_t)l * NE * DE * D, (const float*)nullptr, D, (size_t)DE * D, MIX, D, DE,
                           (const int*)ROWT, (const int*)BLKE, (const float*)ROWW);
        hipLaunchKernelGGL(k_gemm<1>, dim3(DE / 64, T / 64), dim3(256), 0, stream, (const float*)H, D, s_w1 + (size_t)l * D * DE, s_w3 + (size_t)l * D * DE, DE, (size_t)0, HBS, DE, D,
                           (const int*)nullptr, (const int*)nullptr, (const float*)nullptr);
        hipLaunchKernelGGL(k_gemm<2>, dim3(D / 64, T / 64), dim3(256), 0, stream, (const float*)HBS, DE, s_w2 + (size_t)l * DE * D, (const float*)nullptr, D, (size_t)0, MIX, D, DE,
                           (const int*)nullptr, (const int*)nullptr, (const float*)nullptr);
        hipLaunchKernelGGL(k_resid, dim3(T), dim3(256), 0, stream, (const float*)out, (const float*)MIX, n_post_ffn + l * D, mod_l, 5, out);
        xin = out;
    }
}
```

```cpp
#include <hip/hip_runtime.h>
#include <cstdio>
#include <cstdint>
#include <cmath>

namespace {
constexpr int D = 1024, BATCH = 8, SEQ = 2048, T = BATCH * SEQ, DEPTH = 2;
constexpr int A_HEADS = 4, A_WIDTH = 512;
constexpr int B_WIDTH = 256, B_COLS = 1024, CHUNK = 128;
constexpr int A_COLS = 1536, IN_COLS = 3072;
constexpr int NE = 64, TOPK = 8, DE = 256;
constexpr int EBLK = 256;
constexpr int NBLK = T * TOPK / EBLK + NE;
constexpr int P = NBLK * EBLK;
constexpr int NT = 512;
constexpr int LDS_BYTES = 147456;

#define LAS __attribute__((address_space(3)))

__device__ __forceinline__ int olane() { int l; asm volatile("v_mbcnt_lo_u32_b32 %0, -1, 0\n\tv_mbcnt_hi_u32_b32 %0, -1, %0" : "=v"(l)); return l; }
__device__ __forceinline__ float shfl_idx(float v, int src) { return __int_as_float(__builtin_amdgcn_ds_bpermute(src << 2, __float_as_int(v))); }
__device__ __forceinline__ float wave_sum(float v) {
    const int l = olane();
#pragma unroll
    for (int o = 1; o < 64; o <<= 1) v += shfl_idx(v, l ^ o);
    return v;
}
__device__ __forceinline__ float wave_max(float v) {
    const int l = olane();
#pragma unroll
    for (int o = 1; o < 64; o <<= 1) v = fmaxf(v, shfl_idx(v, l ^ o));
    return v;
}
__device__ __forceinline__ float rdlane(float v, int src) { return __int_as_float(__builtin_amdgcn_readlane(__float_as_int(v), src)); }
__device__ __forceinline__ float sigmoidf_(float x) { return 1.f / (1.f + __expf(-x)); }
__device__ __forceinline__ float siluf_(float x) { return x / (1.f + __expf(-x)); }
__device__ __forceinline__ float gelu_tanh(float x) {
    const float u = 0.7978845608028654f * (x + 0.044715f * x * x * x);
    return 0.5f * x * (1.f + tanhf(u));
}

extern __shared__ __attribute__((aligned(16))) unsigned char lds_raw[];
constexpr int WIDTAB_OFF = 147456 - 768;
__device__ __forceinline__ int owave() {
    const unsigned key = (unsigned)__builtin_amdgcn_s_getreg(63492) & 63u;
    const int w = *(volatile __attribute__((address_space(3))) int*)((__attribute__((address_space(3))) unsigned char*)lds_raw + WIDTAB_OFF + 4 * key);
    return __builtin_amdgcn_readfirstlane(w);
}
__device__ __forceinline__ int olane_() { int l; asm volatile("v_mbcnt_lo_u32_b32 %0, -1, 0\n\tv_mbcnt_hi_u32_b32 %0, -1, %0" : "=v"(l)); return l; }
__device__ __forceinline__ int otid() { return owave() * 64 + olane_(); }
__device__ __forceinline__ int obid() { int b = blockIdx.x; asm volatile("" : "+s"(b)); return b; }
__device__ __forceinline__ int ogdim() { int g = gridDim.x; asm volatile("" : "+s"(g)); return g; }
typedef unsigned short bf16;
__device__ __forceinline__ float bf2f(bf16 v) { return __uint_as_float((unsigned)v << 16); }
__device__ __forceinline__ unsigned f2bf(float f) { unsigned u = __float_as_uint(f); return (u + 0x7fffu + ((u >> 16) & 1u)) >> 16; }
__device__ __forceinline__ unsigned pk2(float lo, float hi) { return f2bf(lo) | (f2bf(hi) << 16); }

#define XB_TMO      128
#define XB_XCNT(j)  (256  + 64 * (j))
#define XB_XSUB(j)  (1280 + 64 * (j))
#define XB_XGEN(j)  (2304 + 64 * (j))
#define XB_TOP      3328
#define XB_TOPGEN   3392
#define XCD_BAR_WORDS 3456
#define XB_SPIN_CAP (1u << 27)
__device__ __forceinline__ unsigned xb_ld(unsigned* p)              { return __hip_atomic_load(p, __ATOMIC_RELAXED, __HIP_MEMORY_SCOPE_AGENT); }
__device__ __forceinline__ unsigned xb_add(unsigned* p, unsigned v) { return __hip_atomic_fetch_add(p, v, __ATOMIC_RELAXED, __HIP_MEMORY_SCOPE_AGENT); }
__device__ __forceinline__ unsigned xb_xcc_id() { return (unsigned)__builtin_amdgcn_s_getreg((3 << 11) | 20) & 0xFu; }
#define XB_SPIN(cond, bar) do { unsigned _sp = 0; while (cond) { __builtin_amdgcn_s_sleep(1); \
    if ((++_sp & 255u) == 0u) { if (xb_ld(&(bar)[XB_TMO])) break; if (_sp > XB_SPIN_CAP) { atomicAdd(&(bar)[XB_TMO], 1u); break; } } } } while (0)
struct XcdBarrier { unsigned* bar; unsigned x; volatile LAS unsigned* st; };
__device__ __forceinline__ XcdBarrier xcd_barrier_post(unsigned* bar, volatile LAS unsigned* st) {
    XcdBarrier b; b.bar = bar; b.x = xb_xcc_id(); b.st = st;
    if (threadIdx.x == 0) (void)xb_add(&bar[XB_XCNT(b.x)], 1u);
    return b;
}
__device__ __forceinline__ void xcd_barrier_complete(unsigned* bar, unsigned x, unsigned& nloc, unsigned& nx) {
    const unsigned G = gridDim.x * gridDim.y * gridDim.z;
    unsigned sum, cnt, mine, sp = 0u;
    for (;;) {
        sum = 0u; cnt = 0u; mine = 0u;
#pragma unroll
        for (unsigned j = 0; j < 16; ++j) { const unsigned c = xb_ld(&bar[XB_XCNT(j)]); sum += c; cnt += (c > 0u) ? 1u : 0u; mine = (j == x) ? c : mine; }
        if (sum == G) break;
        __builtin_amdgcn_s_sleep(1);
        if ((++sp & 255u) == 0u) { if (xb_ld(&bar[XB_TMO])) break; if (sp > XB_SPIN_CAP) { atomicAdd(&bar[XB_TMO], 1u); break; } }
    }
    nloc = mine > 0u ? mine : 1u; nx = cnt > 0u ? cnt : 1u;
}
__device__ __forceinline__ void xcd_barrier(const XcdBarrier& b) {
    asm volatile("s_waitcnt vmcnt(0)" ::: "memory");
    __syncthreads();
    if (otid() == 0) {
        unsigned* bar = b.bar; asm volatile("" : "+s"(bar));
        unsigned bx = b.x; asm volatile("" : "+s"(bx));
        __builtin_amdgcn_s_waitcnt(0);
        unsigned nloc = b.st[0], nx = b.st[1];
        if (nloc == 0u) { xcd_barrier_complete(bar, bx, nloc, nx); b.st[0] = nloc; b.st[1] = nx; }
        const unsigned old = xb_add(&bar[XB_XSUB(bx)], 1u);
        const unsigned gen = old / nloc;
        if (old + 1u == (gen + 1u) * nloc) {
            __builtin_amdgcn_fence(__ATOMIC_RELEASE, "agent");
            asm volatile("s_waitcnt vmcnt(0)" ::: "memory");
            const unsigned og = xb_add(&bar[XB_TOP], 1u);
            const unsigned tg = og / nx;
            if (og + 1u == (tg + 1u) * nx) xb_add(&bar[XB_TOPGEN], 1u);
            else XB_SPIN(xb_ld(&bar[XB_TOPGEN]) == tg, bar);
            __builtin_amdgcn_fence(__ATOMIC_ACQUIRE, "agent");
            xb_add(&bar[XB_XGEN(bx)], 1u);
            asm volatile("s_waitcnt vmcnt(0)" ::: "memory");
        } else {
            XB_SPIN(xb_ld(&bar[XB_XGEN(bx)]) == gen, bar);
            __builtin_amdgcn_fence(__ATOMIC_ACQUIRE, "agent");
            asm volatile("s_waitcnt vmcnt(0)" ::: "memory");
        }
    }
    __syncthreads();
}

namespace pg8 {
#define PG8_LAS __attribute__((address_space(3)))
typedef unsigned short bf16_t;
typedef short bf16x8 __attribute__((ext_vector_type(8)));
typedef float f32x4 __attribute__((ext_vector_type(4)));
typedef unsigned u32x4 __attribute__((ext_vector_type(4)));
constexpr int BM = 256, BK = 64, HALF = 128, HTB = HALF * BK * 2  , STAGE_BYTES = 8 * HTB, NXCD = 8, WGM = 8;

__host__ __device__ __forceinline__ int lds_byte(int r, int c) { const int st = (r >> 4) * 2 + (c >> 5), rr = r & 15, cc = c & 31, ob = rr * 64 + cc * 2; return st * 1024 + (ob ^ (((ob >> 9) & 1) << 5)); }
__host__ __device__ __forceinline__ void stage_rc(int b, int& R, int& C) { const int st = b / 1024, sb = b % 1024, swz = sb ^ (((sb >> 9) & 1) << 5); R = (st >> 1) * 16 + swz / 64; C = (st & 1) * 32 + (swz % 64) / 2; }
__host__ __device__ __forceinline__ int perm32(int rho) { const int n = rho >> 4, i = rho & 15; return 8 * (i >> 2) + 4 * n + (i & 3); }

struct Unit { int pm, pn; size_t boff; };
struct Gemm { const bf16_t* A; const bf16_t* Bt; int M, N, K; };

struct StaticOrder {
    int nM, nN, nwg, G, c;
    __host__ __device__ void init(int M, int N, int G_, int c_) { nM = M / BM; nN = N / BM; nwg = nM * nN; G = G_; c = c_; }
    __host__ __device__ bool next(int i, Unit& u) const {
        const long L = (long)i * G + c; if (L >= nwg) return false;
        int wgid = (int)L; { const int q = nwg / NXCD, r = nwg % NXCD, xcd = wgid % NXCD, off = wgid / NXCD; wgid = (xcd < r ? xcd * (q + 1) : r * (q + 1) + (xcd - r) * q) + off; }
        const int nig = WGM * nN, gid = wgid / nig, fm = gid * WGM, gsz = (nM - fm) < WGM ? (nM - fm) : WGM;
        u.pm = fm + ((wgid % nig) % gsz); u.pn = (wgid % nig) / gsz; u.boff = 0; return true;
    }
    __device__ __forceinline__ unsigned arow(const Unit& u, int r) const { return (unsigned)(u.pm * BM + r); }
    __device__ __forceinline__ void a_ready(const Unit&) const {}
    __device__ __forceinline__ void done(const Unit&) const {}
};

__device__ __forceinline__ unsigned cvt_pk_bf16(float lo, float hi) { unsigned r; asm volatile("v_cvt_pk_bf16_f32 %0, %1, %2" : "=v"(r) : "v"(lo), "v"(hi)); return r; }
typedef float f32x2 __attribute__((ext_vector_type(2)));
__device__ __forceinline__ f32x2 gelu_pk(f32x2 v) {
    const f32x2 av = __builtin_elementwise_abs(v), d = av * 0.2316418882f + 1.0f;
    f32x2 t; t.x = __builtin_amdgcn_rcpf(d.x); t.y = __builtin_amdgcn_rcpf(d.y);
    f32x2 q = t * 0.5307027145f + (-0.7265760135f); q = q * t + 0.7107068705f; q = q * t + (-0.142248368f); q = q * t + 0.127414796f; q = q * t;
    const f32x2 s = (v * v) * (-0.72134752044f);
    f32x2 e; e.x = __builtin_amdgcn_exp2f(s.x); e.y = __builtin_amdgcn_exp2f(s.y);
    const f32x2 m = v * (q * e), r = v - m;
    f32x2 o; o.x = v.x < 0.f ? m.x : r.x; o.y = v.y < 0.f ? m.y : r.y; return o;
}

template <int ACT  > struct EpiBf16 {
    static constexpr bool PERM = true, AFTER_DRAIN = false; static_assert(ACT == 0 || ACT == 1, "EpiBf16: ACT is 0 (none) or 1 (gelu_pk)");
    bf16_t* O; int ldc; const float* bias; int split_cols; size_t split_stride; float scale0;
    __device__ __forceinline__ void operator()(const f32x4 (&acc)[2][2][4][2], const Unit& u, int wr, int wc, int fr, int fq) const {
        const int row0 = u.pm * BM + wr * 64 + fr; int colt = u.pn * BM; bf16_t* base = O;
        float sc = 1.f; if (split_cols) { const int t = colt / split_cols; base += (size_t)t * split_stride; colt -= t * split_cols; if (t == 0) sc = scale0; }
        const int col0 = colt + wc * 32 + 8 * fq, bcol0 = u.pn * BM + wc * 32 + 8 * fq;
        f32x4 bv[2][2];
#pragma unroll
        for (int bj = 0; bj < 2; ++bj)
#pragma unroll
            for (int n = 0; n < 2; ++n) bv[bj][n] = bias ? *(const f32x4*)(bias + bcol0 + bj * HALF + 4 * n) : (f32x4){0.f, 0.f, 0.f, 0.f};
#pragma unroll
        for (int ai = 0; ai < 2; ++ai)
#pragma unroll
            for (int m = 0; m < 4; ++m) { bf16_t* rowp = base + (size_t)(row0 + ai * HALF + m * 16) * ldc + col0;
#pragma unroll
                for (int bj = 0; bj < 2; ++bj) { f32x4 v0 = acc[ai][bj][m][0] + bv[bj][0], v1 = acc[ai][bj][m][1] + bv[bj][1];
                    if (ACT == 1) { f32x2 a = gelu_pk((f32x2){v0[0], v0[1]}), b = gelu_pk((f32x2){v0[2], v0[3]}), c = gelu_pk((f32x2){v1[0], v1[1]}), d = gelu_pk((f32x2){v1[2], v1[3]});
                        v0 = (f32x4){a.x, a.y, b.x, b.y}; v1 = (f32x4){c.x, c.y, d.x, d.y}; }
                    v0 = v0 * sc; v1 = v1 * sc; u32x4 w; w.x = cvt_pk_bf16(v0[0], v0[1]); w.y = cvt_pk_bf16(v0[2], v0[3]); w.z = cvt_pk_bf16(v1[0], v1[1]); w.w = cvt_pk_bf16(v1[2], v1[3]);
                    *(u32x4*)(rowp + bj * HALF) = w; } }
    }
};

struct EpiF32 {
    static constexpr bool PERM = false, AFTER_DRAIN = false;
    float* C; int ldc;
    __device__ __forceinline__ void operator()(const f32x4 (&acc)[2][2][4][2], const Unit& u, int wr, int wc, int fr, int fq) const {
        const int row0 = u.pm * BM + wr * 64 + fr, col0 = u.pn * BM + wc * 32 + 4 * fq;
#pragma unroll
        for (int ai = 0; ai < 2; ++ai)
#pragma unroll
            for (int m = 0; m < 4; ++m) { float* rowp = C + (size_t)(row0 + ai * HALF + m * 16) * ldc + col0;
#pragma unroll
                for (int bj = 0; bj < 2; ++bj)
#pragma unroll
                    for (int n = 0; n < 2; ++n) *(f32x4*)(rowp + bj * HALF + n * 16) = acc[ai][bj][m][n]; }
    }
};

struct EpiSwiGLU {
    static constexpr bool PERM = true, AFTER_DRAIN = false;
    bf16_t* O;
    __device__ __forceinline__ void operator()(const f32x4 (&acc)[2][2][4][2], const Unit& u, int wr, int wc, int fr, int fq) const {
        const int row0 = u.pm * BM + wr * 64 + fr, col0 = u.pn * HALF + wc * 32 + 8 * fq;
#pragma unroll
        for (int ai = 0; ai < 2; ++ai)
#pragma unroll
            for (int m = 0; m < 4; ++m) {
                bf16_t* rowp = O + (size_t)(row0 + ai * HALF + m * 16) * 256 + col0;
                float hv[8];
#pragma unroll
                for (int n = 0; n < 2; ++n)
#pragma unroll
                    for (int j = 0; j < 4; ++j) { const float a = acc[ai][0][m][n][j], g = acc[ai][1][m][n][j]; hv[n * 4 + j] = a * __builtin_amdgcn_rcpf(1.f + __expf(-a)) * g; }
                u32x4 w; w.x = cvt_pk_bf16(hv[0], hv[1]); w.y = cvt_pk_bf16(hv[2], hv[3]); w.z = cvt_pk_bf16(hv[4], hv[5]); w.w = cvt_pk_bf16(hv[6], hv[7]);
                *(u32x4*)rowp = w;
            }
    }
};
__device__ __forceinline__ unsigned pack_fp8x4(const f32x4& v) {
    const float s = 16.f;
    int w = __builtin_amdgcn_cvt_pk_fp8_f32(__builtin_amdgcn_fmed3f(v[0] * s, -448.f, 448.f), __builtin_amdgcn_fmed3f(v[1] * s, -448.f, 448.f), 0, false);
    w = __builtin_amdgcn_cvt_pk_fp8_f32(__builtin_amdgcn_fmed3f(v[2] * s, -448.f, 448.f), __builtin_amdgcn_fmed3f(v[3] * s, -448.f, 448.f), w, true);
    return (unsigned)w;
}
struct EpiRows {
    static constexpr bool PERM = true, AFTER_DRAIN = false;
    unsigned char* O; unsigned char* O2; int shared_pm0;
    __device__ __forceinline__ void operator()(const f32x4 (&acc)[2][2][4][2], const Unit& u, int wr, int wc, int fr, int fq) const {
        unsigned char* base = u.pm < shared_pm0 ? O + (size_t)u.pm * BM * 1024 : O2 + (size_t)(u.pm - shared_pm0) * BM * 1024;
        const int row0 = wr * 64 + fr, col0 = u.pn * BM + wc * 32 + 8 * fq;
#pragma unroll
        for (int ai = 0; ai < 2; ++ai)
#pragma unroll
            for (int m = 0; m < 4; ++m) {
                unsigned char* rowp = base + (size_t)(row0 + ai * HALF + m * 16) * 1024 + col0;
#pragma unroll
                for (int bj = 0; bj < 2; ++bj) { typedef unsigned u32x2 __attribute__((ext_vector_type(2)));
                    u32x2 w; w.x = pack_fp8x4(acc[ai][bj][m][0]); w.y = pack_fp8x4(acc[ai][bj][m][1]);
                    *(u32x2*)(rowp + bj * HALF) = w; }
            }
    }
};
struct GroupedOrder {
    int nMr, nM, nN, nwg, G, c, spm0; const int* ps; const int* rows; size_t estride;
    __device__ void init(const int* ps_, int nN_, int G_, int c_, const int* rows_, size_t estride_, int spm0_, int nshared) {
        ps = ps_; nMr = ps_[64] / BM; nM = nMr + nshared; nN = nN_; nwg = nM * nN; G = G_; c = c_; rows = rows_; estride = estride_; spm0 = spm0_; }
    __device__ bool next(int i, Unit& u) const {
        const long L = (long)i * G + c; if (L >= nwg) return false;
        int wgid = (int)L; { const int q = nwg / NXCD, r = nwg % NXCD, xcd = wgid % NXCD, off = wgid / NXCD; wgid = (xcd < r ? xcd * (q + 1) : r * (q + 1) + (xcd - r) * q) + off; }
        const int nig = WGM * nN, gid = wgid / nig, fm = gid * WGM, gsz = (nM - fm) < WGM ? (nM - fm) : WGM;
        const int pmi = fm + ((wgid % nig) % gsz); u.pn = (wgid % nig) / gsz;
        if (pmi < nMr) { const int pj = ps[olane()];
            const int e = __popcll(__ballot(pmi * BM >= pj)) - 1; u.pm = pmi; u.boff = (size_t)e * estride; }
        else { u.pm = spm0 + (pmi - nMr); u.boff = (size_t)64 * estride; }
        return true;
    }
    __device__ __forceinline__ unsigned arow(const Unit& u, int r) const {
        if (rows) return u.pm < spm0 ? (unsigned)rows[u.pm * BM + r] : (unsigned)((u.pm - spm0) * BM + r);
        return (unsigned)(u.pm * BM + r);
    }
    __device__ __forceinline__ void a_ready(const Unit&) const {}
    __device__ __forceinline__ void done(const Unit&) const {}
};

template <class Epi, class Sched, bool ALIGN_EPI = false>
__device__ __forceinline__ void gemm_phase(PG8_LAS unsigned char* lds, const Gemm g, const Sched& S, const Epi& E) {
    const int wid = owave(), wr = wid >> 2, wc = wid & 3;
#define tid (wid * 64 + olane())
    int K = g.K; asm volatile("" : "+s"(K));
    const int nt = K / BK;
    unsigned voffB;
    { int R, C; stage_rc(tid * 16, R, C); const int Rb = Epi::PERM ? ((R & ~31) + perm32(R & 31)) : R; voffB = (unsigned)(Rb * K + C) * 2u; }
    const size_t r64step = (size_t)64 * K * 2;
    const unsigned rowbytes = (unsigned)K * 2u;
    const size_t kstep = (size_t)(BK * 2);
    const size_t hstep = (size_t)HALF * K * 2;
    const size_t tstep = 2 * hstep;
    const unsigned ldsw = (unsigned)wid * 1024u;
    int aoff, boff; { const int ln = olane(), fr = ln & 15, fq = ln >> 4; aoff = lds_byte(wr * 64 + fr, fq * 8); boff = lds_byte(wc * 32 + fr, fq * 8); }
#define PG8_SA(b, h) (((b) * 2 + (h)) * HTB)
#define PG8_SB(b, h) ((4 + (b) * 2 + (h)) * HTB)
#define PG8_STAGE(bufoff, gbase, voff) do { _Pragma("unroll") for (int _i = 0; _i < 2; ++_i) \
        __builtin_amdgcn_global_load_lds((const unsigned*)((const char*)(gbase) + (voff)[_i]), (PG8_LAS unsigned*)(lds + (bufoff) + ldsw + _i * 8192), 16, 0, 0); } while (0)
#define PG8_STAGEB(bufoff, gbase) do { _Pragma("unroll") for (int _i = 0; _i < 2; ++_i) \
        __builtin_amdgcn_global_load_lds((const unsigned*)((const char*)(gbase) + _i * r64step + voffB), (PG8_LAS unsigned*)(lds + (bufoff) + ldsw + _i * 8192), 16, 0, 0); } while (0)
#define PG8_LDA(dst, b, h) do { _Pragma("unroll") for (int m = 0; m < 4; ++m) _Pragma("unroll") for (int k = 0; k < 2; ++k) dst[m][k] = *(const PG8_LAS bf16x8*)(lds + PG8_SA(b, h) + aoff + m * 2048 + k * 1024); } while (0)
#define PG8_LDB(dst, b, h) do { _Pragma("unroll") for (int n = 0; n < 2; ++n) _Pragma("unroll") for (int k = 0; k < 2; ++k) dst[n][k] = *(const PG8_LAS bf16x8*)(lds + PG8_SB(b, h) + boff + n * 2048 + k * 1024); } while (0)
#define PG8_MMA(ai, bj, At, Bt) do { __builtin_amdgcn_s_setprio(1); _Pragma("unroll") for (int m = 0; m < 4; ++m) _Pragma("unroll") for (int n = 0; n < 2; ++n) _Pragma("unroll") for (int k = 0; k < 2; ++k) \
        acc[ai][bj][m][n] = __builtin_amdgcn_mfma_f32_16x16x32_bf16(Bt[n][k], At[m][k], acc[ai][bj][m][n], 0, 0, 0); __builtin_amdgcn_s_setprio(0); } while (0)
#define PG8_WAIT_V(n) asm volatile("s_waitcnt vmcnt(" #n ")" ::: "memory")
#define PG8_WAIT_L(n) asm volatile("s_waitcnt lgkmcnt(" #n ")" ::: "memory")
#define PG8_BAR __builtin_amdgcn_s_barrier()
#define PG8_SCHED __builtin_amdgcn_sched_barrier(0)
#define PG8_FILL(tb, u) do { int _t = tid; asm volatile("" : "+v"(_t)); if (_t < BM) rtab[(tb) * BM + _t] = S.arow(u, _t) * rowbytes; } while (0)
#define PG8_AOFF(dst, tb) do { int _t = tid; asm volatile("" : "+v"(_t)); _Pragma("unroll") for (int _i = 0; _i < 2; ++_i) { int _R, _C; stage_rc(_t * 16 + _i * 8192, _R, _C); \
        _Pragma("unroll") for (int _h = 0; _h < 2; ++_h) dst[_h][_i] = rtab[(tb) * BM + _h * HALF + _R] + (unsigned)_C * 2u; } } while (0)
    PG8_LAS unsigned* const rtab = (PG8_LAS unsigned*)(lds + STAGE_BYTES);
    Unit cur, nxt; int ui = 0, ctb = 0;
    if (!S.next(0, cur)) return;
    f32x4 acc[2][2][4][2];
#pragma unroll
    for (int a = 0; a < 2; ++a)
#pragma unroll
        for (int b = 0; b < 2; ++b)
#pragma unroll
            for (int m = 0; m < 4; ++m)
#pragma unroll
                for (int n = 0; n < 2; ++n) acc[a][b][m][n] = (f32x4){0.f, 0.f, 0.f, 0.f};
    bf16x8 At[4][2], B0[2][2], B1[2][2];
    const char* const Ab = (const char*)g.A;
    const char* cB = (const char*)g.Bt + cur.boff + (size_t)cur.pn * tstep;
    PG8_FILL(0, cur);
    __syncthreads();
    S.a_ready(cur);
    { unsigned cv[2][2]; PG8_AOFF(cv, 0);
    PG8_STAGEB(PG8_SB(0, 0), cB); PG8_STAGEB(PG8_SB(0, 1), cB + hstep); PG8_STAGE(PG8_SA(0, 0), Ab, cv[0]); PG8_STAGE(PG8_SA(0, 1), Ab, cv[1]);
    if (wr == 1) PG8_BAR;
    PG8_WAIT_V(2); PG8_BAR;
    PG8_STAGEB(PG8_SB(1, 0), cB + kstep); PG8_STAGE(PG8_SA(1, 0), Ab + kstep, cv[0]); PG8_STAGEB(PG8_SB(1, 1), cB + hstep + kstep);
    PG8_WAIT_V(6); PG8_BAR; }
    for (;;) {
        const bool has_next = S.next(ui + 1, nxt);
        const char* nB = has_next ? (const char*)g.Bt + nxt.boff + (size_t)nxt.pn * tstep : cB;
        if (has_next) PG8_FILL(ctb ^ 1, nxt);
        for (int t = 0; t < nt; t += 2) {
            const bool last = (t == nt - 2);
            const char* a1 = Ab + (size_t)(t + 1) * kstep;
            const char* a2 = last ? Ab : Ab + (size_t)(t + 2) * kstep; const char* b2 = last ? nB : cB + (size_t)(t + 2) * kstep;
            const char* a3 = a2 + kstep; const char* b3 = b2 + kstep;
            unsigned cv[2][2], s2[2][2];
            PG8_AOFF(cv, ctb); PG8_AOFF(s2, (last && has_next) ? (ctb ^ 1) : ctb);
            if (last && has_next) S.a_ready(nxt);
            PG8_LDB(B0, 0, 0); PG8_LDB(B1, 0, 1); PG8_SCHED; PG8_LDA(At, 0, 0); PG8_STAGE(PG8_SA(1, 1), a1, cv[1]);
            PG8_WAIT_V(8); PG8_WAIT_L(0); PG8_BAR; PG8_MMA(0, 0, At, B0); PG8_MMA(0, 1, At, B1); PG8_BAR; PG8_SCHED;
            PG8_LDA(At, 0, 1); PG8_STAGEB(PG8_SB(0, 0), b2); PG8_STAGEB(PG8_SB(0, 1), b2 + hstep); PG8_STAGE(PG8_SA(0, 0), a2, s2[0]);
            PG8_WAIT_V(8); PG8_WAIT_L(0); PG8_BAR; PG8_MMA(1, 0, At, B0); PG8_MMA(1, 1, At, B1); PG8_BAR; PG8_SCHED;
            PG8_LDB(B0, 1, 0); PG8_LDB(B1, 1, 1); PG8_SCHED; PG8_LDA(At, 1, 0); PG8_STAGE(PG8_SA(0, 1), a2, s2[1]);
            PG8_WAIT_V(8); PG8_WAIT_L(0); PG8_BAR; PG8_MMA(0, 0, At, B0); PG8_MMA(0, 1, At, B1); PG8_BAR; PG8_SCHED;
            PG8_LDA(At, 1, 1); PG8_STAGEB(PG8_SB(1, 0), b3); PG8_STAGEB(PG8_SB(1, 1), b3 + hstep); PG8_STAGE(PG8_SA(1, 0), a3, s2[0]);
            PG8_WAIT_V(8); PG8_WAIT_L(0); PG8_BAR; PG8_MMA(1, 0, At, B0); PG8_MMA(1, 1, At, B1); PG8_BAR; PG8_SCHED;
        }
        if constexpr (ALIGN_EPI) { if (wr == 0) PG8_BAR; }
        { const int ln = olane(); E(acc, cur, wr, wc, ln & 15, ln >> 4); } S.done(cur);
        if (!has_next) break;
#pragma unroll
        for (int a = 0; a < 2; ++a)
#pragma unroll
            for (int b = 0; b < 2; ++b)
#pragma unroll
                for (int m = 0; m < 4; ++m)
#pragma unroll
                    for (int n = 0; n < 2; ++n) acc[a][b][m][n] = (f32x4){0.f, 0.f, 0.f, 0.f};
        cur = nxt; cB = nB; ++ui; ctb ^= 1;
        if constexpr (ALIGN_EPI) { if (wr == 1) PG8_BAR; }
    }
    PG8_WAIT_V(0);
    if constexpr (!ALIGN_EPI) { if (wr == 0) PG8_BAR; }
    PG8_BAR;
#undef PG8_FILL
#undef tid
#undef PG8_SA
#undef PG8_SB
#undef PG8_STAGE
#undef PG8_STAGEB
#undef PG8_LDA
#undef PG8_LDB
#undef PG8_MMA
#undef PG8_WAIT_V
#undef PG8_WAIT_L
#undef PG8_BAR
#undef PG8_SCHED
#undef PG8_AOFF
}
}

struct Args { const float* in[36]; float* out; char* ws; };

constexpr size_t al256(size_t x) { return (x + 255) & ~(size_t)255; }
constexpr size_t MiB = (size_t)1 << 20;
constexpr size_t WS_CTL = 0;
constexpr size_t CTL_BYTES = 64 * 1024;
constexpr int CW_BAR = 0, CW_CNT = 8192, CW_CUR = 8192 + 64;
constexpr size_t WS_MOD = WS_CTL + CTL_BYTES;
constexpr size_t WS_TOPI = 512 * 1024;
constexpr size_t WS_TOPW = 1 * MiB;
constexpr size_t WS_ROWT = 1 * MiB + 512 * 1024;
constexpr size_t WS_DST = 2 * MiB + 512 * 1024;
constexpr size_t WS_SMALL = 3 * MiB + 256 * 1024;
constexpr size_t WS_WTR = 4 * MiB;
constexpr size_t WS_WTIN = 5 * MiB;
constexpr size_t WS_WTOUT = 17 * MiB;
constexpr size_t WS_WTUP = 21 * MiB;
constexpr size_t WS_WTDN = 86 * MiB;
constexpr size_t WS_HBF = 119 * MiB;
constexpr size_t WS_ARENA = 151 * MiB;
constexpr size_t WS_PROJ = WS_ARENA;
constexpr size_t WS_MIXB = WS_ARENA + 96 * MiB;
constexpr size_t WS_RW = WS_ARENA + 128 * MiB;
constexpr size_t WS_GU = WS_ARENA + 256 * MiB;
constexpr size_t WS_HBB = WS_ARENA;
constexpr size_t WS_YB = WS_ARENA + 81 * MiB;
constexpr size_t WS_YS = WS_ARENA + 232 * MiB;
constexpr size_t WS_LOGIT = WS_YB;
constexpr size_t WS_END = WS_ARENA + 369 * MiB;
static_assert(WS_MOD + (size_t)DEPTH * BATCH * 6 * D * 4 <= WS_TOPI && WS_DST + (size_t)P * 4 <= WS_WTIN && WS_WTUP + (size_t)65 * 512 * 1024 * 2 <= WS_WTDN && WS_WTDN + (size_t)65 * 1024 * 256 * 2 <= WS_HBF, "ws map");
static_assert(WS_HBB + (size_t)(P + T) * 256 * 2 <= WS_YB && WS_YB + (size_t)P * 1024 * 2 <= WS_END, "ws map (moe)");

__device__ __forceinline__ void transpose_item(const float* W, int K, int N, bf16* WT, int k0, int n0, int drow0, float* scr, int lane) {
#pragma unroll 8
    for (int i = 0; i < 32; ++i) { const int kk = 2 * i + (lane >> 5); scr[kk * 33 + (lane & 31)] = W[(size_t)(k0 + kk) * N + n0 + (lane & 31)]; }
    asm volatile("s_waitcnt lgkmcnt(0)" ::: "memory");
    const int c = lane & 7;
#pragma unroll
    for (int j = 0; j < 4; ++j) { const int n = (lane >> 3) + 8 * j; const float* sp = scr + (8 * c) * 33 + n;
        uint4 o; o.x = pk2(sp[0 * 33], sp[1 * 33]); o.y = pk2(sp[2 * 33], sp[3 * 33]); o.z = pk2(sp[4 * 33], sp[5 * 33]); o.w = pk2(sp[6 * 33], sp[7 * 33]);
        *(uint4*)(WT + (size_t)(drow0 + n) * K + k0 + 8 * c) = o; }
    asm volatile("s_waitcnt lgkmcnt(0)" ::: "memory");
}
struct ItemDesc { const float* W; int N; bf16* WT; int K, k0, n0, drow0; };
__device__ __forceinline__ void item_load(const ItemDesc& d, float (&v)[32], int lane) {
    const float* p = d.W + (size_t)(d.k0 + (lane >> 3)) * d.N + d.n0 + 4 * (lane & 7);
#pragma unroll
    for (int j = 0; j < 8; ++j) { const float4 t = *(const float4*)(p + (size_t)(8 * j) * d.N); v[4 * j] = t.x; v[4 * j + 1] = t.y; v[4 * j + 2] = t.z; v[4 * j + 3] = t.w; }
}
__device__ __forceinline__ void item_finish(const ItemDesc& d, const float (&v)[32], float* scr, int lane) {
#pragma unroll
    for (int j = 0; j < 8; ++j) { const int k = 8 * j + (lane >> 3), sw = (8 * ((k >> 3) & 3)) ^ (4 * ((k >> 5) & 1));
        *(float4*)(scr + k * 32 + ((4 * (lane & 7)) ^ sw)) = make_float4(v[4 * j], v[4 * j + 1], v[4 * j + 2], v[4 * j + 3]); }
    asm volatile("s_waitcnt lgkmcnt(0)" ::: "memory");
    const int c = lane & 7, swc = (8 * (c & 3)) ^ (4 * (c >> 2));
#pragma unroll
    for (int j = 0; j < 4; ++j) { const int n = (lane >> 3) + 8 * j; const float* sp = scr + (8 * c) * 32 + (n ^ swc);
        uint4 o; o.x = pk2(sp[0 * 32], sp[1 * 32]); o.y = pk2(sp[2 * 32], sp[3 * 32]); o.z = pk2(sp[4 * 32], sp[5 * 32]); o.w = pk2(sp[6 * 32], sp[7 * 32]);
        *(uint4*)(d.WT + (size_t)(d.drow0 + n) * d.K + d.k0 + 8 * c) = o; }
    asm volatile("s_waitcnt lgkmcnt(0)" ::: "memory");
}
__device__ __forceinline__ void transpose_matrix(const float* W, int K, int N, bf16* WT, float* lds) {
    const int tidx = otid(), bidx = obid(), gdim = ogdim();
    const int wave = tidx >> 6, lane = tidx & 63;
    float* scr = lds + wave * (64 * 33);
    const int nblk = N / 32, nitems = (K / 64) * nblk;
#pragma unroll 1
    for (int it = bidx * 8 + wave; it < nitems; it += gdim * 8) {
        const int kb = it / nblk, nb = it % nblk;
        transpose_item(W, K, N, WT, 64 * kb, 32 * nb, 32 * nb, scr, lane);
    }
}
template <int CTRL> __device__ __forceinline__ float dpp_add(float v) { return v + __int_as_float(__builtin_amdgcn_update_dpp(0, __float_as_int(v), CTRL, 0xF, 0xF, false)); }
__device__ __forceinline__ float wave_sum_fast(float v) {
    v = dpp_add<0xB1>(v); v = dpp_add<0x4E>(v); v = dpp_add<0x141>(v); v = dpp_add<0x140>(v);
    const int vi = __float_as_int(v);
    return (__int_as_float(__builtin_amdgcn_readlane(vi, 0)) + __int_as_float(__builtin_amdgcn_readlane(vi, 16))) + (__int_as_float(__builtin_amdgcn_readlane(vi, 32)) + __int_as_float(__builtin_amdgcn_readlane(vi, 48)));
}
typedef unsigned u32x4n __attribute__((ext_vector_type(4)));
typedef unsigned u32x2n __attribute__((ext_vector_type(2)));
__device__ __forceinline__ uint4 nt_load16(const void* p) { const u32x4n v = __builtin_nontemporal_load((const u32x4n*)p); return make_uint4(v.x, v.y, v.z, v.w); }
__device__ __forceinline__ uint2 nt_load8(const void* p) { const u32x2n v = __builtin_nontemporal_load((const u32x2n*)p); return make_uint2(v.x, v.y); }
__device__ __forceinline__ float sq4(const float4& a) { return a.x * a.x + a.y * a.y + a.z * a.z + a.w * a.w; }
template <bool HAS_Y, bool HAS_H>
__device__ __forceinline__ void row_phase(const float* xin, const bf16* y, const float* gy, const float* gate_base, float* xout,
                                          const float* gn, const float* mod_l, int sh_idx, int sc_idx, bf16* hb) {
    const int tidx = otid(), bidx = obid(), gdim = ogdim();
    const int lane = tidx & 63, wave = tidx >> 6;
    float4 gyv[4], gnv[4];
#pragma unroll
    for (int j = 0; j < 4; ++j) { if (HAS_Y) gyv[j] = ((const float4*)gy)[lane + 64 * j]; if (HAS_H) gnv[j] = ((const float4*)gn)[lane + 64 * j]; }
#pragma unroll 1
    for (int row0 = (bidx * 8 + wave) * 4; row0 < T; row0 += gdim * 32) {
        const int b = row0 / SEQ;
        const float* m = mod_l + (size_t)b * 6 * D;
        float4 v[4][4], yv[4][4], gt[4], sc[4], sh[4];
#pragma unroll
        for (int r = 0; r < 4; ++r)
#pragma unroll
            for (int j = 0; j < 4; ++j) {
                v[r][j] = ((const float4*)(xin + (size_t)(row0 + r) * D))[lane + 64 * j];
                if (HAS_Y) { const uint2 yb_ = nt_load8((const uint2*)(y + (size_t)(row0 + r) * D) + lane + 64 * j);
                    yv[r][j] = make_float4(__uint_as_float(yb_.x << 16), __uint_as_float(yb_.x & 0xffff0000u), __uint_as_float(yb_.y << 16), __uint_as_float(yb_.y & 0xffff0000u)); }
            }
#pragma unroll
        for (int j = 0; j < 4; ++j) {
            if (HAS_Y) gt[j] = ((const float4*)(gate_base + (size_t)b * 6 * D))[lane + 64 * j];
            if (HAS_H) { sc[j] = ((const float4*)(m + sc_idx * D))[lane + 64 * j]; sh[j] = ((const float4*)(m + sh_idx * D))[lane + 64 * j]; }
        }
#pragma unroll
        for (int r = 0; r < 4; ++r) {
            const int row = row0 + r;
            if (HAS_Y) {
                const float rs = rsqrtf(wave_sum_fast((sq4(yv[r][0]) + sq4(yv[r][1])) + (sq4(yv[r][2]) + sq4(yv[r][3]))) * (1.f / D) + 1e-6f);
#pragma unroll
                for (int j = 0; j < 4; ++j) {
                    v[r][j].x += gt[j].x * yv[r][j].x * rs * gyv[j].x; v[r][j].y += gt[j].y * yv[r][j].y * rs * gyv[j].y;
                    v[r][j].z += gt[j].z * yv[r][j].z * rs * gyv[j].z; v[r][j].w += gt[j].w * yv[r][j].w * rs * gyv[j].w;
                    ((float4*)(xout + (size_t)row * D))[lane + 64 * j] = v[r][j];
                }
            }
            if (HAS_H) {
                const float rs = rsqrtf(wave_sum_fast((sq4(v[r][0]) + sq4(v[r][1])) + (sq4(v[r][2]) + sq4(v[r][3]))) * (1.f / D) + 1e-6f);
#pragma unroll
                for (int j = 0; j < 4; ++j) {
                    float4 o;
                    o.x = v[r][j].x * rs * gnv[j].x * (1.f + sc[j].x) + sh[j].x; o.y = v[r][j].y * rs * gnv[j].y * (1.f + sc[j].y) + sh[j].y;
                    o.z = v[r][j].z * rs * gnv[j].z * (1.f + sc[j].z) + sh[j].z; o.w = v[r][j].w * rs * gnv[j].w * (1.f + sc[j].w) + sh[j].w;
                    ((uint2*)(hb + (size_t)row * D))[lane + 64 * j] = make_uint2(pk2(o.x, o.y), pk2(o.z, o.w));
                }
            }
        }
    }
}

__device__ __forceinline__ int t5_bucket(int n) {
    if (n < 16) return n;
    int large = 16 + (int)(logf((float)n / 16.f) / logf(8.f) * 16.f);
    return large < 31 ? large : 31;
}
constexpr int BT_OFF = LDS_BYTES - 6144;
typedef float f32x16 __attribute__((ext_vector_type(16)));
typedef short bf16x8_t __attribute__((ext_vector_type(8)));
typedef short s16x4_t __attribute__((ext_vector_type(4)));
__device__ __forceinline__ unsigned cvtpk(float lo, float hi) { unsigned r; asm volatile("v_cvt_pk_bf16_f32 %0, %1, %2" : "=v"(r) : "v"(lo), "v"(hi)); return r; }
#define ATT_C 0.18033688011112042f
template <bool NEAR>
__device__ __forceinline__ void att_scores(f32x16& x, const float* bt_h, int qrow, int kvb) {
#pragma unroll
    for (int r = 0; r < 16; ++r) {
        float v = x[r];
        if (NEAR) { const int dist = qrow - (kvb + (r & 3) + 8 * (r >> 2)); v += bt_h[dist < 0 ? 0 : (dist > 127 ? 127 : dist)]; if (dist < 0) v = -INFINITY; }
        x[r] = v;
    }
}
__device__ __forceinline__ void attn_phase(unsigned char* ldsb, const bf16* proj, const float* lam_par, const float* subln, float lambda_init, bf16* mix, int bidx, int gdim) {
    const int tidx = otid();
    const int wave = tidx >> 6, lane = tidx & 63, qg = wave >> 1, kh = wave & 1, lq = lane & 31, hi = lane >> 5;
    float l01 = lam_par[lane] * lam_par[64 + lane], l23 = lam_par[128 + lane] * lam_par[192 + lane];
    l01 = wave_sum(l01); l23 = wave_sum(l23);
    const float lam = __expf(l01) - __expf(l23) + lambda_init;
    float* stat = (float*)(ldsb + 65536);
    const int vtr = (4 * hi + ((lane & 15) >> 2)) * 64 + (16 * ((lane >> 4) & 1) + 4 * (lane & 3)) * 2;
#pragma unroll 1
    for (int u = bidx; u < BATCH * A_HEADS * 8; u += gdim) {
        const int b = u >> 5, h = (u >> 3) & 3, pi = u & 7;
        const float* bt_h = (const float*)(ldsb + BT_OFF) + h * 128;
#pragma unroll 1
        for (int half = 0; half < 2; ++half) {
            const int qb = half == 0 ? 15 - pi : pi, R0 = qb * 128, r0 = R0 + 32 * qg, ntile = 2 * qb + 2, qrow = r0 + lq;
            const char* kbase = (const char*)(proj + (size_t)(b * SEQ) * IN_COLS + A_WIDTH + h * 128);
            { const char* qb_ = (const char*)(proj + (size_t)(b * SEQ + r0) * IN_COLS + h * 128); const unsigned qo = (unsigned)(lq * IN_COLS + 8 * hi) * 2u;
#pragma unroll
              for (int m = 0; m < 2; ++m)
#pragma unroll
                  for (int s4 = 0; s4 < 4; ++s4) {
                      const uint4 qw = *(const uint4*)(qb_ + qo + (m * 64 + 16 * s4) * 2);
                      const unsigned qq[4] = {qw.x, qw.y, qw.z, qw.w}; union { unsigned u[4]; bf16x8_t v; } qs;
#pragma unroll
                      for (int w = 0; w < 4; ++w) qs.u[w] = cvtpk(__uint_as_float(qq[w] << 16) * ATT_C, __uint_as_float(qq[w] & 0xffff0000u) * ATT_C);
                      *(bf16x8_t*)(ldsb + 73728 + ((wave * 8 + m * 4 + s4) * 64 + lane) * 16) = qs.v; } }
            const int c0 = tidx, c1 = tidx + 512;
            const int sr0 = c0 >> 4, sc0 = c0 & 15, sr1 = c1 >> 4, sc1 = c1 & 15;
            const unsigned so0 = (unsigned)(sr0 * IN_COLS + sc0 * 8) * 2u, so1 = (unsigned)(sr1 * IN_COLS + sc1 * 8) * 2u;
            const int kdst0 = sr0 * 256 + ((sc0 ^ (sr0 & 15)) << 4), kdst1 = sr1 * 256 + ((sc1 ^ (sr1 & 15)) << 4);
#define VDST(sr, sc) ((((sc) >> 2) * 4096) + (((sr) >> 4) * 1024) + ((((sr) >> 3) & 1) * 512) + (((sr) & 7) * 64) + (((sc) & 3) * 16))
            const int vdst0 = VDST(sr0, sc0), vdst1 = VDST(sr1, sc1);
            float m1 = -1e30f, l1 = 0.f, m2 = -1e30f, l2 = 0.f, iv1 = 0.f, iv2 = 0.f;
            f32x16 o[4];
#pragma unroll
            for (int pass = 0; pass < 2; ++pass) {
                if (pass == 1) {
#pragma unroll
                    for (int e = 0; e < 4; ++e)
#pragma unroll
                        for (int r = 0; r < 16; ++r) o[e][r] = 0.f;
                }
                uint4 ka0, ka1, va0, va1, kb0, kb1, vb0, vb1;
                ka0 = *(const uint4*)(kbase + so0); ka1 = *(const uint4*)(kbase + so1);
                if (pass) { va0 = *(const uint4*)(kbase + 1024 + so0); va1 = *(const uint4*)(kbase + 1024 + so1); }
                { const char* kt = kbase + (size_t)64 * IN_COLS * 2;
                  kb0 = *(const uint4*)(kt + so0); kb1 = *(const uint4*)(kt + so1);
                  if (pass) { vb0 = *(const uint4*)(kt + 1024 + so0); vb1 = *(const uint4*)(kt + 1024 + so1); } }
                __syncthreads();
                *(uint4*)(ldsb + kdst0) = ka0; *(uint4*)(ldsb + kdst1) = ka1;
                if (pass) { *(uint4*)(ldsb + 16384 + vdst0) = va0; *(uint4*)(ldsb + 16384 + vdst1) = va1; }
                __syncthreads();
#define ATT_ITER(JJ, LK0, LK1, LV0, LV1, WK0, WK1, WV0, WV1) do { \
                    const int j = j0 + (JJ); \
                    unsigned char* buf = ldsb + (JJ) * 32768; \
                    unsigned char* nbuf = ldsb + ((JJ) ^ 1) * 32768; \
                    const bool more = j + 1 < ntile; \
                    if (j + 2 < ntile) { \
                        const char* kt = kbase + (size_t)(64 * (j + 2)) * IN_COLS * 2; \
                        LK0 = *(const uint4*)(kt + so0); LK1 = *(const uint4*)(kt + so1); \
                        if (pass) { LV0 = *(const uint4*)(kt + 1024 + so0); LV1 = *(const uint4*)(kt + 1024 + so1); } \
                    } \
                    const int kv0 = 64 * j + 32 * kh; \
                    if (kv0 <= r0 + 31) { \
                        f32x16 st1, st2; \
_Pragma("unroll") \
                        for (int r = 0; r < 16; ++r) { st1[r] = 0.f; st2[r] = 0.f; } \
                        const int krow = 32 * kh + lq; \
_Pragma("unroll") \
                        for (int s4 = 0; s4 < 4; ++s4) { \
                            const bf16x8_t a1 = *(const bf16x8_t*)(buf + krow * 256 + (((2 * s4 + hi) ^ (krow & 15)) << 4)); \
                            const bf16x8_t a2 = *(const bf16x8_t*)(buf + krow * 256 + (((8 + 2 * s4 + hi) ^ (krow & 15)) << 4)); \
                            const bf16x8_t q1 = *(const bf16x8_t*)(ldsb + 73728 + ((wave * 8 + s4) * 64 + lane) * 16), q2 = *(const bf16x8_t*)(ldsb + 73728 + ((wave * 8 + 4 + s4) * 64 + lane) * 16); \
                            st1 = __builtin_amdgcn_mfma_f32_32x32x16_bf16(a1, q1, st1, 0, 0, 0); \
                            st2 = __builtin_amdgcn_mfma_f32_32x32x16_bf16(a2, q2, st2, 0, 0, 0); \
                        } \
                        const int kvb = kv0 + 4 * hi; \
                        if (kv0 + 31 + 113 > r0) { att_scores<true>(st1, bt_h, qrow, kvb); att_scores<true>(st2, bt_h, qrow, kvb); } \
                        else { att_scores<false>(st1, bt_h, qrow, kvb); att_scores<false>(st2, bt_h, qrow, kvb); } \
                        if (pass == 0) { \
                            float t1 = st1[0], t2 = st2[0]; \
_Pragma("unroll") \
                            for (int r = 1; r < 16; ++r) { t1 = fmaxf(t1, st1[r]); t2 = fmaxf(t2, st2[r]); } \
                            const float n1 = fmaxf(m1, t1), n2 = fmaxf(m2, t2); \
                            float a1 = 0.f, a2 = 0.f; \
_Pragma("unroll") \
                            for (int r = 0; r < 16; ++r) { a1 += __builtin_amdgcn_exp2f(st1[r] - n1); a2 += __builtin_amdgcn_exp2f(st2[r] - n2); } \
                            l1 = l1 * __builtin_amdgcn_exp2f(m1 - n1) + a1; l2 = l2 * __builtin_amdgcn_exp2f(m2 - n2) + a2; m1 = n1; m2 = n2; \
                        } else { \
_Pragma("unroll") \
                            for (int r = 0; r < 16; ++r) st1[r] = __builtin_amdgcn_exp2f(st1[r] - m1) * iv1 - __builtin_amdgcn_exp2f(st2[r] - m2) * iv2; \
                            const unsigned char* vb = buf + 16384 + vtr + (2 * kh) * 1024; \
_Pragma("unroll") \
                            for (int s2 = 0; s2 < 2; ++s2) { \
                                union { unsigned u[4]; bf16x8_t v; } pa; \
_Pragma("unroll") \
                                for (int w = 0; w < 4; ++w) pa.u[w] = cvtpk(st1[8 * s2 + 2 * w], st1[8 * s2 + 2 * w + 1]); \
_Pragma("unroll") \
                                for (int e = 0; e < 4; ++e) { \
                                    const s16x4_t lo = __builtin_bit_cast(s16x4_t, __builtin_amdgcn_ds_read_tr16_b64_v4i16((__attribute__((address_space(3))) s16x4_t*)(unsigned)(uintptr_t)(vb + e * 4096 + s2 * 1024))); \
                                    const s16x4_t hh = __builtin_bit_cast(s16x4_t, __builtin_amdgcn_ds_read_tr16_b64_v4i16((__attribute__((address_space(3))) s16x4_t*)(unsigned)(uintptr_t)(vb + e * 4096 + s2 * 1024 + 512))); \
                                    const bf16x8_t bv = (bf16x8_t){lo[0], lo[1], lo[2], lo[3], hh[0], hh[1], hh[2], hh[3]}; \
                                    o[e] = __builtin_amdgcn_mfma_f32_32x32x16_bf16(pa.v, bv, o[e], 0, 0, 0); \
                                } \
                            } \
                        } \
                    } \
                    if (more) { \
                        *(uint4*)(nbuf + kdst0) = WK0; *(uint4*)(nbuf + kdst1) = WK1; \
                        if (pass) { *(uint4*)(nbuf + 16384 + vdst0) = WV0; *(uint4*)(nbuf + 16384 + vdst1) = WV1; } \
                    } \
                    __syncthreads(); \
                } while (0)
#pragma unroll 1
                for (int j0 = 0; j0 < ntile; j0 += 2) {
                    ATT_ITER(0, ka0, ka1, va0, va1, kb0, kb1, vb0, vb1);
                    ATT_ITER(1, kb0, kb1, vb0, vb1, ka0, ka1, va0, va1);
                }
#undef ATT_ITER

                if (pass == 0) {
                    float4* sp = (float4*)stat;
                    sp[wave * 64 + lane] = make_float4(m1, l1, m2, l2);
                    __syncthreads();
                    float M1 = -1e30f, M2 = -1e30f;
                    float4 pr[4];
#pragma unroll
                    for (int i = 0; i < 4; ++i) { pr[i] = sp[(2 * qg + (i >> 1)) * 64 + lq + 32 * (i & 1)]; M1 = fmaxf(M1, pr[i].x); M2 = fmaxf(M2, pr[i].z); }
                    float L1 = 0.f, L2 = 0.f;
#pragma unroll
                    for (int i = 0; i < 4; ++i) { L1 += pr[i].y * __builtin_amdgcn_exp2f(pr[i].x - M1); L2 += pr[i].w * __builtin_amdgcn_exp2f(pr[i].z - M2); }
                    m1 = M1; m2 = M2; iv1 = 1.f / L1; iv2 = lam / L2;
                }
            }
            __syncthreads();
            float* ox = (float*)ldsb;
            if (kh == 1) {
#pragma unroll
                for (int e = 0; e < 4; ++e)
#pragma unroll
                    for (int r = 0; r < 16; ++r) ox[((qg * 4 + e) * 16 + r) * 64 + lane] = o[e][r];
            }
            __syncthreads();
            if (kh == 0) {
                float ss[16];
#pragma unroll
                for (int r = 0; r < 16; ++r) ss[r] = 0.f;
#pragma unroll
                for (int e = 0; e < 4; ++e)
#pragma unroll
                    for (int r = 0; r < 16; ++r) { o[e][r] += ox[((qg * 4 + e) * 16 + r) * 64 + lane]; ss[r] += o[e][r] * o[e][r]; }
                const int ln = olane(), lq2 = ln & 31, hi2 = ln >> 5;
                char* mb_ = (char*)(mix + (size_t)(b * SEQ + r0) * D + h * 128);
#pragma unroll
                for (int r = 0; r < 16; ++r) {
#pragma unroll
                    for (int of = 1; of < 32; of <<= 1) ss[r] += shfl_idx(ss[r], ln ^ of);
                    ss[r] = rsqrtf(ss[r] * (1.f / 128.f) + 1e-6f) * (1.f - lambda_init);
                }
#pragma unroll
                for (int e = 0; e < 4; ++e) {
                    const float g = subln[e * 32 + lq2];
#pragma unroll
                    for (int r = 0; r < 16; ++r) {
                        const unsigned q = (unsigned)((r & 3) + 8 * (r >> 2) + 4 * hi2);
                        *(bf16*)(mb_ + (q * D + e * 32 + lq2) * 2u) = (bf16)f2bf(o[e][r] * ss[r] * g);
                    }
                }
            }
        }
    }
#undef VDST
}

__device__ __forceinline__ void attn_flash(unsigned char* ldsb, const bf16* proj, const float* lam_par, const float* subln, float lambda_init, bf16* mix, int bidx, int gdim) {
    const int wave = owave(), qg = wave >> 1, kh = wave & 1;
    float* stat = (float*)(ldsb + 65536);
    float* asc = (float*)(ldsb + 69632) + wave * 64;
    float* ftab = (float*)(ldsb + 71680) + wave * 64;
#pragma unroll 1
    for (int u = bidx; u < BATCH * A_HEADS * 8; u += gdim) {
        const int b = u >> 5, h = (u >> 3) & 3, pi = u & 7;
        const float* bt_h = (const float*)(ldsb + BT_OFF) + h * 128;
#pragma unroll 1
        for (int half = 0; half < 2; ++half) {
            const int lane = olane(), lq = lane & 31, hi = lane >> 5;
            const int vtr = (4 * hi + ((lane & 15) >> 2)) * 64 + (16 * ((lane >> 4) & 1) + 4 * (lane & 3)) * 2;
            const int qb = half == 0 ? 15 - pi : pi, R0 = qb * 128, r0 = R0 + 32 * qg, ntile = 2 * qb + 2, qrow = r0 + lq;
            const char* kbase = (const char*)(proj + (size_t)(b * SEQ) * IN_COLS + A_WIDTH + h * 128);
            { const char* qb_ = (const char*)(proj + (size_t)(b * SEQ + r0) * IN_COLS + h * 128); const unsigned qo = (unsigned)(lq * IN_COLS + 8 * hi) * 2u;
#pragma unroll
              for (int m = 0; m < 2; ++m)
#pragma unroll
                  for (int s4 = 0; s4 < 4; ++s4) {
                      const uint4 qw = *(const uint4*)(qb_ + qo + (m * 64 + 16 * s4) * 2);
                      const unsigned qq[4] = {qw.x, qw.y, qw.z, qw.w}; union { unsigned u[4]; bf16x8_t v; } qs;
#pragma unroll
                      for (int w = 0; w < 4; ++w) qs.u[w] = cvtpk(__uint_as_float(qq[w] << 16) * ATT_C, __uint_as_float(qq[w] & 0xffff0000u) * ATT_C);
                      *(bf16x8_t*)(ldsb + 73728 + ((wave * 8 + m * 4 + s4) * 64 + lane) * 16) = qs.v; } }
            unsigned ksrc[2], vsrc[2];
#pragma unroll
            for (int i = 0; i < 2; ++i) {
                const int p = wave * 64 + i * 512 + lane, row = p >> 4, c = (p & 15) ^ (row & 15);
                ksrc[i] = (unsigned)(row * IN_COLS * 2 + c * 16);
                const int o = p * 16, eb = o >> 12, ks = (o >> 10) & 3, sub = (o >> 9) & 1, r8 = (o >> 6) & 7, c16 = (o >> 4) & 3, kv = ks * 16 + sub * 8 + r8, sc = eb * 4 + c16;
                vsrc[i] = (unsigned)(kv * IN_COLS * 2 + 1024 + sc * 16);
            }
#define ATT_DMA(kt, bufp) do { _Pragma("unroll") for (int i_ = 0; i_ < 2; ++i_) { \
                __builtin_amdgcn_global_load_lds((const unsigned*)((kt) + ksrc[i_]), (__attribute__((address_space(3))) unsigned*)(unsigned)(uintptr_t)((bufp) + (wave * 64 + i_ * 512) * 16), 16, 0, 0); \
                __builtin_amdgcn_global_load_lds((const unsigned*)((kt) + vsrc[i_]), (__attribute__((address_space(3))) unsigned*)(unsigned)(uintptr_t)((bufp) + 16384 + (wave * 64 + i_ * 512) * 16), 16, 0, 0); } } while (0)
            float m1 = -1e30f, l1 = 0.f, m2 = -1e30f, l2 = 0.f;
            f32x16 o1[4], o2[4];
#pragma unroll
            for (int e = 0; e < 4; ++e)
#pragma unroll
                for (int r = 0; r < 16; ++r) { o1[e][r] = 0.f; o2[e][r] = 0.f; }
            __syncthreads();
            ATT_DMA(kbase, ldsb);
            asm volatile("s_waitcnt vmcnt(0)" ::: "memory");
            __syncthreads();
#pragma unroll 1
            for (int j = 0; j < ntile; ++j) {
                unsigned char* buf = ldsb + (j & 1) * 32768;
                unsigned char* nbuf = ldsb + ((j + 1) & 1) * 32768;
                const bool more = j + 1 < ntile;
                if (more) ATT_DMA(kbase + (size_t)(64 * (j + 1)) * IN_COLS * 2, nbuf);
                const int kv0 = 64 * j + 32 * kh;
                if (kv0 <= r0 + 31) {
                    f32x16 st1, st2;
#pragma unroll
                    for (int r = 0; r < 16; ++r) { st1[r] = 0.f; st2[r] = 0.f; }
                    const int krow = 32 * kh + lq;
#pragma unroll
                    for (int s4 = 0; s4 < 4; ++s4) {
                        const bf16x8_t a1 = *(const bf16x8_t*)(buf + krow * 256 + (((2 * s4 + hi) ^ (krow & 15)) << 4));
                        const bf16x8_t a2 = *(const bf16x8_t*)(buf + krow * 256 + (((8 + 2 * s4 + hi) ^ (krow & 15)) << 4));
                        const bf16x8_t q1 = *(const bf16x8_t*)(ldsb + 73728 + ((wave * 8 + s4) * 64 + lane) * 16), q2 = *(const bf16x8_t*)(ldsb + 73728 + ((wave * 8 + 4 + s4) * 64 + lane) * 16);
                        st1 = __builtin_amdgcn_mfma_f32_32x32x16_bf16(a1, q1, st1, 0, 0, 0);
                        st2 = __builtin_amdgcn_mfma_f32_32x32x16_bf16(a2, q2, st2, 0, 0, 0);
                    }
                    const int kvb = kv0 + 4 * hi;
                    if (kv0 + 31 + 113 > r0) { att_scores<true>(st1, bt_h, qrow, kvb); att_scores<true>(st2, bt_h, qrow, kvb); }
                    else { att_scores<false>(st1, bt_h, qrow, kvb); att_scores<false>(st2, bt_h, qrow, kvb); }
                    float t1 = st1[0], t2 = st2[0];
#pragma unroll
                    for (int r = 1; r < 16; ++r) { t1 = fmaxf(t1, st1[r]); t2 = fmaxf(t2, st2[r]); }
                    { const auto ra = __builtin_amdgcn_permlane32_swap(__float_as_uint(t1), __float_as_uint(t1), false, false); t1 = fmaxf(__uint_as_float(ra[0]), __uint_as_float(ra[1]));
                      const auto rb = __builtin_amdgcn_permlane32_swap(__float_as_uint(t2), __float_as_uint(t2), false, false); t2 = fmaxf(__uint_as_float(rb[0]), __uint_as_float(rb[1])); }
                    if (__builtin_amdgcn_ballot_w64(t1 > m1 + 8.f || t2 > m2 + 8.f) != 0ull) {
                        const float n1 = fmaxf(m1, t1), n2 = fmaxf(m2, t2);
                        const float a1 = __builtin_amdgcn_exp2f(m1 - n1), a2 = __builtin_amdgcn_exp2f(m2 - n2);
                        l1 *= a1; l2 *= a2; m1 = n1; m2 = n2;
                        if (hi == 0) { asc[lq] = a1; asc[32 + lq] = a2; }
                        asm volatile("s_waitcnt lgkmcnt(0)" ::: "memory");
#pragma unroll
                        for (int g = 0; g < 4; ++g) {
                            const float4 f1 = *(const float4*)(asc + 8 * g + 4 * hi), f2 = *(const float4*)(asc + 32 + 8 * g + 4 * hi);
#pragma unroll
                            for (int e = 0; e < 4; ++e) {
                                o1[e][4 * g] *= f1.x; o1[e][4 * g + 1] *= f1.y; o1[e][4 * g + 2] *= f1.z; o1[e][4 * g + 3] *= f1.w;
                                o2[e][4 * g] *= f2.x; o2[e][4 * g + 1] *= f2.y; o2[e][4 * g + 2] *= f2.z; o2[e][4 * g + 3] *= f2.w;
                            }
                        }
                        asm volatile("s_waitcnt lgkmcnt(0)" ::: "memory");
                    }
                    float s1 = 0.f, s2 = 0.f;
#pragma unroll
                    for (int r = 0; r < 16; ++r) { st1[r] = __builtin_amdgcn_exp2f(st1[r] - m1); s1 += st1[r]; st2[r] = __builtin_amdgcn_exp2f(st2[r] - m2); s2 += st2[r]; }
                    l1 += s1; l2 += s2;
                    const unsigned char* vb = buf + 16384 + vtr + (2 * kh) * 1024;
#pragma unroll
                    for (int s2i = 0; s2i < 2; ++s2i) {
                        union { unsigned u[4]; bf16x8_t v; } pa, pb;
#pragma unroll
                        for (int w = 0; w < 4; ++w) { pa.u[w] = cvtpk(st1[8 * s2i + 2 * w], st1[8 * s2i + 2 * w + 1]); pb.u[w] = cvtpk(st2[8 * s2i + 2 * w], st2[8 * s2i + 2 * w + 1]); }
#pragma unroll
                        for (int e = 0; e < 4; ++e) {
                            const s16x4_t lo = __builtin_bit_cast(s16x4_t, __builtin_amdgcn_ds_read_tr16_b64_v4i16((__attribute__((address_space(3))) s16x4_t*)(unsigned)(uintptr_t)(vb + e * 4096 + s2i * 1024)));
                            const s16x4_t hh = __builtin_bit_cast(s16x4_t, __builtin_amdgcn_ds_read_tr16_b64_v4i16((__attribute__((address_space(3))) s16x4_t*)(unsigned)(uintptr_t)(vb + e * 4096 + s2i * 1024 + 512)));
                            const bf16x8_t bv = (bf16x8_t){lo[0], lo[1], lo[2], lo[3], hh[0], hh[1], hh[2], hh[3]};
                            o1[e] = __builtin_amdgcn_mfma_f32_32x32x16_bf16(pa.v, bv, o1[e], 0, 0, 0);
                            o2[e] = __builtin_amdgcn_mfma_f32_32x32x16_bf16(pb.v, bv, o2[e], 0, 0, 0);
                        }
                    }
                }
                asm volatile("s_waitcnt vmcnt(0)" ::: "memory");
                __syncthreads();
            }
            { const auto ra = __builtin_amdgcn_permlane32_swap(__float_as_uint(l1), __float_as_uint(l1), false, false); l1 = __uint_as_float(ra[0]) + __uint_as_float(ra[1]);
              const auto rb = __builtin_amdgcn_permlane32_swap(__float_as_uint(l2), __float_as_uint(l2), false, false); l2 = __uint_as_float(rb[0]) + __uint_as_float(rb[1]); }
            if (hi == 0) ((float4*)stat)[wave * 32 + lq] = make_float4(m1, l1, m2, l2);
            __syncthreads();
            float lam;
            { float l01 = lam_par[lane] * lam_par[64 + lane], l23 = lam_par[128 + lane] * lam_par[192 + lane];
              l01 = wave_sum_fast(l01); l23 = wave_sum_fast(l23); lam = __expf(l01) - __expf(l23) + lambda_init; }
            if (hi == 0) {
                const float4 pb = ((const float4*)stat)[(wave ^ 1) * 32 + lq];
                const float M1 = fmaxf(m1, pb.x), M2 = fmaxf(m2, pb.z);
                const float e1 = __builtin_amdgcn_exp2f(m1 - M1), e2 = __builtin_amdgcn_exp2f(m2 - M2);
                const float L1 = l1 * e1 + pb.y * __builtin_amdgcn_exp2f(pb.x - M1), L2 = l2 * e2 + pb.w * __builtin_amdgcn_exp2f(pb.z - M2);
                ftab[lq] = e1 / L1; ftab[32 + lq] = -lam * e2 / L2;
            }
            asm volatile("s_waitcnt lgkmcnt(0)" ::: "memory");
#pragma unroll
            for (int g = 0; g < 4; ++g) {
                const float4 f1 = *(const float4*)(ftab + 8 * g + 4 * hi), f2 = *(const float4*)(ftab + 32 + 8 * g + 4 * hi);
#pragma unroll
                for (int e = 0; e < 4; ++e) {
                    o1[e][4 * g] = o1[e][4 * g] * f1.x + o2[e][4 * g] * f2.x; o1[e][4 * g + 1] = o1[e][4 * g + 1] * f1.y + o2[e][4 * g + 1] * f2.y;
                    o1[e][4 * g + 2] = o1[e][4 * g + 2] * f1.z + o2[e][4 * g + 2] * f2.z; o1[e][4 * g + 3] = o1[e][4 * g + 3] * f1.w + o2[e][4 * g + 3] * f2.w;
                }
            }
            __syncthreads();
            float* ox = (float*)ldsb;
            if (kh == 1) {
#pragma unroll
                for (int e = 0; e < 4; ++e)
#pragma unroll
                    for (int r = 0; r < 16; ++r) ox[((qg * 4 + e) * 16 + r) * 64 + lane] = o1[e][r];
            }
            __syncthreads();
            if (kh == 0) {
                float ss[16];
#pragma unroll
                for (int r = 0; r < 16; ++r) ss[r] = 0.f;
#pragma unroll
                for (int e = 0; e < 4; ++e)
#pragma unroll
                    for (int r = 0; r < 16; ++r) { o1[e][r] += ox[((qg * 4 + e) * 16 + r) * 64 + lane]; ss[r] += o1[e][r] * o1[e][r]; }
                const int ln = olane(), lq2 = ln & 31, hi2 = ln >> 5;
                char* mb_ = (char*)(mix + (size_t)(b * SEQ + r0) * D + h * 128);
#pragma unroll
                for (int r = 0; r < 16; ++r) {
#pragma unroll
                    for (int of = 1; of < 32; of <<= 1) ss[r] += shfl_idx(ss[r], ln ^ of);
                    ss[r] = rsqrtf(ss[r] * (1.f / 128.f) + 1e-6f) * (1.f - lambda_init);
                }
#pragma unroll
                for (int e = 0; e < 4; ++e) {
                    const float g = subln[e * 32 + lq2];
#pragma unroll
                    for (int r = 0; r < 16; ++r) {
                        const unsigned q = (unsigned)((r & 3) + 8 * (r >> 2) + 4 * hi2);
                        *(bf16*)(mb_ + (q * D + e * 32 + lq2) * 2u) = (bf16)f2bf(o1[e][r] * ss[r] * g);
                    }
                }
            }
        }
    }
#undef ATT_DMA
#undef VDST
}

typedef float f32x4_t __attribute__((ext_vector_type(4)));
constexpr int PL_STRIDE = 1536 + 16, AL_STRIDE = 512 + 16;
constexpr int PREP_PL = 0, PREP_AL = 64 * PL_STRIDE, PREP_KS = PREP_AL + 64 * AL_STRIDE;
__device__ __forceinline__ void rwkv_prep_phase(unsigned char* ldsb, const bf16* proj, const float* mu, const float* w0, const bf16* w2T, const float* a0, const bf16* a2T, const bf16* g2T,
                                                const float* k_k, const float* k_a, float* RW) {
    const int tidx = otid(), bidx = obid(), gdim = ogdim();
    const int wave = tidx >> 6, lane = tidx & 63, fr = lane & 15, fq = lane >> 4;
    constexpr size_t AS = (size_t)T * 256;
#pragma unroll 1
    for (int u = bidx; u < T / 64; u += gdim) {
        const int t0 = u * 64;
        __syncthreads();
#pragma unroll 2
        for (int i = 0; i < 16; ++i) {
            const int id = tidx + 512 * i, tok = id >> 7, cc = id & 127, c = cc * 8, t = t0 + tok;
            const bf16* src = proj + (size_t)t * IN_COLS + A_COLS + c;
            const uint4 cu = *(const uint4*)src;
            uint4 pv = make_uint4(0u, 0u, 0u, 0u);
            if ((t & (SEQ - 1)) != 0) pv = *(const uint4*)(src - IN_COLS);
            const float4 m0 = *(const float4*)(mu + c), m1 = *(const float4*)(mu + c + 4);
            const unsigned cw[4] = {cu.x, cu.y, cu.z, cu.w}, pw[4] = {pv.x, pv.y, pv.z, pv.w};
            const float mm[8] = {m0.x, m0.y, m0.z, m0.w, m1.x, m1.y, m1.z, m1.w};
            float p[8];
#pragma unroll
            for (int j = 0; j < 4; ++j) {
                const float c0 = __uint_as_float(cw[j] << 16), c1 = __uint_as_float(cw[j] & 0xffff0000u), p0 = __uint_as_float(pw[j] << 16), p1 = __uint_as_float(pw[j] & 0xffff0000u);
                p[2 * j] = c0 + (p0 - c0) * mm[2 * j]; p[2 * j + 1] = c1 + (p1 - c1) * mm[2 * j + 1];
            }
            unsigned char* dst;
            if (c < 768) dst = ldsb + PREP_PL + tok * PL_STRIDE + c * 2;
            else {
                dst = ldsb + PREP_AL + tok * AL_STRIDE + (c - 768) * 2;
                if (c < 832) {
#pragma unroll
                    for (int j = 0; j < 8; ++j) { const float e2 = __expf(2.f * p[j]); p[j] = 1.f - 2.f / (e2 + 1.f); }
                } else if (c >= 896) {
#pragma unroll
                    for (int j = 0; j < 8; ++j) p[j] = 1.f / (1.f + __expf(-p[j]));
                }
            }
            *(uint4*)dst = make_uint4(pk2(p[0], p[1]), pk2(p[2], p[3]), pk2(p[4], p[5]), pk2(p[6], p[7]));
        }
        __syncthreads();
        if (tidx < 256) {
            const int tok = tidx >> 2, hd = tidx & 3;
            const unsigned char* kp = ldsb + PREP_PL + tok * PL_STRIDE + (256 + hd * 64) * 2;
            float ss = 0.f;
#pragma unroll 4
            for (int j = 0; j < 64; j += 2) { const unsigned w = *(const unsigned*)(kp + j * 2); const float2 kk2 = *(const float2*)(k_k + hd * 64 + j);
                const float x0 = __uint_as_float(w << 16) * kk2.x, x1 = __uint_as_float(w & 0xffff0000u) * kk2.y; ss += x0 * x0 + x1 * x1; }
            ((float*)(ldsb + PREP_KS))[tok * 4 + hd] = ss;
        }
        __syncthreads();
        const int n0 = wave * 32, hd = wave >> 1;
        bf16x8_t bw[2][2], ba[2][2], bg[2][4];
#pragma unroll
        for (int ct = 0; ct < 2; ++ct) {
            const int n = n0 + 16 * ct + fr;
#pragma unroll
            for (int ks = 0; ks < 2; ++ks) { bw[ct][ks] = *(const bf16x8_t*)(w2T + n * 64 + 32 * ks + 8 * fq); ba[ct][ks] = *(const bf16x8_t*)(a2T + n * 64 + 32 * ks + 8 * fq); }
#pragma unroll
            for (int ks = 0; ks < 4; ++ks) bg[ct][ks] = *(const bf16x8_t*)(g2T + n * 128 + 32 * ks + 8 * fq);
        }
#pragma unroll 1
        for (int rt = 0; rt < 4; ++rt) {
            const unsigned char* ar = ldsb + PREP_AL + (16 * rt + fr) * AL_STRIDE + 16 * fq;
            bf16x8_t af[8];
#pragma unroll
            for (int ks = 0; ks < 8; ++ks) af[ks] = *(const bf16x8_t*)(ar + 64 * ks);
#pragma unroll
            for (int ct = 0; ct < 2; ++ct) {
                f32x4_t cw_ = {0.f, 0.f, 0.f, 0.f}, ca_ = {0.f, 0.f, 0.f, 0.f}, cg_ = {0.f, 0.f, 0.f, 0.f};
#pragma unroll
                for (int ks = 0; ks < 2; ++ks) { cw_ = __builtin_amdgcn_mfma_f32_16x16x32_bf16(af[ks], bw[ct][ks], cw_, 0, 0, 0); ca_ = __builtin_amdgcn_mfma_f32_16x16x32_bf16(af[2 + ks], ba[ct][ks], ca_, 0, 0, 0); }
#pragma unroll
                for (int ks = 0; ks < 4; ++ks) cg_ = __builtin_amdgcn_mfma_f32_16x16x32_bf16(af[4 + ks], bg[ct][ks], cg_, 0, 0, 0);
                const int ch = n0 + 16 * ct + fr;
                const float w0c = w0[ch], a0c = a0[ch], kkc = k_k[ch], kac = k_a[ch];
#pragma unroll
                for (int rg = 0; rg < 4; ++rg) {
                    const int tok = 16 * rt + 4 * fq + rg;
                    const unsigned char* pr = ldsb + PREP_PL + tok * PL_STRIDE + ch * 2;
                    const float r = bf2f(*(const bf16*)pr), k = bf2f(*(const bf16*)(pr + 512)), v = bf2f(*(const bf16*)(pr + 1024));
                    const float zw = w0c + cw_[rg];
                    const float sp = (-zw > 20.f) ? -zw : __logf(1.f + __expf(-zw));
                    const float decay = __expf(-__expf(-sp - 0.5f));
                    const float a = 1.f / (1.f + __expf(-(a0c + ca_[rg])));
                    const float ss = ((const float*)(ldsb + PREP_KS))[tok * 4 + hd];
                    const float kk = k * kkc * rsqrtf(fmaxf(ss, 1e-24f));
                    float* o = RW + (size_t)(t0 + tok) * 256 + ch;
                    o[0] = r; o[AS] = decay; o[2 * AS] = k * (1.f + (a - 1.f) * kac); o[3 * AS] = v; o[4 * AS] = -kk; o[5 * AS] = kk * a; o[6 * AS] = cg_[rg];
                }
            }
        }
    }
}


template <int CTRL> __device__ __forceinline__ float dpp_f(float v) { return __int_as_float(__builtin_amdgcn_update_dpp(0, __float_as_int(v), CTRL, 0xF, 0xF, false)); }
constexpr int VT_STRIDE = 256 + 16;
__device__ __forceinline__ float gelu_fast(float x) { const float u = 1.5957691216057308f * (x + 0.044715f * x * x * x); return x / (1.f + __expf(-u)); }
__device__ __forceinline__ void gmlp_phase(unsigned char* ldsb, const bf16* proj, const float* ln_g, const float* ln_b, const bf16* wsb, const float* b_s, bf16* mix, int bidx, int gdim) {
    const int tidx = otid();
    const int wave = tidx >> 6, lane = tidx & 63, fr = lane & 15, fq = lane >> 4;
#pragma unroll 1
    for (int u = bidx; u < T / CHUNK; u += gdim) {
        const int t0 = u * CHUNK;
        __syncthreads();
        {
            const int tok = tidx >> 2, qd = tidx & 3;
            const bf16* pv = proj + (size_t)(t0 + tok) * IN_COLS + A_COLS + B_COLS + 256 + qd * 64;
            float s1 = 0.f, s2 = 0.f;
#pragma unroll 2
            for (int j = 0; j < 8; ++j) {
                const uint4 w = *(const uint4*)(pv + 8 * j);
                const unsigned ww[4] = {w.x, w.y, w.z, w.w};
#pragma unroll
                for (int i = 0; i < 4; ++i) { const float g0 = gelu_fast(__uint_as_float(ww[i] << 16)), g1 = gelu_fast(__uint_as_float(ww[i] & 0xffff0000u)); s1 += g0 + g1; s2 += g0 * g0 + g1 * g1; }
            }
            s1 += dpp_f<0xB1>(s1); s1 += dpp_f<0x4E>(s1); s2 += dpp_f<0xB1>(s2); s2 += dpp_f<0x4E>(s2);
            const float mean = s1 * (1.f / 256.f), var = fmaxf(s2 * (1.f / 256.f) - mean * mean, 0.f), rstd = rsqrtf(var + 1e-5f);
#pragma unroll 2
            for (int j = 0; j < 8; ++j) {
                const uint4 w = *(const uint4*)(pv + 8 * j);
                const unsigned ww[4] = {w.x, w.y, w.z, w.w};
#pragma unroll
                for (int i = 0; i < 4; ++i) {
                    const int ch = qd * 64 + 8 * j + 2 * i;
                    const float g0 = gelu_fast(__uint_as_float(ww[i] << 16)), g1 = gelu_fast(__uint_as_float(ww[i] & 0xffff0000u));
                    *(bf16*)(ldsb + ch * VT_STRIDE + tok * 2) = (bf16)f2bf((g0 - mean) * rstd * ln_g[ch] + ln_b[ch]);
                    *(bf16*)(ldsb + (ch + 1) * VT_STRIDE + tok * 2) = (bf16)f2bf((g1 - mean) * rstd * ln_g[ch + 1] + ln_b[ch + 1]);
                }
            }
        }
        __syncthreads();
        const int rt = wave, nks = (16 * rt + 15) / 32 + 1;
#pragma unroll 1
        for (int g = 0; g < 4; ++g) {
            bf16x8_t af[4];
#pragma unroll
            for (int ks = 0; ks < 4; ++ks) if (ks < nks) af[ks] = *(const bf16x8_t*)(wsb + ((size_t)g * CHUNK + 16 * rt + fr) * CHUNK + 32 * ks + 8 * fq);
            float bs[4];
#pragma unroll
            for (int rg = 0; rg < 4; ++rg) bs[rg] = b_s[g * CHUNK + 16 * rt + 4 * fq + rg];
#pragma unroll
            for (int ct = 0; ct < 4; ++ct) {
                const int ch = g * 64 + 16 * ct + fr;
                f32x4_t acc = {0.f, 0.f, 0.f, 0.f};
#pragma unroll
                for (int ks = 0; ks < 4; ++ks) if (ks < nks) {
                    const bf16x8_t bv = *(const bf16x8_t*)(ldsb + ch * VT_STRIDE + (32 * ks + 8 * fq) * 2);
                    acc = __builtin_amdgcn_mfma_f32_16x16x32_bf16(af[ks], bv, acc, 0, 0, 0);
                }
#pragma unroll
                for (int rg = 0; rg < 4; ++rg) {
                    const int t = t0 + 16 * rt + 4 * fq + rg;
                    const float uu = gelu_fast(bf2f(proj[(size_t)t * IN_COLS + A_COLS + B_COLS + ch]));
                    mix[(size_t)t * D + A_WIDTH + B_WIDTH + ch] = (bf16)f2bf(uu * (acc[rg] + bs[rg]));
                }
            }
        }
    }
}

__device__ __forceinline__ float red16(float v) { v += dpp_f<0xB1>(v); v += dpp_f<0x4E>(v); v += dpp_f<0x141>(v); v += dpp_f<0x140>(v); return v; }
struct ExpW { const float *w1, *w3, *w2, *s1, *s3, *s2; bf16 *WTUP, *WTDN; };
constexpr int CONV_ITEMS = 65 * 384, NCK_CONV = 22, CONV_SCAN = 128 * NCK_CONV * 4;
__device__ __forceinline__ ItemDesc expert_item(const ExpW& X, int it) {
    const int e = it / 384, r = it % 384, which = r >> 7, q = r & 127;
    ItemDesc d;
    if (which < 2) { d.W = which == 0 ? (e < 64 ? X.w1 + (size_t)e * D * DE : X.s1) : (e < 64 ? X.w3 + (size_t)e * D * DE : X.s3);
        const int kb = q >> 3, nb = q & 7, n0 = 32 * nb; d.N = DE; d.WT = X.WTUP + (size_t)e * 512 * D; d.K = D; d.k0 = 64 * kb; d.n0 = n0; d.drow0 = (n0 >> 7) * 256 + which * 128 + (n0 & 127); }
    else { d.W = e < 64 ? X.w2 + (size_t)e * DE * D : X.s2; const int kb = q >> 5, nb = q & 31; d.N = D; d.WT = X.WTDN + (size_t)e * D * DE; d.K = DE; d.k0 = 64 * kb; d.n0 = 32 * nb; d.drow0 = 32 * nb; }
    return d;
}
__device__ __forceinline__ void convert_item(const ExpW& X, int it, float* scr, int lane) {
    const int e = it / 384, r = it % 384, which = r >> 7, q = r & 127;
    if (which < 2) {
        const float* W = which == 0 ? (e < 64 ? X.w1 + (size_t)e * D * DE : X.s1) : (e < 64 ? X.w3 + (size_t)e * D * DE : X.s3);
        const int kb = q >> 3, nb = q & 7, n0 = 32 * nb;
        transpose_item(W, D, DE, X.WTUP + (size_t)e * 512 * D, 64 * kb, n0, (n0 >> 7) * 256 + which * 128 + (n0 & 127), scr, lane);
    } else {
        const float* W = e < 64 ? X.w2 + (size_t)e * DE * D : X.s2;
        const int kb = q >> 5, nb = q & 31;
        transpose_item(W, DE, D, X.WTDN + (size_t)e * D * DE, 64 * kb, 32 * nb, 32 * nb, scr, lane);
    }
}
typedef float f32x2_t __attribute__((ext_vector_type(2)));
__device__ __forceinline__ void rwkv_scan_phase(unsigned char* ldsb, float* RW, int bidx, int gdim, const ExpW& X) {
    const int tidx = otid();
    const int wave = tidx >> 6, lane = tidx & 63, c = lane >> 4, s = lane & 15;
    constexpr int CH = 32, ARRB = CH * 256, BUFB = 6 * ARRB, YOFF = 2 * BUFB;
    const int sstep = tidx >> 4, sq = tidx & 15;
#pragma unroll 1
    for (int u = bidx; u < BATCH * 4 * 4; u += gdim) {
        const int b = u >> 4, h = (u >> 2) & 3, q4 = u & 3, lrow = (wave & 3) * 4 + c, row = q4 * 16 + lrow;
        float* Yg = RW + (size_t)T * 256 * 7 + (size_t)(b * SEQ + sstep) * 256 + h * 64 + q4 * 16 + sq;
        const float* g0 = RW + (size_t)(b * SEQ + sstep) * 256 + h * 64 + sq * 4;
        constexpr size_t AS = (size_t)T * 256;
#define SCAN_LOAD(ckk) do { const float* g_ = g0 + (size_t)(ckk) * CH * 256; pf0 = *(const float4*)(g_ + 4 * AS); pf1 = *(const float4*)(g_ + 5 * AS); pf2 = *(const float4*)(g_ + 1 * AS); \
        pf3 = *(const float4*)(g_ + 2 * AS); pf4 = *(const float4*)(g_); pf5 = *(const float4*)(g_ + 3 * AS); } while (0)
#define SCAN_STORE(bufp) do { unsigned char* d_ = (bufp) + sstep * 256 + sq * 16; *(float4*)(d_) = pf0; *(float4*)(d_ + ARRB) = pf1; *(float4*)(d_ + 2 * ARRB) = pf2; \
        *(float4*)(d_ + 3 * ARRB) = pf3; *(float4*)(d_ + 4 * ARRB) = pf4; *(float4*)(d_ + 5 * ARRB) = pf5; } while (0)
#define SCAN_LOAD_TO(ckk, A0, A1, A2, A3, A4, A5) do { const float* g_ = g0 + (size_t)(ckk) * CH * 256; A0 = *(const float4*)(g_ + 4 * AS); A1 = *(const float4*)(g_ + 5 * AS); A2 = *(const float4*)(g_ + 1 * AS); \
        A3 = *(const float4*)(g_ + 2 * AS); A4 = *(const float4*)(g_); A5 = *(const float4*)(g_ + 3 * AS); } while (0)
#define SCAN_STORE_FROM(bufp, A0, A1, A2, A3, A4, A5) do { unsigned char* d_ = (bufp) + sstep * 256 + sq * 16; *(float4*)(d_) = A0; *(float4*)(d_ + ARRB) = A1; *(float4*)(d_ + 2 * ARRB) = A2; \
        *(float4*)(d_ + 3 * ARRB) = A3; *(float4*)(d_ + 4 * ARRB) = A4; *(float4*)(d_ + 5 * ARRB) = A5; } while (0)
        float4 pf0, pf1, pf2, pf3, pf4, pf5, pg0, pg1, pg2, pg3, pg4, pg5;
        SCAN_LOAD(0);
        SCAN_LOAD_TO(1, pg0, pg1, pg2, pg3, pg4, pg5);
        __syncthreads();
        SCAN_STORE(ldsb);
        __syncthreads();
        f32x2_t s01 = {0.f, 0.f}, s23 = {0.f, 0.f};
        float cv[32]; int pit = -1;
#define SCAN_CHUNK(CKE, LA, LB, LC, LD, LE, LF, SA, SB, SC, SD, SE, SF) do { const int ck = (CKE); \
            const unsigned char* buf = ldsb + (ck & 1) * BUFB; \
            unsigned char* nbuf = ldsb + ((ck + 1) & 1) * BUFB; \
            float* yb = (float*)(ldsb + YOFF + (ck & 1) * (CH * 16 * 4)); \
            const bool more = ck + 1 < SEQ / CH; \
            if (wave >= 4) { \
                float* scr = (float*)(ldsb + YOFF + 2 * CH * 16 * 4) + (wave - 4) * (64 * 36); \
                if (pit >= 0) item_finish(expert_item(X, pit), cv, scr, lane); \
                pit = -1; \
                if (ck < NCK_CONV) { pit = (u * NCK_CONV + ck) * 4 + (wave - 4); item_load(expert_item(X, pit), cv, lane); } \
            } \
            if (ck + 2 < SEQ / CH) SCAN_LOAD_TO(ck + 2, LA, LB, LC, LD, LE, LF); \
            if (wave < 4) { \
_Pragma("unroll 1") \
                for (int t8 = 0; t8 < CH; t8 += 8) { \
                    float yv[8]; \
_Pragma("unroll") \
                    for (int j = 0; j < 8; ++j) { \
                        const unsigned char* bp = buf + (t8 + j) * 256 + s * 16; \
                        const f32x2_t a01 = *(const f32x2_t*)(bp), a23 = *(const f32x2_t*)(bp + 8); \
                        const f32x2_t b01 = *(const f32x2_t*)(bp + ARRB), b23 = *(const f32x2_t*)(bp + ARRB + 8); \
                        const f32x2_t w01 = *(const f32x2_t*)(bp + 2 * ARRB), w23 = *(const f32x2_t*)(bp + 2 * ARRB + 8); \
                        const f32x2_t k01 = *(const f32x2_t*)(bp + 3 * ARRB), k23 = *(const f32x2_t*)(bp + 3 * ARRB + 8); \
                        const f32x2_t r01 = *(const f32x2_t*)(bp + 4 * ARRB), r23 = *(const f32x2_t*)(bp + 4 * ARRB + 8); \
                        const float v = *(const float*)(buf + 5 * ARRB + (t8 + j) * 256 + row * 4); \
                        f32x2_t d = s01 * a01 + s23 * a23; \
                        const float sa = red16(d.x + d.y); \
                        const f32x2_t vv = {v, v}, sv = {sa, sa}; \
                        s01 = (s01 * w01 + vv * k01) + sv * b01; s23 = (s23 * w23 + vv * k23) + sv * b23; \
                        d = s01 * r01 + s23 * r23; \
                        yv[j] = red16(d.x + d.y); \
                    } \
_Pragma("unroll") \
                    for (int j = 0; j < 8; ++j) yb[(t8 + j) * 16 + lrow] = yv[j]; \
                } \
            } \
            if (more) SCAN_STORE_FROM(nbuf, SA, SB, SC, SD, SE, SF); \
            __syncthreads(); \
            Yg[(size_t)ck * CH * 256] = yb[sstep * 16 + sq]; \
        } while (0)
#pragma unroll 1
        for (int ck2 = 0; ck2 < SEQ / CH; ck2 += 2) {
            SCAN_CHUNK(ck2, pf0, pf1, pf2, pf3, pf4, pf5, pg0, pg1, pg2, pg3, pg4, pg5);
            SCAN_CHUNK(ck2 + 1, pg0, pg1, pg2, pg3, pg4, pg5, pf0, pf1, pf2, pf3, pf4, pf5);
        }
#undef SCAN_CHUNK
#undef SCAN_LOAD_TO
#undef SCAN_STORE_FROM
        if (wave >= 4 && pit >= 0) item_finish(expert_item(X, pit), cv, (float*)(ldsb + YOFF + 2 * CH * 16 * 4) + (wave - 4) * (64 * 36), lane);
    }
#undef SCAN_LOAD
#undef SCAN_STORE
}
__device__ __forceinline__ void rwkv_post_phase(const float* RW, const float* r_k, const float* lnx_g, const float* lnx_b, bf16* mix) {
    const int tidx = otid(), bidx = obid(), gdim = ogdim();
    const int lane = tidx & 63, wave = tidx >> 6, stride = gdim * 8;
    constexpr size_t AS = (size_t)T * 256;
    const float4 rk4 = ((const float4*)r_k)[lane], lg4 = ((const float4*)lnx_g)[lane], lb4 = ((const float4*)lnx_b)[lane];
#pragma unroll 1
    for (int t0 = bidx * 8 + wave; t0 < T; t0 += 4 * stride) {
        float4 yv[4], rv[4], kv[4], vv[4], gv[4];
#pragma unroll
        for (int i = 0; i < 4; ++i) {
            const int t = t0 + i * stride < T ? t0 + i * stride : t0;
            const float4* p = (const float4*)(RW + (size_t)t * 256) + lane;
            yv[i] = p[7 * AS / 4]; rv[i] = p[0]; kv[i] = p[2 * AS / 4]; vv[i] = p[3 * AS / 4]; gv[i] = p[6 * AS / 4];
        }
#pragma unroll
        for (int i = 0; i < 4; ++i) {
            const int t = t0 + i * stride;
            const float mean = red16((yv[i].x + yv[i].y) + (yv[i].z + yv[i].w)) * (1.f / 64.f);
            const float4 d = make_float4(yv[i].x - mean, yv[i].y - mean, yv[i].z - mean, yv[i].w - mean);
            const float rstd = rsqrtf(red16(sq4(d)) * (1.f / 64.f) + 64e-5f);
            const float bonus = red16((rv[i].x * kv[i].x * rk4.x + rv[i].y * kv[i].y * rk4.y) + (rv[i].z * kv[i].z * rk4.z + rv[i].w * kv[i].w * rk4.w));
            const float o0 = (d.x * rstd * lg4.x + lb4.x + bonus * vv[i].x) * gv[i].x, o1 = (d.y * rstd * lg4.y + lb4.y + bonus * vv[i].y) * gv[i].y;
            const float o2 = (d.z * rstd * lg4.z + lb4.z + bonus * vv[i].z) * gv[i].z, o3 = (d.w * rstd * lg4.w + lb4.w + bonus * vv[i].w) * gv[i].w;
            if (t < T) ((uint2*)(mix + (size_t)t * D + A_WIDTH))[lane] = make_uint2(pk2(o0, o1), pk2(o2, o3));
        }
    }
}
__device__ __forceinline__ void route_topk(unsigned* hist, const float* logits, const float* ebias, int* top_idx, float* top_w, unsigned* counts) {
    const int tidx = otid(), bidx = obid(), gdim = ogdim();
    const int wave = tidx >> 6, lane = tidx & 63;
    __syncthreads();
    if (tidx < NE) hist[tidx] = 0u;
    __syncthreads();
#pragma unroll 1
    for (int t = bidx * 8 + wave; t < T; t += gdim * 8) {
        const float acc = logits[(size_t)t * 256 + lane];
        const float s = sigmoidf_(acc);
        const float bz = s + ebias[lane];
        int rk = 0;
        const int gbase = lane & ~7;
#pragma unroll
        for (int j = 0; j < 8; ++j) { const float o = shfl_idx(bz, gbase + j); rk += (o > bz || (o == bz && (gbase + j) < lane)) ? 1 : 0; }
        float gs = rk < 2 ? bz : 0.f;
        gs += shfl_idx(gs, lane ^ 1); gs += shfl_idx(gs, lane ^ 2); gs += shfl_idx(gs, lane ^ 4);
        int grk = 0;
        const int myg = lane >> 3;
#pragma unroll
        for (int g = 0; g < 8; ++g) { const float o = rdlane(gs, g * 8); grk += (o > gs || (o == gs && g < myg)) ? 1 : 0; }
        const float masked = grk < 4 ? bz : -INFINITY;
        int rank = 0;
#pragma unroll 8
        for (int j = 0; j < 64; ++j) { const float o = rdlane(masked, j); rank += (o > masked || (o == masked && j < lane)) ? 1 : 0; }
        const bool sel = rank < TOPK;
        const float ssum = wave_sum(sel ? s : 0.f);
        if (sel) {
            top_idx[t * TOPK + rank] = lane;
            top_w[t * TOPK + rank] = s / (ssum + 1e-20f) * 2.5f;
            atomicAdd(&hist[lane], 1u);
        }
    }
    __syncthreads();
    if (tidx < NE && hist[tidx]) atomicAdd(&counts[tidx], hist[tidx]);
}

typedef float f32x2c __attribute__((ext_vector_type(2)));
__device__ __forceinline__ void acc16(float (&y)[16], const uint4& v, float w) {
    const unsigned u[4] = {v.x, v.y, v.z, v.w};
#pragma unroll
    for (int i = 0; i < 4; ++i) {
        const f32x2c lo = __builtin_amdgcn_cvt_pk_f32_fp8((int)u[i], false), hi = __builtin_amdgcn_cvt_pk_f32_fp8((int)u[i], true);
        y[4 * i] += w * lo.x; y[4 * i + 1] += w * lo.y; y[4 * i + 2] += w * hi.x; y[4 * i + 3] += w * hi.y;
    }
}
template <bool NEXT>
__device__ __forceinline__ void combine_phase(const unsigned char* YB, const unsigned char* YS, const int* posi, const float* topw, const float* gy, const float* gate_base, float* x,
                                              const float* gn, const float* modn, bf16* hb) {
    const int tidx = otid(), bidx = obid(), gdim = ogdim();
    const int lane = tidx & 63, wave = tidx >> 6, stride = gdim * 8;
#pragma unroll 1
    for (int row0 = bidx * 8 + wave; row0 < T; row0 += 2 * stride) {
#pragma unroll
        for (int r = 0; r < 2; ++r) {
            const int row = row0 + r * stride;
            if (row < T) {
                const int b = row / SEQ;
                const int4 p0 = *(const int4*)(posi + row * TOPK), p1 = *(const int4*)(posi + row * TOPK + 4);
                const float4 w0 = *(const float4*)(topw + row * TOPK), w1 = *(const float4*)(topw + row * TOPK + 4);
                const int pp[8] = {p0.x, p0.y, p0.z, p0.w, p1.x, p1.y, p1.z, p1.w};
                const float ww[8] = {w0.x, w0.y, w0.z, w0.w, w1.x, w1.y, w1.z, w1.w};
                float y[16];
#pragma unroll
                for (int i = 0; i < 16; ++i) y[i] = 0.f;
                acc16(y, nt_load16((const uint4*)(YS + (size_t)row * D) + lane), 1.f / 16.f);
#pragma unroll
                for (int k = 0; k < TOPK; ++k) acc16(y, nt_load16((const uint4*)(YB + (size_t)pp[k] * D) + lane), ww[k] * (1.f / 16.f));
                float ss = 0.f;
#pragma unroll
                for (int i = 0; i < 16; ++i) ss += y[i] * y[i];
                const float rs = rsqrtf(wave_sum_fast(ss) * (1.f / D) + 1e-6f);
                float xn[16]; float s2 = 0.f;
#pragma unroll
                for (int q = 0; q < 4; ++q) {
                    const int c4 = 4 * lane + q;
                    const float4 gg = ((const float4*)gy)[c4], gt = ((const float4*)(gate_base + (size_t)b * 6 * D))[c4];
                    float4 v = ((const float4*)(x + (size_t)row * D))[c4];
                    v.x += gt.x * y[4 * q] * rs * gg.x; v.y += gt.y * y[4 * q + 1] * rs * gg.y; v.z += gt.z * y[4 * q + 2] * rs * gg.z; v.w += gt.w * y[4 * q + 3] * rs * gg.w;
                    ((float4*)(x + (size_t)row * D))[c4] = v;
                    xn[4 * q] = v.x; xn[4 * q + 1] = v.y; xn[4 * q + 2] = v.z; xn[4 * q + 3] = v.w;
                    s2 += sq4(v);
                }
                if (NEXT) {
                    const float r2 = rsqrtf(wave_sum_fast(s2) * (1.f / D) + 1e-6f);
                    const float* m = modn + (size_t)b * 6 * D;
                    float o[16];
#pragma unroll
                    for (int q = 0; q < 4; ++q) {
                        const int c4 = 4 * lane + q;
                        const float4 gg = ((const float4*)gn)[c4], sc = ((const float4*)(m + D))[c4], sh = ((const float4*)m)[c4];
                        o[4 * q] = xn[4 * q] * r2 * gg.x * (1.f + sc.x) + sh.x; o[4 * q + 1] = xn[4 * q + 1] * r2 * gg.y * (1.f + sc.y) + sh.y;
                        o[4 * q + 2] = xn[4 * q + 2] * r2 * gg.z * (1.f + sc.z) + sh.z; o[4 * q + 3] = xn[4 * q + 3] * r2 * gg.w * (1.f + sc.w) + sh.w;
                    }
                    ((uint4*)(hb + (size_t)row * D))[2 * lane] = make_uint4(pk2(o[0], o[1]), pk2(o[2], o[3]), pk2(o[4], o[5]), pk2(o[6], o[7]));
                    ((uint4*)(hb + (size_t)row * D))[2 * lane + 1] = make_uint4(pk2(o[8], o[9]), pk2(o[10], o[11]), pk2(o[12], o[13]), pk2(o[14], o[15]));
                }
            }
        }
    }
}
__device__ __forceinline__ void build_ps(int* ps, const unsigned* counts) {
    const int tidx = otid(), bidx = obid(), gdim = ogdim();
    __syncthreads();
    if (tidx == 0) {
        int acc = 0;
#pragma unroll 1
        for (int e = 0; e < NE; ++e) { ps[e] = acc; acc += ((int)__hip_atomic_load(&counts[e], __ATOMIC_RELAXED, __HIP_MEMORY_SCOPE_AGENT) + EBLK - 1) / EBLK * EBLK; }
        ps[NE] = acc;
    }
    __syncthreads();
}

__global__ void __launch_bounds__(NT) mk_fwd(Args args) {
    float* lds = (float*)lds_raw;
    if ((threadIdx.x & 63) == 0) *(volatile LAS int*)((LAS unsigned char*)lds_raw + WIDTAB_OFF + 4 * ((unsigned)__builtin_amdgcn_s_getreg(63492) & 63u)) = (int)(threadIdx.x >> 6);
    volatile LAS unsigned* misc = (volatile LAS unsigned*)((LAS unsigned char*)lds_raw + LDS_BYTES - 256);
    int* ps = (int*)(lds_raw + LDS_BYTES - 2048);
    if (threadIdx.x < 64) misc[threadIdx.x] = 0u;
    __syncthreads();
#define XBAR() xcd_barrier(bar)
    if (threadIdx.x < 512) { const int h_ = threadIdx.x >> 7, d_ = threadIdx.x & 127; const float* tb_ = args.in[10];
        ((float*)(lds_raw + BT_OFF))[threadIdx.x] = (tb_[t5_bucket(d_) * A_HEADS + h_] - tb_[31 * A_HEADS + h_]) * 1.4426950408889634f; }
    __syncthreads();
    unsigned* ctl = (unsigned*)(args.ws + WS_CTL);
    XcdBarrier bar = xcd_barrier_post(ctl + CW_BAR, misc);
#define GAS __attribute__((address_space(1)))
#define WSO(off) ((char*)({ char* _w = args.ws; asm volatile("" : "+s"(_w)); (GAS char*)_w + (off); }))
#define CNT ((unsigned*)WSO(WS_CTL) + CW_CNT)
#define CUR ((unsigned*)WSO(WS_CTL) + CW_CUR)
#define MOD ((float*)WSO(WS_MOD))
#define TOPI ((int*)WSO(WS_TOPI))
#define TOPW ((float*)WSO(WS_TOPW))
#define ROWT ((int*)WSO(WS_ROWT))
#define DST ((int*)WSO(WS_DST))
#define RW ((float*)WSO(WS_RW))
#define Y ((float*)WSO(WS_PROJ))
#define GU ((float*)WSO(WS_GU))
#define GVN ((float*)WSO(WS_GU) + (size_t)T * 256)
#define HBF ((bf16*)WSO(WS_HBF))
#define WTIN ((bf16*)WSO(WS_WTIN))
#define WTR ((bf16*)WSO(WS_WTR))
#define SMALLW(l_) ((bf16*)WSO(WS_SMALL) + (size_t)(l_) * 131072)
#define LOGIT ((float*)WSO(WS_LOGIT))
#define PROJB ((bf16*)WSO(WS_PROJ))
#define WTOUT ((bf16*)WSO(WS_WTOUT))
#define MIXB ((bf16*)WSO(WS_MIXB))
#define WTUP ((bf16*)WSO(WS_WTUP))
#define WTDN ((bf16*)WSO(WS_WTDN))
#define HBB ((bf16*)WSO(WS_HBB))
#define YB ((bf16*)WSO(WS_YB))
#define YS8 ((unsigned char*)WSO(WS_YS))
#define IN(k) ((const float*)(const GAS float*)args.in[({ int _k = (k); asm volatile("" : "+s"(_k)); _k; })])
#define out ((float*)(GAS float*)args.out)
#define gsz (ogdim() * NT)
#define GTID (obid() * NT + otid())

#pragma unroll 1
    for (int idx = GTID; idx < DEPTH * BATCH * 6 * D; idx += gsz) {
        const int n = idx % (6 * D), b = (idx / (6 * D)) % BATCH, l = idx / (6 * D * BATCH);
        float acc = IN(3)[l * 6 * D + n];
        const float* w = IN(2) + (size_t)l * D * 6 * D + n;
        const float* cr = IN(1) + b * D;
        for (int k = 0; k < D; ++k) acc += siluf_(cr[k]) * w[(size_t)k * 6 * D];
        MOD[idx] = acc;
    }
    {
    for (int l = 0; l < DEPTH; ++l) {
        transpose_matrix(IN(8) + (size_t)l * D * IN_COLS, D, IN_COLS, WTIN + (size_t)l * IN_COLS * D, lds);
        transpose_matrix(IN(9) + (size_t)l * D * D, D, D, WTOUT + (size_t)l * D * D, lds);
        transpose_matrix(IN(28) + (size_t)l * D * NE, D, NE, WTR + (size_t)l * 256 * D, lds);
        transpose_matrix(IN(15) + (size_t)l * 64 * 256, 64, 256, SMALLW(l), lds);
        transpose_matrix(IN(17) + (size_t)l * 64 * 256, 64, 256, SMALLW(l) + 16384, lds);
        transpose_matrix(IN(18) + (size_t)l * 128 * 256, 128, 256, SMALLW(l) + 32768, lds);
#pragma unroll 1
        for (int i = GTID; i < 4 * CHUNK * CHUNK; i += gsz) { const int s_ = i & 127, t_ = (i >> 7) & 127; (SMALLW(l) + 65536)[i] = (bf16)(s_ <= t_ ? f2bf((IN(26) + (size_t)l * 4 * CHUNK * CHUNK)[i]) : 0u); }
#pragma unroll 1
        for (int i = GTID; i < 192 * D / 8; i += gsz) ((uint4*)(WTR + (size_t)l * 256 * D + 64 * D))[i] = make_uint4(0u, 0u, 0u, 0u);
    }
    }
    XBAR();

#define xin (l == 0 ? IN(0) : (const float*)out)
#pragma unroll 1
    for (int l_ = 0; l_ < DEPTH; ++l_) {
        int l = l_; asm volatile("" : "+s"(l));
#define mod_l (MOD + (size_t)l * BATCH * 6 * D)
        const float lambda_init = l == 0 ? 0.2f : 0.8f - 0.6f * 0.7408182206817179f;
        if (l == 0) { row_phase<false, true>(xin, nullptr, nullptr, nullptr, nullptr, IN(4) + l * D, mod_l, 0, 1, HBF);
        XBAR(); }
        {
            pg8::Gemm g{HBF, WTIN + (size_t)l * IN_COLS * D, T, IN_COLS, D}; pg8::StaticOrder S; S.init(T, IN_COLS, ogdim(), obid());
            pg8::EpiBf16<0> E{PROJB, IN_COLS, nullptr, 0, 0, 1.f};
            pg8::gemm_phase<pg8::EpiBf16<0>, pg8::StaticOrder, true>((LAS unsigned char*)lds_raw, g, S, E);
        }
        XBAR();
        rwkv_prep_phase(lds_raw, PROJB, IN(13) + l * B_COLS, IN(14) + l * 256, SMALLW(l), IN(16) + l * 256, SMALLW(l) + 16384, SMALLW(l) + 32768, IN(19) + l * 256, IN(20) + l * 256, RW);
        XBAR();
        {
            const int G_ = ogdim(), b_ = obid(), nsc = G_ >= 256 ? 128 : G_ / 2;
            if (b_ < nsc) {
                const ExpW X{IN(30) + (size_t)l * NE * D * DE, IN(31) + (size_t)l * NE * D * DE, IN(32) + (size_t)l * NE * DE * D, IN(33) + (size_t)l * D * DE, IN(34) + (size_t)l * D * DE, IN(35) + (size_t)l * DE * D, WTUP, WTDN};
                rwkv_scan_phase(lds_raw, RW, b_, nsc, X);
            }
            else {
                attn_flash(lds_raw, PROJB, IN(11) + l * 256, IN(12) + l * 128, lambda_init, MIXB, b_ - nsc, G_ - nsc);
                __syncthreads();
                gmlp_phase(lds_raw, PROJB, IN(24) + l * 256, IN(25) + l * 256, SMALLW(l) + 65536, IN(27) + l * 4 * CHUNK, MIXB, b_ - nsc, G_ - nsc);
                __syncthreads();
                {
                    const ExpW X{IN(30) + (size_t)l * NE * D * DE, IN(31) + (size_t)l * NE * D * DE, IN(32) + (size_t)l * NE * DE * D, IN(33) + (size_t)l * D * DE, IN(34) + (size_t)l * D * DE, IN(35) + (size_t)l * DE * D, WTUP, WTDN};
                    const int wv_ = owave(), ln_ = olane(), st_ = (G_ - nsc) * 8;
                    float* scr = lds + wv_ * (64 * 32);
                    float ca[32], cb[32];
                    const int it0 = CONV_SCAN + (b_ - nsc) * 8 + wv_;
                    item_load(expert_item(X, it0 < CONV_ITEMS ? it0 : CONV_ITEMS - 1), ca, ln_);
#pragma unroll 1
                    for (int it = it0; it < CONV_ITEMS; it += 2 * st_) {
                        const int i1 = it + st_, i2 = it + 2 * st_;
                        item_load(expert_item(X, i1 < CONV_ITEMS ? i1 : CONV_ITEMS - 1), cb, ln_);
                        item_finish(expert_item(X, it), ca, scr, ln_);
                        item_load(expert_item(X, i2 < CONV_ITEMS ? i2 : CONV_ITEMS - 1), ca, ln_);
                        if (i1 < CONV_ITEMS) item_finish(expert_item(X, i1), cb, scr, ln_);
                    }
                }
            }
        }
        XBAR();
        rwkv_post_phase(RW, IN(21) + l * 256, IN(22) + l * 256, IN(23) + l * 256, MIXB);
        XBAR();
        {
            pg8::Gemm g{MIXB, WTOUT + (size_t)l * D * D, T, D, D}; pg8::StaticOrder S; S.init(T, D, ogdim(), obid());
            pg8::EpiBf16<0> E{(bf16*)Y, D, nullptr, 0, 0, 1.f};
            pg8::gemm_phase<pg8::EpiBf16<0>, pg8::StaticOrder, false>((LAS unsigned char*)lds_raw, g, S, E);
        }
        XBAR();
        row_phase<true, true>(xin, (const bf16*)Y, IN(5) + l * D, mod_l + 2 * D, out, IN(6) + l * D, mod_l, 3, 4, HBF);
#pragma unroll 1
        for (int i = GTID; i < P; i += gsz) ROWT[i] = 0;
        { const int t_ = otid(); if (obid() == 0 && t_ < NE) { CNT[t_] = 0u; CUR[t_] = 0u; } }
        XBAR();
        {
            pg8::Gemm g{HBF, WTR + (size_t)l * 256 * D, T, 256, D}; pg8::StaticOrder S; S.init(T, 256, ogdim(), obid());
            pg8::EpiF32 E{LOGIT, 256};
            pg8::gemm_phase<pg8::EpiF32, pg8::StaticOrder, false>((LAS unsigned char*)lds_raw, g, S, E);
        }
        {
            const int G_ = ogdim(); int c_ = obid() - 64; if (c_ < 0) c_ += G_;
            pg8::Gemm g{HBF, WTUP + (size_t)64 * 512 * D, T, 512, D}; pg8::StaticOrder S; S.init(T, 512, G_, c_);
            pg8::EpiSwiGLU E{HBB + (size_t)P * 256};
            pg8::gemm_phase<pg8::EpiSwiGLU, pg8::StaticOrder, false>((LAS unsigned char*)lds_raw, g, S, E);
        }
        XBAR();
        route_topk((unsigned*)lds_raw, LOGIT, IN(29) + l * NE, TOPI, TOPW, CNT);
        XBAR();
        build_ps(ps, CNT);
        {
            unsigned* lc = (unsigned*)lds_raw; unsigned* lb = lc + 64; unsigned* lc2 = lc + 128;
            const int t_ = otid();
            if (t_ < NE) { lc[t_] = 0u; lc2[t_] = 0u; }
            __syncthreads();
#pragma unroll 1
            for (int i = GTID; i < T * TOPK; i += gsz) atomicAdd(&lc[TOPI[i]], 1u);
            __syncthreads();
            if (t_ < NE) lb[t_] = lc[t_] ? atomicAdd(&CUR[t_], lc[t_]) : 0u;
            __syncthreads();
#pragma unroll 1
            for (int i = GTID; i < T * TOPK; i += gsz) {
                const int e = TOPI[i];
                const int pos = ps[e] + (int)(lb[e] + atomicAdd(&lc2[e], 1u));
                ROWT[pos] = i / TOPK; DST[i] = pos;
            }
        }
        XBAR();
        {
            pg8::Gemm g{HBF, WTUP, 0, 512, D}; pg8::GroupedOrder S; S.init(ps, 2, ogdim(), obid(), ROWT, (size_t)512 * D * 2, NBLK, 0);
            pg8::EpiSwiGLU E{HBB};
            pg8::gemm_phase<pg8::EpiSwiGLU, pg8::GroupedOrder, true>((LAS unsigned char*)lds_raw, g, S, E);
        }
        XBAR();
        {
            pg8::Gemm g{HBB, WTDN, 0, D, DE}; pg8::GroupedOrder S; S.init(ps, 4, ogdim(), obid(), nullptr, (size_t)D * DE * 2, NBLK, T / 256);
            pg8::EpiRows E{(unsigned char*)YB, YS8, NBLK};
            pg8::gemm_phase<pg8::EpiRows, pg8::GroupedOrder, true>((LAS unsigned char*)lds_raw, g, S, E);
        }
        XBAR();
        if (l + 1 < DEPTH) combine_phase<true>((const unsigned char*)YB, YS8, DST, TOPW, IN(7) + l * D, mod_l + 5 * D, out, IN(4) + (l + 1) * D, MOD + (size_t)(l + 1) * BATCH * 6 * D, HBF);
        else combine_phase<false>((const unsigned char*)YB, YS8, DST, TOPW, IN(7) + l * D, mod_l + 5 * D, out, nullptr, nullptr, nullptr);
        XBAR();
    }
}
#undef out
}

extern "C" void kernel_launch(void* const* d_in, const int* in_sizes, int n_in, void* d_out, int out_size, void* d_ws, size_t ws_size, hipStream_t stream) {
    static int grid = 0;
    if (grid == 0) {
        if (n_in != 36 || ws_size < WS_END) { fprintf(stderr, "kernel_launch: need 36 inputs and %zu bytes of workspace; got %d, %zu\n", (size_t)WS_END, n_in, ws_size); grid = -1; return; }
        int dev = 0, cus = 0, per_cu = 0;
        if (hipGetDevice(&dev) != hipSuccess || hipDeviceGetAttribute(&cus, hipDeviceAttributeMultiprocessorCount, dev) != hipSuccess) { grid = -1; return; }
        if (hipFuncSetAttribute((const void*)mk_fwd, hipFuncAttributeMaxDynamicSharedMemorySize, LDS_BYTES) != hipSuccess) { fprintf(stderr, "kernel_launch: hipFuncSetAttribute failed\n"); grid = -1; return; }
        if (hipOccupancyMaxActiveBlocksPerMultiprocessor(&per_cu, (const void*)mk_fwd, NT, LDS_BYTES) != hipSuccess || per_cu < 1) { fprintf(stderr, "kernel_launch: occupancy query says %d\n", per_cu); per_cu = 1; }
        (void)hipGetLastError();
        grid = cus;
        fprintf(stderr, "kernel_launch: grid %d (occupancy query %d per CU)\n", grid, per_cu);
    }
    if (grid < 0) return;
    (void)hipMemsetAsync((char*)d_ws + WS_CTL, 0, CTL_BYTES, stream);
    Args a{};
    for (int i = 0; i < 36; ++i) a.in[i] = (const float*)d_in[i];
    a.out = (float*)d_out; a.ws = (char*)d_ws;
    hipLaunchKernelGGL(mk_fwd, dim3(grid), dim3(NT), LDS_BYTES, stream, a);
}
```

```cpp
#include <hip/hip_runtime.h>
#include <cstdio>
#include <cstdint>
#include <cmath>

namespace {
constexpr int D = 1024, BATCH = 8, SEQ = 2048, T = BATCH * SEQ, DEPTH = 2;
constexpr int A_HEADS = 4, A_WIDTH = 512;
constexpr int B_WIDTH = 256, B_COLS = 1024, CHUNK = 128;
constexpr int A_COLS = 1536, IN_COLS = 3072;
constexpr int NE = 64, TOPK = 8, DE = 256;
constexpr int EBLK = 256;
constexpr int NBLK = T * TOPK / EBLK + NE;
constexpr int P = NBLK * EBLK;
constexpr int NT = 512;
constexpr int LDS_BYTES = 147456;

#define LAS __attribute__((address_space(3)))

__device__ __forceinline__ int olane() { int l; asm volatile("v_mbcnt_lo_u32_b32 %0, -1, 0\n\tv_mbcnt_hi_u32_b32 %0, -1, %0" : "=v"(l)); return l; }
__device__ __forceinline__ float shfl_idx(float v, int src) { return __int_as_float(__builtin_amdgcn_ds_bpermute(src << 2, __float_as_int(v))); }
__device__ __forceinline__ float wave_sum(float v) {
    const int l = olane();
#pragma unroll
    for (int o = 1; o < 64; o <<= 1) v += shfl_idx(v, l ^ o);
    return v;
}
__device__ __forceinline__ float wave_max(float v) {
    const int l = olane();
#pragma unroll
    for (int o = 1; o < 64; o <<= 1) v = fmaxf(v, shfl_idx(v, l ^ o));
    return v;
}
__device__ __forceinline__ float rdlane(float v, int src) { return __int_as_float(__builtin_amdgcn_readlane(__float_as_int(v), src)); }
__device__ __forceinline__ float sigmoidf_(float x) { return 1.f / (1.f + __expf(-x)); }
__device__ __forceinline__ float siluf_(float x) { return x / (1.f + __expf(-x)); }
__device__ __forceinline__ float gelu_tanh(float x) {
    const float u = 0.7978845608028654f * (x + 0.044715f * x * x * x);
    return 0.5f * x * (1.f + tanhf(u));
}

extern __shared__ __attribute__((aligned(16))) unsigned char lds_raw[];
constexpr int WIDTAB_OFF = 147456 - 768;
__device__ __forceinline__ int owave() {
    const unsigned key = (unsigned)__builtin_amdgcn_s_getreg(63492) & 63u;
    const int w = *(volatile __attribute__((address_space(3))) int*)((__attribute__((address_space(3))) unsigned char*)lds_raw + WIDTAB_OFF + 4 * key);
    return __builtin_amdgcn_readfirstlane(w);
}
__device__ __forceinline__ int olane_() { int l; asm volatile("v_mbcnt_lo_u32_b32 %0, -1, 0\n\tv_mbcnt_hi_u32_b32 %0, -1, %0" : "=v"(l)); return l; }
__device__ __forceinline__ int otid() { return owave() * 64 + olane_(); }
__device__ __forceinline__ int obid() { int b = blockIdx.x; asm volatile("" : "+s"(b)); return b; }
__device__ __forceinline__ int ogdim() { int g = gridDim.x; asm volatile("" : "+s"(g)); return g; }
typedef unsigned short bf16;
__device__ __forceinline__ float bf2f(bf16 v) { return __uint_as_float((unsigned)v << 16); }
typedef float f32x2cv __attribute__((ext_vector_type(2))); typedef __bf16 bf16x2cv __attribute__((ext_vector_type(2)));
__device__ __forceinline__ unsigned pk2(float lo, float hi) { const f32x2cv v = {lo, hi}; const bf16x2cv b = __builtin_convertvector(v, bf16x2cv); return __builtin_bit_cast(unsigned, b); }
__device__ __forceinline__ unsigned f2bf(float f) { return pk2(f, 0.f) & 0xffffu; }

#define XB_TMO      128
#define XB_XCNT(j)  (256  + 64 * (j))
#define XB_XSUB(j)  (1280 + 64 * (j))
#define XB_XGEN(j)  (2304 + 64 * (j))
#define XB_TOP      3328
#define XB_TOPGEN   3392
#define XCD_BAR_WORDS 3456
#define XB_SPIN_CAP (1u << 27)
__device__ __forceinline__ unsigned xb_ld(unsigned* p)              { return __hip_atomic_load(p, __ATOMIC_RELAXED, __HIP_MEMORY_SCOPE_AGENT); }
__device__ __forceinline__ unsigned xb_add(unsigned* p, unsigned v) { return __hip_atomic_fetch_add(p, v, __ATOMIC_RELAXED, __HIP_MEMORY_SCOPE_AGENT); }
__device__ __forceinline__ unsigned xb_xcc_id() { return (unsigned)__builtin_amdgcn_s_getreg((3 << 11) | 20) & 0xFu; }
#define XB_SPIN(cond, bar) do { unsigned _sp = 0; while (cond) { __builtin_amdgcn_s_sleep(1); \
    if ((++_sp & 255u) == 0u) { if (xb_ld(&(bar)[XB_TMO])) break; if (_sp > XB_SPIN_CAP) { atomicAdd(&(bar)[XB_TMO], 1u); break; } } } } while (0)
struct XcdBarrier { unsigned* bar; unsigned x; volatile LAS unsigned* st; };
__device__ __forceinline__ XcdBarrier xcd_barrier_post(unsigned* bar, volatile LAS unsigned* st) {
    XcdBarrier b; b.bar = bar; b.x = xb_xcc_id(); b.st = st;
    if (threadIdx.x == 0) (void)xb_add(&bar[XB_XCNT(b.x)], 1u);
    return b;
}
__device__ __forceinline__ void xcd_barrier_complete(unsigned* bar, unsigned x, unsigned& nloc, unsigned& nx) {
    const unsigned G = gridDim.x * gridDim.y * gridDim.z;
    unsigned sum, cnt, mine, sp = 0u;
    for (;;) {
        sum = 0u; cnt = 0u; mine = 0u;
#pragma unroll
        for (unsigned j = 0; j < 16; ++j) { const unsigned c = xb_ld(&bar[XB_XCNT(j)]); sum += c; cnt += (c > 0u) ? 1u : 0u; mine = (j == x) ? c : mine; }
        if (sum == G) break;
        __builtin_amdgcn_s_sleep(1);
        if ((++sp & 255u) == 0u) { if (xb_ld(&bar[XB_TMO])) break; if (sp > XB_SPIN_CAP) { atomicAdd(&bar[XB_TMO], 1u); break; } }
    }
    nloc = mine > 0u ? mine : 1u; nx = cnt > 0u ? cnt : 1u;
}
__device__ __forceinline__ void xcd_barrier(const XcdBarrier& b) {
    asm volatile("s_waitcnt vmcnt(0)" ::: "memory");
    __syncthreads();
    if (otid() == 0) {
        unsigned* bar = b.bar; asm volatile("" : "+s"(bar));
        unsigned bx = b.x; asm volatile("" : "+s"(bx));
        __builtin_amdgcn_s_waitcnt(0);
        unsigned nloc = b.st[0], nx = b.st[1];
        if (nloc == 0u) { xcd_barrier_complete(bar, bx, nloc, nx); b.st[0] = nloc; b.st[1] = nx; }
        const unsigned old = xb_add(&bar[XB_XSUB(bx)], 1u);
        const unsigned gen = old / nloc;
        if (old + 1u == (gen + 1u) * nloc) {
            __builtin_amdgcn_fence(__ATOMIC_RELEASE, "agent");
            asm volatile("s_waitcnt vmcnt(0)" ::: "memory");
            const unsigned og = xb_add(&bar[XB_TOP], 1u);
            const unsigned tg = og / nx;
            if (og + 1u == (tg + 1u) * nx) xb_add(&bar[XB_TOPGEN], 1u);
            else XB_SPIN(xb_ld(&bar[XB_TOPGEN]) == tg, bar);
            __builtin_amdgcn_fence(__ATOMIC_ACQUIRE, "agent");
            xb_add(&bar[XB_XGEN(bx)], 1u);
            asm volatile("s_waitcnt vmcnt(0)" ::: "memory");
        } else {
            XB_SPIN(xb_ld(&bar[XB_XGEN(bx)]) == gen, bar);
            __builtin_amdgcn_fence(__ATOMIC_ACQUIRE, "agent");
            asm volatile("s_waitcnt vmcnt(0)" ::: "memory");
        }
    }
    __syncthreads();
}

namespace pg8 {
#define PG8_LAS __attribute__((address_space(3)))
typedef unsigned short bf16_t;
typedef short bf16x8 __attribute__((ext_vector_type(8)));
typedef float f32x4 __attribute__((ext_vector_type(4)));
typedef unsigned u32x4 __attribute__((ext_vector_type(4)));
constexpr int BM = 256, BK = 64, HALF = 128, HTB = HALF * BK * 2  , STAGE_BYTES = 8 * HTB, NXCD = 8, WGM = 8;

__host__ __device__ __forceinline__ int lds_byte(int r, int c) { const int st = (r >> 4) * 2 + (c >> 5), rr = r & 15, cc = c & 31, ob = rr * 64 + cc * 2; return st * 1024 + (ob ^ (((ob >> 9) & 1) << 5)); }
__host__ __device__ __forceinline__ void stage_rc(int b, int& R, int& C) { const int st = b / 1024, sb = b % 1024, swz = sb ^ (((sb >> 9) & 1) << 5); R = (st >> 1) * 16 + swz / 64; C = (st & 1) * 32 + (swz % 64) / 2; }
__host__ __device__ __forceinline__ int perm32(int rho) { const int n = rho >> 4, i = rho & 15; return 8 * (i >> 2) + 4 * n + (i & 3); }

struct Unit { int pm, pn; size_t boff; };
struct Gemm { const bf16_t* A; const bf16_t* Bt; int M, N, K; };

struct StaticOrder {
    int nM, nN, nwg, G, c;
    __host__ __device__ void init(int M, int N, int G_, int c_) { nM = M / BM; nN = N / BM; nwg = nM * nN; G = G_; c = c_; }
    __host__ __device__ bool next(int i, Unit& u) const {
        const long L = (long)i * G + c; if (L >= nwg) return false;
        int wgid = (int)L; { const int q = nwg / NXCD, r = nwg % NXCD, xcd = wgid % NXCD, off = wgid / NXCD; wgid = (xcd < r ? xcd * (q + 1) : r * (q + 1) + (xcd - r) * q) + off; }
        const int nig = WGM * nN, gid = wgid / nig, fm = gid * WGM, gsz = (nM - fm) < WGM ? (nM - fm) : WGM;
        u.pm = fm + ((wgid % nig) % gsz); u.pn = (wgid % nig) / gsz; u.boff = 0; return true;
    }
    __device__ __forceinline__ unsigned arow(const Unit& u, int r) const { return (unsigned)(u.pm * BM + r); }
    __device__ __forceinline__ void a_ready(const Unit&) const {}
    __device__ __forceinline__ void done(const Unit&) const {}
};

__device__ __forceinline__ unsigned cvt_pk_bf16(float lo, float hi) { typedef float f2_ __attribute__((ext_vector_type(2))); typedef __bf16 b2_ __attribute__((ext_vector_type(2))); const f2_ v = {lo, hi}; const b2_ b = __builtin_convertvector(v, b2_); return __builtin_bit_cast(unsigned, b); }
typedef float f32x2 __attribute__((ext_vector_type(2)));
__device__ __forceinline__ f32x2 gelu_pk(f32x2 v) {
    const f32x2 av = __builtin_elementwise_abs(v), d = av * 0.2316418882f + 1.0f;
    f32x2 t; t.x = __builtin_amdgcn_rcpf(d.x); t.y = __builtin_amdgcn_rcpf(d.y);
    f32x2 q = t * 0.5307027145f + (-0.7265760135f); q = q * t + 0.7107068705f; q = q * t + (-0.142248368f); q = q * t + 0.127414796f; q = q * t;
    const f32x2 s = (v * v) * (-0.72134752044f);
    f32x2 e; e.x = __builtin_amdgcn_exp2f(s.x); e.y = __builtin_amdgcn_exp2f(s.y);
    const f32x2 m = v * (q * e), r = v - m;
    f32x2 o; o.x = v.x < 0.f ? m.x : r.x; o.y = v.y < 0.f ? m.y : r.y; return o;
}

template <int ACT  > struct EpiBf16 {
    static constexpr bool PERM = true, AFTER_DRAIN = false; static_assert(ACT == 0 || ACT == 1, "EpiBf16: ACT is 0 (none) or 1 (gelu_pk)");
    bf16_t* O; int ldc; const float* bias; int split_cols; size_t split_stride; float scale0;
    __device__ __forceinline__ void operator()(const f32x4 (&acc)[2][2][4][2], const Unit& u, int wr, int wc, int fr, int fq) const {
        const int row0 = u.pm * BM + wr * 64 + fr; int colt = u.pn * BM; bf16_t* base = O;
        float sc = 1.f; if (split_cols) { const int t = colt / split_cols; base += (size_t)t * split_stride; colt -= t * split_cols; if (t == 0) sc = scale0; }
        const int col0 = colt + wc * 32 + 8 * fq, bcol0 = u.pn * BM + wc * 32 + 8 * fq;
        f32x4 bv[2][2];
#pragma unroll
        for (int bj = 0; bj < 2; ++bj)
#pragma unroll
            for (int n = 0; n < 2; ++n) bv[bj][n] = bias ? *(const f32x4*)(bias + bcol0 + bj * HALF + 4 * n) : (f32x4){0.f, 0.f, 0.f, 0.f};
#pragma unroll
        for (int ai = 0; ai < 2; ++ai)
#pragma unroll
            for (int m = 0; m < 4; ++m) { bf16_t* rowp = base + (size_t)(row0 + ai * HALF + m * 16) * ldc + col0;
#pragma unroll
                for (int bj = 0; bj < 2; ++bj) { f32x4 v0 = acc[ai][bj][m][0] + bv[bj][0], v1 = acc[ai][bj][m][1] + bv[bj][1];
                    if (ACT == 1) { f32x2 a = gelu_pk((f32x2){v0[0], v0[1]}), b = gelu_pk((f32x2){v0[2], v0[3]}), c = gelu_pk((f32x2){v1[0], v1[1]}), d = gelu_pk((f32x2){v1[2], v1[3]});
                        v0 = (f32x4){a.x, a.y, b.x, b.y}; v1 = (f32x4){c.x, c.y, d.x, d.y}; }
                    v0 = v0 * sc; v1 = v1 * sc; u32x4 w; w.x = cvt_pk_bf16(v0[0], v0[1]); w.y = cvt_pk_bf16(v0[2], v0[3]); w.z = cvt_pk_bf16(v1[0], v1[1]); w.w = cvt_pk_bf16(v1[2], v1[3]);
                    *(u32x4*)(rowp + bj * HALF) = w; } }
    }
};

struct EpiF32 {
    static constexpr bool PERM = false, AFTER_DRAIN = false;
    float* C; int ldc;
    __device__ __forceinline__ void operator()(const f32x4 (&acc)[2][2][4][2], const Unit& u, int wr, int wc, int fr, int fq) const {
        const int row0 = u.pm * BM + wr * 64 + fr, col0 = u.pn * BM + wc * 32 + 4 * fq;
#pragma unroll
        for (int ai = 0; ai < 2; ++ai)
#pragma unroll
            for (int m = 0; m < 4; ++m) { float* rowp = C + (size_t)(row0 + ai * HALF + m * 16) * ldc + col0;
#pragma unroll
                for (int bj = 0; bj < 2; ++bj)
#pragma unroll
                    for (int n = 0; n < 2; ++n) *(f32x4*)(rowp + bj * HALF + n * 16) = acc[ai][bj][m][n]; }
    }
};

struct EpiSwiGLU {
    static constexpr bool PERM = true, AFTER_DRAIN = false;
    bf16_t* O;
    __device__ __forceinline__ void operator()(const f32x4 (&acc)[2][2][4][2], const Unit& u, int wr, int wc, int fr, int fq) const {
        const int row0 = u.pm * BM + wr * 64 + fr, col0 = u.pn * HALF + wc * 32 + 8 * fq;
#pragma unroll
        for (int ai = 0; ai < 2; ++ai)
#pragma unroll
            for (int m = 0; m < 4; ++m) {
                bf16_t* rowp = O + (size_t)(row0 + ai * HALF + m * 16) * 256 + col0;
                float hv[8];
#pragma unroll
                for (int n = 0; n < 2; ++n)
#pragma unroll
                    for (int j = 0; j < 4; ++j) { const float a = acc[ai][0][m][n][j], g = acc[ai][1][m][n][j]; hv[n * 4 + j] = a * __builtin_amdgcn_rcpf(1.f + __expf(-a)) * g; }
                u32x4 w; w.x = cvt_pk_bf16(hv[0], hv[1]); w.y = cvt_pk_bf16(hv[2], hv[3]); w.z = cvt_pk_bf16(hv[4], hv[5]); w.w = cvt_pk_bf16(hv[6], hv[7]);
                *(u32x4*)rowp = w;
            }
    }
};
__device__ __forceinline__ unsigned pack_fp8x4(const f32x4& v) {
    const float s = 16.f;
    int w = __builtin_amdgcn_cvt_pk_fp8_f32(__builtin_amdgcn_fmed3f(v[0] * s, -448.f, 448.f), __builtin_amdgcn_fmed3f(v[1] * s, -448.f, 448.f), 0, false);
    w = __builtin_amdgcn_cvt_pk_fp8_f32(__builtin_amdgcn_fmed3f(v[2] * s, -448.f, 448.f), __builtin_amdgcn_fmed3f(v[3] * s, -448.f, 448.f), w, true);
    return (unsigned)w;
}
struct EpiRows {
    static constexpr bool PERM = true, AFTER_DRAIN = false;
    unsigned char* O; unsigned char* O2; int shared_pm0;
    __device__ __forceinline__ void operator()(const f32x4 (&acc)[2][2][4][2], const Unit& u, int wr, int wc, int fr, int fq) const {
        unsigned char* base = u.pm < shared_pm0 ? O + (size_t)u.pm * BM * 1024 : O2 + (size_t)(u.pm - shared_pm0) * BM * 1024;
        const int row0 = wr * 64 + fr, col0 = u.pn * BM + wc * 32 + 8 * fq;
#pragma unroll
        for (int ai = 0; ai < 2; ++ai)
#pragma unroll
            for (int m = 0; m < 4; ++m) {
                unsigned char* rowp = base + (size_t)(row0 + ai * HALF + m * 16) * 1024 + col0;
#pragma unroll
                for (int bj = 0; bj < 2; ++bj) { typedef unsigned u32x2 __attribute__((ext_vector_type(2)));
                    u32x2 w; w.x = pack_fp8x4(acc[ai][bj][m][0]); w.y = pack_fp8x4(acc[ai][bj][m][1]);
                    *(u32x2*)(rowp + bj * HALF) = w; }
            }
    }
};
struct GroupedOrder {
    int nMr, nM, nN, nwg, G, c, spm0; const int* ps; const int* rows; size_t estride;
    __device__ void init(const int* ps_, int nN_, int G_, int c_, const int* rows_, size_t estride_, int spm0_, int nshared) {
        ps = ps_; nMr = ps_[64] / BM; nM = nMr + nshared; nN = nN_; nwg = nM * nN; G = G_; c = c_; rows = rows_; estride = estride_; spm0 = spm0_; }
    __device__ bool next(int i, Unit& u) const {
        const long L = (long)i * G + c; if (L >= nwg) return false;
        int wgid = (int)L; { const int q = nwg / NXCD, r = nwg % NXCD, xcd = wgid % NXCD, off = wgid / NXCD; wgid = (xcd < r ? xcd * (q + 1) : r * (q + 1) + (xcd - r) * q) + off; }
        const int nig = WGM * nN, gid = wgid / nig, fm = gid * WGM, gsz = (nM - fm) < WGM ? (nM - fm) : WGM;
        const int pmi = fm + ((wgid % nig) % gsz); u.pn = (wgid % nig) / gsz;
        if (pmi < nMr) { const int pj = ps[olane()];
            const int e = __popcll(__ballot(pmi * BM >= pj)) - 1; u.pm = pmi; u.boff = (size_t)e * estride; }
        else { u.pm = spm0 + (pmi - nMr); u.boff = (size_t)64 * estride; }
        return true;
    }
    __device__ __forceinline__ unsigned arow(const Unit& u, int r) const {
        if (rows) return u.pm < spm0 ? (unsigned)rows[u.pm * BM + r] : (unsigned)((u.pm - spm0) * BM + r);
        return (unsigned)(u.pm * BM + r);
    }
    __device__ __forceinline__ void a_ready(const Unit&) const {}
    __device__ __forceinline__ void done(const Unit&) const {}
};

template <class Epi, class Sched, bool ALIGN_EPI = false>
__device__ __forceinline__ void gemm_phase(PG8_LAS unsigned char* lds, const Gemm g, const Sched& S, const Epi& E) {
    const int wid = owave(), wr = wid >> 2, wc = wid & 3;
#define tid (wid * 64 + olane())
    int K = g.K; asm volatile("" : "+s"(K));
    const int nt = K / BK;
    unsigned voffB;
    { int R, C; stage_rc(tid * 16, R, C); const int Rb = Epi::PERM ? ((R & ~31) + perm32(R & 31)) : R; voffB = (unsigned)(Rb * K + C) * 2u; }
    const size_t r64step = (size_t)64 * K * 2;
    const unsigned rowbytes = (unsigned)K * 2u;
    const size_t kstep = (size_t)(BK * 2);
    const size_t hstep = (size_t)HALF * K * 2;
    const size_t tstep = 2 * hstep;
    const unsigned ldsw = (unsigned)wid * 1024u;
    int aoff, boff; { const int ln = olane(), fr = ln & 15, fq = ln >> 4; aoff = lds_byte(wr * 64 + fr, fq * 8); boff = lds_byte(wc * 32 + fr, fq * 8); }
#define PG8_SA(b, h) (((b) * 2 + (h)) * HTB)
#define PG8_SB(b, h) ((4 + (b) * 2 + (h)) * HTB)
#define PG8_STAGE(bufoff, gbase, voff) do { _Pragma("unroll") for (int _i = 0; _i < 2; ++_i) \
        __builtin_amdgcn_global_load_lds((const unsigned*)((const char*)(gbase) + (voff)[_i]), (PG8_LAS unsigned*)(lds + (bufoff) + ldsw + _i * 8192), 16, 0, 0); } while (0)
#define PG8_STAGEB(bufoff, gbase) do { _Pragma("unroll") for (int _i = 0; _i < 2; ++_i) \
        __builtin_amdgcn_global_load_lds((const unsigned*)((const char*)(gbase) + _i * r64step + voffB), (PG8_LAS unsigned*)(lds + (bufoff) + ldsw + _i * 8192), 16, 0, 0); } while (0)
#define PG8_LDA(dst, b, h) do { _Pragma("unroll") for (int m = 0; m < 4; ++m) _Pragma("unroll") for (int k = 0; k < 2; ++k) dst[m][k] = *(const PG8_LAS bf16x8*)(lds + PG8_SA(b, h) + aoff + m * 2048 + k * 1024); } while (0)
#define PG8_LDB(dst, b, h) do { _Pragma("unroll") for (int n = 0; n < 2; ++n) _Pragma("unroll") for (int k = 0; k < 2; ++k) dst[n][k] = *(const PG8_LAS bf16x8*)(lds + PG8_SB(b, h) + boff + n * 2048 + k * 1024); } while (0)
#define PG8_MMA(ai, bj, At, Bt) do { __builtin_amdgcn_s_setprio(1); _Pragma("unroll") for (int m = 0; m < 4; ++m) _Pragma("unroll") for (int n = 0; n < 2; ++n) _Pragma("unroll") for (int k = 0; k < 2; ++k) \
        acc[ai][bj][m][n] = __builtin_amdgcn_mfma_f32_16x16x32_bf16(Bt[n][k], At[m][k], acc[ai][bj][m][n], 0, 0, 0); __builtin_amdgcn_s_setprio(0); } while (0)
#define PG8_WAIT_V(n) asm volatile("s_waitcnt vmcnt(" #n ")" ::: "memory")
#define PG8_WAIT_L(n) asm volatile("s_waitcnt lgkmcnt(" #n ")" ::: "memory")
#define PG8_BAR __builtin_amdgcn_s_barrier()
#define PG8_SCHED __builtin_amdgcn_sched_barrier(0)
#define PG8_FILL(tb, u) do { int _t = tid; asm volatile("" : "+v"(_t)); if (_t < BM) rtab[(tb) * BM + _t] = S.arow(u, _t) * rowbytes; } while (0)
#define PG8_AOFF(dst, tb) do { int _t = tid; asm volatile("" : "+v"(_t)); _Pragma("unroll") for (int _i = 0; _i < 2; ++_i) { int _R, _C; stage_rc(_t * 16 + _i * 8192, _R, _C); \
        _Pragma("unroll") for (int _h = 0; _h < 2; ++_h) dst[_h][_i] = rtab[(tb) * BM + _h * HALF + _R] + (unsigned)_C * 2u; } } while (0)
    PG8_LAS unsigned* const rtab = (PG8_LAS unsigned*)(lds + STAGE_BYTES);
    Unit cur, nxt; int ui = 0, ctb = 0;
    if (!S.next(0, cur)) return;
    f32x4 acc[2][2][4][2];
#pragma unroll
    for (int a = 0; a < 2; ++a)
#pragma unroll
        for (int b = 0; b < 2; ++b)
#pragma unroll
            for (int m = 0; m < 4; ++m)
#pragma unroll
                for (int n = 0; n < 2; ++n) acc[a][b][m][n] = (f32x4){0.f, 0.f, 0.f, 0.f};
    bf16x8 At[4][2], B0[2][2], B1[2][2];
    const char* const Ab = (const char*)g.A;
    const char* cB = (const char*)g.Bt + cur.boff + (size_t)cur.pn * tstep;
    PG8_FILL(0, cur);
    __syncthreads();
    S.a_ready(cur);
    { unsigned cv[2][2]; PG8_AOFF(cv, 0);
    PG8_STAGEB(PG8_SB(0, 0), cB); PG8_STAGEB(PG8_SB(0, 1), cB + hstep); PG8_STAGE(PG8_SA(0, 0), Ab, cv[0]); PG8_STAGE(PG8_SA(0, 1), Ab, cv[1]);
    if (wr == 1) PG8_BAR;
    PG8_WAIT_V(2); PG8_BAR;
    PG8_STAGEB(PG8_SB(1, 0), cB + kstep); PG8_STAGE(PG8_SA(1, 0), Ab + kstep, cv[0]); PG8_STAGEB(PG8_SB(1, 1), cB + hstep + kstep);
    PG8_WAIT_V(6); PG8_BAR; }
    for (;;) {
        const bool has_next = S.next(ui + 1, nxt);
        const char* nB = has_next ? (const char*)g.Bt + nxt.boff + (size_t)nxt.pn * tstep : cB;
        if (has_next) PG8_FILL(ctb ^ 1, nxt);
        for (int t = 0; t < nt; t += 2) {
            const bool last = (t == nt - 2);
            const char* a1 = Ab + (size_t)(t + 1) * kstep;
            const char* a2 = last ? Ab : Ab + (size_t)(t + 2) * kstep; const char* b2 = last ? nB : cB + (size_t)(t + 2) * kstep;
            const char* a3 = a2 + kstep; const char* b3 = b2 + kstep;
            unsigned cv[2][2], s2[2][2];
            PG8_AOFF(cv, ctb); PG8_AOFF(s2, (last && has_next) ? (ctb ^ 1) : ctb);
            if (last && has_next) S.a_ready(nxt);
            PG8_LDB(B0, 0, 0); PG8_LDB(B1, 0, 1); PG8_SCHED; PG8_LDA(At, 0, 0); PG8_STAGE(PG8_SA(1, 1), a1, cv[1]);
            PG8_WAIT_V(8); PG8_WAIT_L(0); PG8_BAR; PG8_MMA(0, 0, At, B0); PG8_MMA(0, 1, At, B1); PG8_BAR; PG8_SCHED;
            PG8_LDA(At, 0, 1); PG8_STAGEB(PG8_SB(0, 0), b2); PG8_STAGEB(PG8_SB(0, 1), b2 + hstep); PG8_STAGE(PG8_SA(0, 0), a2, s2[0]);
            PG8_WAIT_V(8); PG8_WAIT_L(0); PG8_BAR; PG8_MMA(1, 0, At, B0); PG8_MMA(1, 1, At, B1); PG8_BAR; PG8_SCHED;
            PG8_LDB(B0, 1, 0); PG8_LDB(B1, 1, 1); PG8_SCHED; PG8_LDA(At, 1, 0); PG8_STAGE(PG8_SA(0, 1), a2, s2[1]);
            PG8_WAIT_V(8); PG8_WAIT_L(0); PG8_BAR; PG8_MMA(0, 0, At, B0); PG8_MMA(0, 1, At, B1); PG8_BAR; PG8_SCHED;
            PG8_LDA(At, 1, 1); PG8_STAGEB(PG8_SB(1, 0), b3); PG8_STAGEB(PG8_SB(1, 1), b3 + hstep); PG8_STAGE(PG8_SA(1, 0), a3, s2[0]);
            PG8_WAIT_V(8); PG8_WAIT_L(0); PG8_BAR; PG8_MMA(1, 0, At, B0); PG8_MMA(1, 1, At, B1); PG8_BAR; PG8_SCHED;
        }
        if constexpr (ALIGN_EPI) { if (wr == 0) PG8_BAR; }
        { const int ln = olane(); E(acc, cur, wr, wc, ln & 15, ln >> 4); } S.done(cur);
        if (!has_next) break;
#pragma unroll
        for (int a = 0; a < 2; ++a)
#pragma unroll
            for (int b = 0; b < 2; ++b)
#pragma unroll
                for (int m = 0; m < 4; ++m)
#pragma unroll
                    for (int n = 0; n < 2; ++n) acc[a][b][m][n] = (f32x4){0.f, 0.f, 0.f, 0.f};
        cur = nxt; cB = nB; ++ui; ctb ^= 1;
        if constexpr (ALIGN_EPI) { if (wr == 1) PG8_BAR; }
    }
    PG8_WAIT_V(0);
    if constexpr (!ALIGN_EPI) { if (wr == 0) PG8_BAR; }
    PG8_BAR;
#undef PG8_FILL
#undef tid
#undef PG8_SA
#undef PG8_SB
#undef PG8_STAGE
#undef PG8_STAGEB
#undef PG8_LDA
#undef PG8_LDB
#undef PG8_MMA
#undef PG8_WAIT_V
#undef PG8_WAIT_L
#undef PG8_BAR
#undef PG8_SCHED
#undef PG8_AOFF
}
}

struct Args { const float* in[36]; float* out; char* ws; };

constexpr size_t al256(size_t x) { return (x + 255) & ~(size_t)255; }
constexpr size_t MiB = (size_t)1 << 20;
constexpr size_t WS_CTL = 0;
constexpr size_t CTL_BYTES = 64 * 1024;
constexpr int CW_BAR = 0, CW_CNT = 8192, CW_CUR = 8192 + 64;
constexpr size_t WS_MOD = WS_CTL + CTL_BYTES;
constexpr size_t WS_TOPI = 512 * 1024;
constexpr size_t WS_TOPW = 1 * MiB;
constexpr size_t WS_ROWT = 1 * MiB + 512 * 1024;
constexpr size_t WS_DST = 2 * MiB + 512 * 1024;
constexpr size_t WS_SMALL = 3 * MiB + 256 * 1024;
constexpr size_t WS_WTR = 4 * MiB;
constexpr size_t WS_WTIN = 5 * MiB;
constexpr size_t WS_WTOUT = 17 * MiB;
constexpr size_t WS_WTUP = 21 * MiB;
constexpr size_t WS_WTDN = 86 * MiB;
constexpr size_t WS_HBF = 119 * MiB;
constexpr size_t WS_ARENA = 151 * MiB;
constexpr size_t WS_PROJ = WS_ARENA;
constexpr size_t WS_MIXB = WS_ARENA + 96 * MiB;
constexpr size_t WS_RW = WS_ARENA + 128 * MiB;
constexpr size_t WS_CHK = WS_ARENA + 256 * MiB;
constexpr size_t WS_GU = WS_ARENA + 256 * MiB;
constexpr size_t WS_HBB = WS_ARENA;
constexpr size_t WS_YB = WS_ARENA + 81 * MiB;
constexpr size_t WS_YS = WS_ARENA + 232 * MiB;
constexpr size_t WS_LOGIT = WS_YB;
constexpr size_t WS_END = WS_ARENA + 369 * MiB;
static_assert(WS_MOD + (size_t)DEPTH * BATCH * 6 * D * 4 <= WS_TOPI && WS_DST + (size_t)P * 4 <= WS_WTIN && WS_WTUP + (size_t)65 * 512 * 1024 * 2 <= WS_WTDN && WS_WTDN + (size_t)65 * 1024 * 256 * 2 <= WS_HBF, "ws map");
static_assert(WS_HBB + (size_t)(P + T) * 256 * 2 <= WS_YB && WS_YB + (size_t)P * 1024 * 2 <= WS_END, "ws map (moe)");

__device__ __forceinline__ void transpose_item(const float* W, int K, int N, bf16* WT, int k0, int n0, int drow0, float* scr, int lane) {
#pragma unroll 8
    for (int i = 0; i < 32; ++i) { const int kk = 2 * i + (lane >> 5); scr[kk * 33 + (lane & 31)] = W[(size_t)(k0 + kk) * N + n0 + (lane & 31)]; }
    asm volatile("s_waitcnt lgkmcnt(0)" ::: "memory");
    const int c = lane & 7;
#pragma unroll
    for (int j = 0; j < 4; ++j) { const int n = (lane >> 3) + 8 * j; const float* sp = scr + (8 * c) * 33 + n;
        uint4 o; o.x = pk2(sp[0 * 33], sp[1 * 33]); o.y = pk2(sp[2 * 33], sp[3 * 33]); o.z = pk2(sp[4 * 33], sp[5 * 33]); o.w = pk2(sp[6 * 33], sp[7 * 33]);
        *(uint4*)(WT + (size_t)(drow0 + n) * K + k0 + 8 * c) = o; }
    asm volatile("s_waitcnt lgkmcnt(0)" ::: "memory");
}
struct ItemDesc { const float* W; int N; bf16* WT; int K, k0, n0, drow0; };
__device__ __forceinline__ void item_load(const ItemDesc& d, float (&v)[32], int lane) {
    const float* p = d.W + (size_t)(d.k0 + (lane >> 3)) * d.N + d.n0 + 4 * (lane & 7);
#pragma unroll
    for (int j = 0; j < 8; ++j) { const float4 t = *(const float4*)(p + (size_t)(8 * j) * d.N); v[4 * j] = t.x; v[4 * j + 1] = t.y; v[4 * j + 2] = t.z; v[4 * j + 3] = t.w; }
}
__device__ __forceinline__ void item_finish(const ItemDesc& d, const float (&v)[32], float* scr, int lane) {
#pragma unroll
    for (int j = 0; j < 8; ++j) { const int k = 8 * j + (lane >> 3), sw = (8 * ((k >> 3) & 3)) ^ (4 * ((k >> 5) & 1));
        *(float4*)(scr + k * 32 + ((4 * (lane & 7)) ^ sw)) = make_float4(v[4 * j], v[4 * j + 1], v[4 * j + 2], v[4 * j + 3]); }
    asm volatile("s_waitcnt lgkmcnt(0)" ::: "memory");
    const int c = lane & 7, swc = (8 * (c & 3)) ^ (4 * (c >> 2));
#pragma unroll
    for (int j = 0; j < 4; ++j) { const int n = (lane >> 3) + 8 * j; const float* sp = scr + (8 * c) * 32 + (n ^ swc);
        uint4 o; o.x = pk2(sp[0 * 32], sp[1 * 32]); o.y = pk2(sp[2 * 32], sp[3 * 32]); o.z = pk2(sp[4 * 32], sp[5 * 32]); o.w = pk2(sp[6 * 32], sp[7 * 32]);
        *(uint4*)(d.WT + (size_t)(d.drow0 + n) * d.K + d.k0 + 8 * c) = o; }
    asm volatile("s_waitcnt lgkmcnt(0)" ::: "memory");
}
__device__ __forceinline__ void transpose_matrix(const float* W, int K, int N, bf16* WT, float* lds) {
    const int tidx = otid(), bidx = obid(), gdim = ogdim();
    const int wave = tidx >> 6, lane = tidx & 63;
    float* scr = lds + wave * (64 * 33);
    const int nblk = N / 32, nitems = (K / 64) * nblk;
#pragma unroll 1
    for (int it = bidx * 8 + wave; it < nitems; it += gdim * 8) {
        const int kb = it / nblk, nb = it % nblk;
        transpose_item(W, K, N, WT, 64 * kb, 32 * nb, 32 * nb, scr, lane);
    }
}
template <int CTRL> __device__ __forceinline__ float dpp_add(float v) { return v + __int_as_float(__builtin_amdgcn_update_dpp(0, __float_as_int(v), CTRL, 0xF, 0xF, false)); }
__device__ __forceinline__ float wave_sum_fast(float v) {
    v = dpp_add<0xB1>(v); v = dpp_add<0x4E>(v); v = dpp_add<0x141>(v); v = dpp_add<0x140>(v);
    const int vi = __float_as_int(v);
    return (__int_as_float(__builtin_amdgcn_readlane(vi, 0)) + __int_as_float(__builtin_amdgcn_readlane(vi, 16))) + (__int_as_float(__builtin_amdgcn_readlane(vi, 32)) + __int_as_float(__builtin_amdgcn_readlane(vi, 48)));
}
typedef unsigned u32x4n __attribute__((ext_vector_type(4)));
typedef unsigned u32x2n __attribute__((ext_vector_type(2)));
__device__ __forceinline__ uint4 nt_load16(const void* p) { const u32x4n v = __builtin_nontemporal_load((const u32x4n*)p); return make_uint4(v.x, v.y, v.z, v.w); }
__device__ __forceinline__ uint2 nt_load8(const void* p) { const u32x2n v = __builtin_nontemporal_load((const u32x2n*)p); return make_uint2(v.x, v.y); }
__device__ __forceinline__ float sq4(const float4& a) { return a.x * a.x + a.y * a.y + a.z * a.z + a.w * a.w; }
template <bool HAS_Y, bool HAS_H>
__device__ __forceinline__ void row_phase(const float* xin, const bf16* y, const float* gy, const float* gate_base, float* xout,
                                          const float* gn, const float* mod_l, int sh_idx, int sc_idx, bf16* hb) {
    const int tidx = otid(), bidx = obid(), gdim = ogdim();
    const int lane = tidx & 63, wave = tidx >> 6;
    float4 gyv[4], gnv[4];
#pragma unroll
    for (int j = 0; j < 4; ++j) { if (HAS_Y) gyv[j] = ((const float4*)gy)[lane + 64 * j]; if (HAS_H) gnv[j] = ((const float4*)gn)[lane + 64 * j]; }
#pragma unroll 1
    for (int row0 = (bidx * 8 + wave) * 4; row0 < T; row0 += gdim * 32) {
        const int b = row0 / SEQ;
        const float* m = mod_l + (size_t)b * 6 * D;
        float4 v[4][4], yv[4][4], gt[4], sc[4], sh[4];
#pragma unroll
        for (int r = 0; r < 4; ++r)
#pragma unroll
            for (int j = 0; j < 4; ++j) {
                v[r][j] = ((const float4*)(xin + (size_t)(row0 + r) * D))[lane + 64 * j];
                if (HAS_Y) { const uint2 yb_ = nt_load8((const uint2*)(y + (size_t)(row0 + r) * D) + lane + 64 * j);
                    yv[r][j] = make_float4(__uint_as_float(yb_.x << 16), __uint_as_float(yb_.x & 0xffff0000u), __uint_as_float(yb_.y << 16), __uint_as_float(yb_.y & 0xffff0000u)); }
            }
#pragma unroll
        for (int j = 0; j < 4; ++j) {
            if (HAS_Y) gt[j] = ((const float4*)(gate_base + (size_t)b * 6 * D))[lane + 64 * j];
            if (HAS_H) { sc[j] = ((const float4*)(m + sc_idx * D))[lane + 64 * j]; sh[j] = ((const float4*)(m + sh_idx * D))[lane + 64 * j]; }
        }
#pragma unroll
        for (int r = 0; r < 4; ++r) {
            const int row = row0 + r;
            if (HAS_Y) {
                const float rs = rsqrtf(wave_sum_fast((sq4(yv[r][0]) + sq4(yv[r][1])) + (sq4(yv[r][2]) + sq4(yv[r][3]))) * (1.f / D) + 1e-6f);
#pragma unroll
                for (int j = 0; j < 4; ++j) {
                    v[r][j].x += gt[j].x * yv[r][j].x * rs * gyv[j].x; v[r][j].y += gt[j].y * yv[r][j].y * rs * gyv[j].y;
                    v[r][j].z += gt[j].z * yv[r][j].z * rs * gyv[j].z; v[r][j].w += gt[j].w * yv[r][j].w * rs * gyv[j].w;
                    ((float4*)(xout + (size_t)row * D))[lane + 64 * j] = v[r][j];
                }
            }
            if (HAS_H) {
                const float rs = rsqrtf(wave_sum_fast((sq4(v[r][0]) + sq4(v[r][1])) + (sq4(v[r][2]) + sq4(v[r][3]))) * (1.f / D) + 1e-6f);
#pragma unroll
                for (int j = 0; j < 4; ++j) {
                    float4 o;
                    o.x = v[r][j].x * rs * gnv[j].x * (1.f + sc[j].x) + sh[j].x; o.y = v[r][j].y * rs * gnv[j].y * (1.f + sc[j].y) + sh[j].y;
                    o.z = v[r][j].z * rs * gnv[j].z * (1.f + sc[j].z) + sh[j].z; o.w = v[r][j].w * rs * gnv[j].w * (1.f + sc[j].w) + sh[j].w;
                    ((uint2*)(hb + (size_t)row * D))[lane + 64 * j] = make_uint2(pk2(o.x, o.y), pk2(o.z, o.w));
                }
            }
        }
    }
}

__device__ __forceinline__ int t5_bucket(int n) {
    if (n < 16) return n;
    int large = 16 + (int)(logf((float)n / 16.f) / logf(8.f) * 16.f);
    return large < 31 ? large : 31;
}
constexpr int BT_OFF = LDS_BYTES - 6144;
typedef float f32x16 __attribute__((ext_vector_type(16)));
typedef short bf16x8_t __attribute__((ext_vector_type(8)));
typedef short s16x4_t __attribute__((ext_vector_type(4)));
__device__ __forceinline__ unsigned cvtpk(float lo, float hi) { return pk2(lo, hi); }
#define ATT_C 0.18033688011112042f
template <bool NEAR>
__device__ __forceinline__ void att_scores(f32x16& x, const float* bt_h, int qrow, int kvb) {
#pragma unroll
    for (int r = 0; r < 16; ++r) {
        float v = x[r];
        if (NEAR) { const int dist = qrow - (kvb + (r & 3) + 8 * (r >> 2)); v += bt_h[dist < 0 ? 0 : (dist > 127 ? 127 : dist)]; if (dist < 0) v = -INFINITY; }
        x[r] = v;
    }
}
__device__ __forceinline__ void attn_phase(unsigned char* ldsb, const bf16* proj, const float* lam_par, const float* subln, float lambda_init, bf16* mix, int bidx, int gdim) {
    const int tidx = otid();
    const int wave = tidx >> 6, lane = tidx & 63, qg = wave >> 1, kh = wave & 1, lq = lane & 31, hi = lane >> 5;
    float l01 = lam_par[lane] * lam_par[64 + lane], l23 = lam_par[128 + lane] * lam_par[192 + lane];
    l01 = wave_sum(l01); l23 = wave_sum(l23);
    const float lam = __expf(l01) - __expf(l23) + lambda_init;
    float* stat = (float*)(ldsb + 65536);
    const int vtr = (4 * hi + ((lane & 15) >> 2)) * 64 + (16 * ((lane >> 4) & 1) + 4 * (lane & 3)) * 2;
#pragma unroll 1
    for (int u = bidx; u < BATCH * A_HEADS * 8; u += gdim) {
        const int b = u >> 5, h = (u >> 3) & 3, pi = u & 7;
        const float* bt_h = (const float*)(ldsb + BT_OFF) + h * 128;
#pragma unroll 1
        for (int half = 0; half < 2; ++half) {
            const int qb = half == 0 ? 15 - pi : pi, R0 = qb * 128, r0 = R0 + 32 * qg, ntile = 2 * qb + 2, qrow = r0 + lq;
            const char* kbase = (const char*)(proj + (size_t)(b * SEQ) * IN_COLS + A_WIDTH + h * 128);
            { const char* qb_ = (const char*)(proj + (size_t)(b * SEQ + r0) * IN_COLS + h * 128); const unsigned qo = (unsigned)(lq * IN_COLS + 8 * hi) * 2u;
#pragma unroll
              for (int m = 0; m < 2; ++m)
#pragma unroll
                  for (int s4 = 0; s4 < 4; ++s4) {
                      const uint4 qw = *(const uint4*)(qb_ + qo + (m * 64 + 16 * s4) * 2);
                      const unsigned qq[4] = {qw.x, qw.y, qw.z, qw.w}; union { unsigned u[4]; bf16x8_t v; } qs;
#pragma unroll
                      for (int w = 0; w < 4; ++w) qs.u[w] = cvtpk(__uint_as_float(qq[w] << 16) * ATT_C, __uint_as_float(qq[w] & 0xffff0000u) * ATT_C);
                      *(bf16x8_t*)(ldsb + 73728 + ((wave * 8 + m * 4 + s4) * 64 + lane) * 16) = qs.v; } }
            const int c0 = tidx, c1 = tidx + 512;
            const int sr0 = c0 >> 4, sc0 = c0 & 15, sr1 = c1 >> 4, sc1 = c1 & 15;
            const unsigned so0 = (unsigned)(sr0 * IN_COLS + sc0 * 8) * 2u, so1 = (unsigned)(sr1 * IN_COLS + sc1 * 8) * 2u;
            const int kdst0 = sr0 * 256 + ((sc0 ^ (sr0 & 15)) << 4), kdst1 = sr1 * 256 + ((sc1 ^ (sr1 & 15)) << 4);
#define VDST(sr, sc) ((((sc) >> 2) * 4096) + (((sr) >> 4) * 1024) + ((((sr) >> 3) & 1) * 512) + (((sr) & 7) * 64) + (((sc) & 3) * 16))
            const int vdst0 = VDST(sr0, sc0), vdst1 = VDST(sr1, sc1);
            float m1 = -1e30f, l1 = 0.f, m2 = -1e30f, l2 = 0.f, iv1 = 0.f, iv2 = 0.f;
            f32x16 o[4];
#pragma unroll
            for (int pass = 0; pass < 2; ++pass) {
                if (pass == 1) {
#pragma unroll
                    for (int e = 0; e < 4; ++e)
#pragma unroll
                        for (int r = 0; r < 16; ++r) o[e][r] = 0.f;
                }
                uint4 ka0, ka1, va0, va1, kb0, kb1, vb0, vb1;
                ka0 = *(const uint4*)(kbase + so0); ka1 = *(const uint4*)(kbase + so1);
                if (pass) { va0 = *(const uint4*)(kbase + 1024 + so0); va1 = *(const uint4*)(kbase + 1024 + so1); }
                { const char* kt = kbase + (size_t)64 * IN_COLS * 2;
                  kb0 = *(const uint4*)(kt + so0); kb1 = *(const uint4*)(kt + so1);
                  if (pass) { vb0 = *(const uint4*)(kt + 1024 + so0); vb1 = *(const uint4*)(kt + 1024 + so1); } }
                __syncthreads();
                *(uint4*)(ldsb + kdst0) = ka0; *(uint4*)(ldsb + kdst1) = ka1;
                if (pass) { *(uint4*)(ldsb + 16384 + vdst0) = va0; *(uint4*)(ldsb + 16384 + vdst1) = va1; }
                __syncthreads();
#define ATT_ITER(JJ, LK0, LK1, LV0, LV1, WK0, WK1, WV0, WV1) do { \
                    const int j = j0 + (JJ); \
                    unsigned char* buf = ldsb + (JJ) * 32768; \
                    unsigned char* nbuf = ldsb + ((JJ) ^ 1) * 32768; \
                    const bool more = j + 1 < ntile; \
                    if (j + 2 < ntile) { \
                        const char* kt = kbase + (size_t)(64 * (j + 2)) * IN_COLS * 2; \
                        LK0 = *(const uint4*)(kt + so0); LK1 = *(const uint4*)(kt + so1); \
                        if (pass) { LV0 = *(const uint4*)(kt + 1024 + so0); LV1 = *(const uint4*)(kt + 1024 + so1); } \
                    } \
                    const int kv0 = 64 * j + 32 * kh; \
                    if (kv0 <= r0 + 31) { \
                        f32x16 st1, st2; \
_Pragma("unroll") \
                        for (int r = 0; r < 16; ++r) { st1[r] = 0.f; st2[r] = 0.f; } \
                        const int krow = 32 * kh + lq; \
_Pragma("unroll") \
                        for (int s4 = 0; s4 < 4; ++s4) { \
                            const bf16x8_t a1 = *(const bf16x8_t*)(buf + krow * 256 + (((2 * s4 + hi) ^ (krow & 15)) << 4)); \
                            const bf16x8_t a2 = *(const bf16x8_t*)(buf + krow * 256 + (((8 + 2 * s4 + hi) ^ (krow & 15)) << 4)); \
                            const bf16x8_t q1 = *(const bf16x8_t*)(ldsb + 73728 + ((wave * 8 + s4) * 64 + lane) * 16), q2 = *(const bf16x8_t*)(ldsb + 73728 + ((wave * 8 + 4 + s4) * 64 + lane) * 16); \
                            st1 = __builtin_amdgcn_mfma_f32_32x32x16_bf16(a1, q1, st1, 0, 0, 0); \
                            st2 = __builtin_amdgcn_mfma_f32_32x32x16_bf16(a2, q2, st2, 0, 0, 0); \
                        } \
                        const int kvb = kv0 + 4 * hi; \
                        if (kv0 + 31 + 113 > r0) { att_scores<true>(st1, bt_h, qrow, kvb); att_scores<true>(st2, bt_h, qrow, kvb); } \
                        else { att_scores<false>(st1, bt_h, qrow, kvb); att_scores<false>(st2, bt_h, qrow, kvb); } \
                        if (pass == 0) { \
                            float t1 = st1[0], t2 = st2[0]; \
_Pragma("unroll") \
                            for (int r = 1; r < 16; ++r) { t1 = fmaxf(t1, st1[r]); t2 = fmaxf(t2, st2[r]); } \
                            const float n1 = fmaxf(m1, t1), n2 = fmaxf(m2, t2); \
                            float a1 = 0.f, a2 = 0.f; \
_Pragma("unroll") \
                            for (int r = 0; r < 16; ++r) { a1 += __builtin_amdgcn_exp2f(st1[r] - n1); a2 += __builtin_amdgcn_exp2f(st2[r] - n2); } \
                            l1 = l1 * __builtin_amdgcn_exp2f(m1 - n1) + a1; l2 = l2 * __builtin_amdgcn_exp2f(m2 - n2) + a2; m1 = n1; m2 = n2; \
                        } else { \
_Pragma("unroll") \
                            for (int r = 0; r < 16; ++r) st1[r] = __builtin_amdgcn_exp2f(st1[r] - m1) * iv1 - __builtin_amdgcn_exp2f(st2[r] - m2) * iv2; \
                            const unsigned char* vb = buf + 16384 + vtr + (2 * kh) * 1024; \
_Pragma("unroll") \
                            for (int s2 = 0; s2 < 2; ++s2) { \
                                union { unsigned u[4]; bf16x8_t v; } pa; \
_Pragma("unroll") \
                                for (int w = 0; w < 4; ++w) pa.u[w] = cvtpk(st1[8 * s2 + 2 * w], st1[8 * s2 + 2 * w + 1]); \
_Pragma("unroll") \
                                for (int e = 0; e < 4; ++e) { \
                                    const s16x4_t lo = __builtin_bit_cast(s16x4_t, __builtin_amdgcn_ds_read_tr16_b64_v4i16((__attribute__((address_space(3))) s16x4_t*)(unsigned)(uintptr_t)(vb + e * 4096 + s2 * 1024))); \
                                    const s16x4_t hh = __builtin_bit_cast(s16x4_t, __builtin_amdgcn_ds_read_tr16_b64_v4i16((__attribute__((address_space(3))) s16x4_t*)(unsigned)(uintptr_t)(vb + e * 4096 + s2 * 1024 + 512))); \
                                    const bf16x8_t bv = (bf16x8_t){lo[0], lo[1], lo[2], lo[3], hh[0], hh[1], hh[2], hh[3]}; \
                                    o[e] = __builtin_amdgcn_mfma_f32_32x32x16_bf16(pa.v, bv, o[e], 0, 0, 0); \
                                } \
                            } \
                        } \
                    } \
                    if (more) { \
                        *(uint4*)(nbuf + kdst0) = WK0; *(uint4*)(nbuf + kdst1) = WK1; \
                        if (pass) { *(uint4*)(nbuf + 16384 + vdst0) = WV0; *(uint4*)(nbuf + 16384 + vdst1) = WV1; } \
                    } \
                    __syncthreads(); \
                } while (0)
#pragma unroll 1
                for (int j0 = 0; j0 < ntile; j0 += 2) {
                    ATT_ITER(0, ka0, ka1, va0, va1, kb0, kb1, vb0, vb1);
                    ATT_ITER(1, kb0, kb1, vb0, vb1, ka0, ka1, va0, va1);
                }
#undef ATT_ITER

                if (pass == 0) {
                    float4* sp = (float4*)stat;
                    sp[wave * 64 + lane] = make_float4(m1, l1, m2, l2);
                    __syncthreads();
                    float M1 = -1e30f, M2 = -1e30f;
                    float4 pr[4];
#pragma unroll
                    for (int i = 0; i < 4; ++i) { pr[i] = sp[(2 * qg + (i >> 1)) * 64 + lq + 32 * (i & 1)]; M1 = fmaxf(M1, pr[i].x); M2 = fmaxf(M2, pr[i].z); }
                    float L1 = 0.f, L2 = 0.f;
#pragma unroll
                    for (int i = 0; i < 4; ++i) { L1 += pr[i].y * __builtin_amdgcn_exp2f(pr[i].x - M1); L2 += pr[i].w * __builtin_amdgcn_exp2f(pr[i].z - M2); }
                    m1 = M1; m2 = M2; iv1 = 1.f / L1; iv2 = lam / L2;
                }
            }
            __syncthreads();
            float* ox = (float*)ldsb;
            if (kh == 1) {
#pragma unroll
                for (int e = 0; e < 4; ++e)
#pragma unroll
                    for (int r = 0; r < 16; ++r) ox[((qg * 4 + e) * 16 + r) * 64 + lane] = o[e][r];
            }
            __syncthreads();
            if (kh == 0) {
                float ss[16];
#pragma unroll
                for (int r = 0; r < 16; ++r) ss[r] = 0.f;
#pragma unroll
                for (int e = 0; e < 4; ++e)
#pragma unroll
                    for (int r = 0; r < 16; ++r) { o[e][r] += ox[((qg * 4 + e) * 16 + r) * 64 + lane]; ss[r] += o[e][r] * o[e][r]; }
                const int ln = olane(), lq2 = ln & 31, hi2 = ln >> 5;
                char* mb_ = (char*)(mix + (size_t)(b * SEQ + r0) * D + h * 128);
#pragma unroll
                for (int r = 0; r < 16; ++r) {
#pragma unroll
                    for (int of = 1; of < 32; of <<= 1) ss[r] += shfl_idx(ss[r], ln ^ of);
                    ss[r] = rsqrtf(ss[r] * (1.f / 128.f) + 1e-6f) * (1.f - lambda_init);
                }
#pragma unroll
                for (int e = 0; e < 4; ++e) {
                    const float g = subln[e * 32 + lq2];
#pragma unroll
                    for (int r = 0; r < 16; ++r) {
                        const unsigned q = (unsigned)((r & 3) + 8 * (r >> 2) + 4 * hi2);
                        *(bf16*)(mb_ + (q * D + e * 32 + lq2) * 2u) = (bf16)f2bf(o[e][r] * ss[r] * g);
                    }
                }
            }
        }
    }
#undef VDST
}

__device__ __forceinline__ void attn_flash(unsigned char* ldsb, const bf16* proj, const float* lam_par, const float* subln, float lambda_init, bf16* mix, int bidx, int gdim) {
    const int wave = owave(), qg = wave >> 1, kh = wave & 1;
    float* stat = (float*)(ldsb + 65536);
    float* asc = (float*)(ldsb + 69632) + wave * 64;
    float* ftab = (float*)(ldsb + 71680) + wave * 64;
#pragma unroll 1
    for (int u = bidx; u < BATCH * A_HEADS * 8; u += gdim) {
        const int b = u >> 5, h = (u >> 3) & 3, pi = u & 7;
        const float* bt_h = (const float*)(ldsb + BT_OFF) + h * 128;
#pragma unroll 1
        for (int half = 0; half < 2; ++half) {
            const int lane = olane(), lq = lane & 31, hi = lane >> 5;
            const int vtr = (4 * hi + ((lane & 15) >> 2)) * 64 + (16 * ((lane >> 4) & 1) + 4 * (lane & 3)) * 2;
            const int qb = half == 0 ? 15 - pi : pi, R0 = qb * 128, r0 = R0 + 32 * qg, ntile = 2 * qb + 2, qrow = r0 + lq;
            const char* kbase = (const char*)(proj + (size_t)(b * SEQ) * IN_COLS + A_WIDTH + h * 128);
            { const char* qb_ = (const char*)(proj + (size_t)(b * SEQ + r0) * IN_COLS + h * 128); const unsigned qo = (unsigned)(lq * IN_COLS + 8 * hi) * 2u;
#pragma unroll
              for (int m = 0; m < 2; ++m)
#pragma unroll
                  for (int s4 = 0; s4 < 4; ++s4) {
                      const uint4 qw = *(const uint4*)(qb_ + qo + (m * 64 + 16 * s4) * 2);
                      const unsigned qq[4] = {qw.x, qw.y, qw.z, qw.w}; union { unsigned u[4]; bf16x8_t v; } qs;
#pragma unroll
                      for (int w = 0; w < 4; ++w) qs.u[w] = cvtpk(__uint_as_float(qq[w] << 16) * ATT_C, __uint_as_float(qq[w] & 0xffff0000u) * ATT_C);
                      *(bf16x8_t*)(ldsb + 73728 + ((wave * 8 + m * 4 + s4) * 64 + lane) * 16) = qs.v; } }
            unsigned ksrc[2], vsrc[2];
#pragma unroll
            for (int i = 0; i < 2; ++i) {
                const int p = wave * 64 + i * 512 + lane, row = p >> 4, c = (p & 15) ^ (row & 15);
                ksrc[i] = (unsigned)(row * IN_COLS * 2 + c * 16);
                const int o = p * 16, eb = o >> 12, ks = (o >> 10) & 3, sub = (o >> 9) & 1, r8 = (o >> 6) & 7, c16 = (o >> 4) & 3, kv = ks * 16 + sub * 8 + r8, sc = eb * 4 + c16;
                vsrc[i] = (unsigned)(kv * IN_COLS * 2 + 1024 + sc * 16);
            }
#define ATT_DMA(kt, bufp) do { _Pragma("unroll") for (int i_ = 0; i_ < 2; ++i_) { \
                __builtin_amdgcn_global_load_lds((const unsigned*)((kt) + ksrc[i_]), (__attribute__((address_space(3))) unsigned*)(unsigned)(uintptr_t)((bufp) + (wave * 64 + i_ * 512) * 16), 16, 0, 0); \
                __builtin_amdgcn_global_load_lds((const unsigned*)((kt) + vsrc[i_]), (__attribute__((address_space(3))) unsigned*)(unsigned)(uintptr_t)((bufp) + 16384 + (wave * 64 + i_ * 512) * 16), 16, 0, 0); } } while (0)
            float m1 = -1e30f, l1 = 0.f, m2 = -1e30f, l2 = 0.f;
            f32x16 o1[4], o2[4];
#pragma unroll
            for (int e = 0; e < 4; ++e)
#pragma unroll
                for (int r = 0; r < 16; ++r) { o1[e][r] = 0.f; o2[e][r] = 0.f; }
            __syncthreads();
            ATT_DMA(kbase, ldsb);
            asm volatile("s_waitcnt vmcnt(0)" ::: "memory");
            __syncthreads();
#pragma unroll 1
            for (int j = 0; j < ntile; ++j) {
                unsigned char* buf = ldsb + (j & 1) * 32768;
                unsigned char* nbuf = ldsb + ((j + 1) & 1) * 32768;
                const bool more = j + 1 < ntile;
                if (more) ATT_DMA(kbase + (size_t)(64 * (j + 1)) * IN_COLS * 2, nbuf);
                const int kv0 = 64 * j + 32 * kh;
                if (kv0 <= r0 + 31) {
                    f32x16 st1, st2;
#pragma unroll
                    for (int r = 0; r < 16; ++r) { st1[r] = 0.f; st2[r] = 0.f; }
                    const int krow = 32 * kh + lq;
#pragma unroll
                    for (int s4 = 0; s4 < 4; ++s4) {
                        const bf16x8_t a1 = *(const bf16x8_t*)(buf + krow * 256 + (((2 * s4 + hi) ^ (krow & 15)) << 4));
                        const bf16x8_t a2 = *(const bf16x8_t*)(buf + krow * 256 + (((8 + 2 * s4 + hi) ^ (krow & 15)) << 4));
                        const bf16x8_t q1 = *(const bf16x8_t*)(ldsb + 73728 + ((wave * 8 + s4) * 64 + lane) * 16), q2 = *(const bf16x8_t*)(ldsb + 73728 + ((wave * 8 + 4 + s4) * 64 + lane) * 16);
                        st1 = __builtin_amdgcn_mfma_f32_32x32x16_bf16(a1, q1, st1, 0, 0, 0);
                        st2 = __builtin_amdgcn_mfma_f32_32x32x16_bf16(a2, q2, st2, 0, 0, 0);
                    }
                    const int kvb = kv0 + 4 * hi;
                    if (kv0 + 31 + 113 > r0) { att_scores<true>(st1, bt_h, qrow, kvb); att_scores<true>(st2, bt_h, qrow, kvb); }
                    else { att_scores<false>(st1, bt_h, qrow, kvb); att_scores<false>(st2, bt_h, qrow, kvb); }
                    float t1 = st1[0], t2 = st2[0];
#pragma unroll
                    for (int r = 1; r < 16; ++r) { t1 = fmaxf(t1, st1[r]); t2 = fmaxf(t2, st2[r]); }
                    { const auto ra = __builtin_amdgcn_permlane32_swap(__float_as_uint(t1), __float_as_uint(t1), false, false); t1 = fmaxf(__uint_as_float(ra[0]), __uint_as_float(ra[1]));
                      const auto rb = __builtin_amdgcn_permlane32_swap(__float_as_uint(t2), __float_as_uint(t2), false, false); t2 = fmaxf(__uint_as_float(rb[0]), __uint_as_float(rb[1])); }
                    if (__builtin_amdgcn_ballot_w64(t1 > m1 + 8.f || t2 > m2 + 8.f) != 0ull) {
                        const float n1 = fmaxf(m1, t1), n2 = fmaxf(m2, t2);
                        const float a1 = __builtin_amdgcn_exp2f(m1 - n1), a2 = __builtin_amdgcn_exp2f(m2 - n2);
                        l1 *= a1; l2 *= a2; m1 = n1; m2 = n2;
                        if (hi == 0) { asc[lq] = a1; asc[32 + lq] = a2; }
                        asm volatile("s_waitcnt lgkmcnt(0)" ::: "memory");
#pragma unroll
                        for (int g = 0; g < 4; ++g) {
                            const float4 f1 = *(const float4*)(asc + 8 * g + 4 * hi), f2 = *(const float4*)(asc + 32 + 8 * g + 4 * hi);
#pragma unroll
                            for (int e = 0; e < 4; ++e) {
                                o1[e][4 * g] *= f1.x; o1[e][4 * g + 1] *= f1.y; o1[e][4 * g + 2] *= f1.z; o1[e][4 * g + 3] *= f1.w;
                                o2[e][4 * g] *= f2.x; o2[e][4 * g + 1] *= f2.y; o2[e][4 * g + 2] *= f2.z; o2[e][4 * g + 3] *= f2.w;
                            }
                        }
                        asm volatile("s_waitcnt lgkmcnt(0)" ::: "memory");
                    }
                    float s1 = 0.f, s2 = 0.f;
#pragma unroll
                    for (int r = 0; r < 16; ++r) { st1[r] = __builtin_amdgcn_exp2f(st1[r] - m1); s1 += st1[r]; st2[r] = __builtin_amdgcn_exp2f(st2[r] - m2); s2 += st2[r]; }
                    l1 += s1; l2 += s2;
                    const unsigned char* vb = buf + 16384 + vtr + (2 * kh) * 1024;
#pragma unroll
                    for (int s2i = 0; s2i < 2; ++s2i) {
                        union { unsigned u[4]; bf16x8_t v; } pa, pb;
#pragma unroll
                        for (int w = 0; w < 4; ++w) { pa.u[w] = cvtpk(st1[8 * s2i + 2 * w], st1[8 * s2i + 2 * w + 1]); pb.u[w] = cvtpk(st2[8 * s2i + 2 * w], st2[8 * s2i + 2 * w + 1]); }
#pragma unroll
                        for (int e = 0; e < 4; ++e) {
                            const s16x4_t lo = __builtin_bit_cast(s16x4_t, __builtin_amdgcn_ds_read_tr16_b64_v4i16((__attribute__((address_space(3))) s16x4_t*)(unsigned)(uintptr_t)(vb + e * 4096 + s2i * 1024)));
                            const s16x4_t hh = __builtin_bit_cast(s16x4_t, __builtin_amdgcn_ds_read_tr16_b64_v4i16((__attribute__((address_space(3))) s16x4_t*)(unsigned)(uintptr_t)(vb + e * 4096 + s2i * 1024 + 512)));
                            const bf16x8_t bv = (bf16x8_t){lo[0], lo[1], lo[2], lo[3], hh[0], hh[1], hh[2], hh[3]};
                            o1[e] = __builtin_amdgcn_mfma_f32_32x32x16_bf16(pa.v, bv, o1[e], 0, 0, 0);
                            o2[e] = __builtin_amdgcn_mfma_f32_32x32x16_bf16(pb.v, bv, o2[e], 0, 0, 0);
                        }
                    }
                }
                asm volatile("s_waitcnt vmcnt(0)" ::: "memory");
                __syncthreads();
            }
            { const auto ra = __builtin_amdgcn_permlane32_swap(__float_as_uint(l1), __float_as_uint(l1), false, false); l1 = __uint_as_float(ra[0]) + __uint_as_float(ra[1]);
              const auto rb = __builtin_amdgcn_permlane32_swap(__float_as_uint(l2), __float_as_uint(l2), false, false); l2 = __uint_as_float(rb[0]) + __uint_as_float(rb[1]); }
            if (hi == 0) ((float4*)stat)[wave * 32 + lq] = make_float4(m1, l1, m2, l2);
            __syncthreads();
            float lam;
            { float l01 = lam_par[lane] * lam_par[64 + lane], l23 = lam_par[128 + lane] * lam_par[192 + lane];
              l01 = wave_sum_fast(l01); l23 = wave_sum_fast(l23); lam = __expf(l01) - __expf(l23) + lambda_init; }
            if (hi == 0) {
                const float4 pb = ((const float4*)stat)[(wave ^ 1) * 32 + lq];
                const float M1 = fmaxf(m1, pb.x), M2 = fmaxf(m2, pb.z);
                const float e1 = __builtin_amdgcn_exp2f(m1 - M1), e2 = __builtin_amdgcn_exp2f(m2 - M2);
                const float L1 = l1 * e1 + pb.y * __builtin_amdgcn_exp2f(pb.x - M1), L2 = l2 * e2 + pb.w * __builtin_amdgcn_exp2f(pb.z - M2);
                ftab[lq] = e1 / L1; ftab[32 + lq] = -lam * e2 / L2;
            }
            asm volatile("s_waitcnt lgkmcnt(0)" ::: "memory");
#pragma unroll
            for (int g = 0; g < 4; ++g) {
                const float4 f1 = *(const float4*)(ftab + 8 * g + 4 * hi), f2 = *(const float4*)(ftab + 32 + 8 * g + 4 * hi);
#pragma unroll
                for (int e = 0; e < 4; ++e) {
                    o1[e][4 * g] = o1[e][4 * g] * f1.x + o2[e][4 * g] * f2.x; o1[e][4 * g + 1] = o1[e][4 * g + 1] * f1.y + o2[e][4 * g + 1] * f2.y;
                    o1[e][4 * g + 2] = o1[e][4 * g + 2] * f1.z + o2[e][4 * g + 2] * f2.z; o1[e][4 * g + 3] = o1[e][4 * g + 3] * f1.w + o2[e][4 * g + 3] * f2.w;
                }
            }
            __syncthreads();
            float* ox = (float*)ldsb;
            if (kh == 1) {
#pragma unroll
                for (int e = 0; e < 4; ++e)
#pragma unroll
                    for (int r = 0; r < 16; ++r) ox[((qg * 4 + e) * 16 + r) * 64 + lane] = o1[e][r];
            }
            __syncthreads();
            if (kh == 0) {
                float ss[16];
#pragma unroll
                for (int r = 0; r < 16; ++r) ss[r] = 0.f;
#pragma unroll
                for (int e = 0; e < 4; ++e)
#pragma unroll
                    for (int r = 0; r < 16; ++r) { o1[e][r] += ox[((qg * 4 + e) * 16 + r) * 64 + lane]; ss[r] += o1[e][r] * o1[e][r]; }
                const int ln = olane(), lq2 = ln & 31, hi2 = ln >> 5;
                char* mb_ = (char*)(mix + (size_t)(b * SEQ + r0) * D + h * 128);
#pragma unroll
                for (int r = 0; r < 16; ++r) {
#pragma unroll
                    for (int of = 1; of < 32; of <<= 1) ss[r] += shfl_idx(ss[r], ln ^ of);
                    ss[r] = rsqrtf(ss[r] * (1.f / 128.f) + 1e-6f) * (1.f - lambda_init);
                }
#pragma unroll
                for (int e = 0; e < 4; ++e) {
                    const float g = subln[e * 32 + lq2];
#pragma unroll
                    for (int r = 0; r < 16; ++r) {
                        const unsigned q = (unsigned)((r & 3) + 8 * (r >> 2) + 4 * hi2);
                        *(bf16*)(mb_ + (q * D + e * 32 + lq2) * 2u) = (bf16)f2bf(o1[e][r] * ss[r] * g);
                    }
                }
            }
        }
    }
#undef ATT_DMA
#undef VDST
}

typedef float f32x4_t __attribute__((ext_vector_type(4)));
constexpr int PL_STRIDE = 1536 + 16, AL_STRIDE = 512 + 16;
constexpr int PREP_PL = 0, PREP_AL = 64 * PL_STRIDE, PREP_KS = PREP_AL + 64 * AL_STRIDE;
__device__ __forceinline__ void rwkv_prep_phase(unsigned char* ldsb, const bf16* proj, const float* mu, const float* w0, const bf16* w2T, const float* a0, const bf16* a2T, const bf16* g2T,
                                                const float* k_k, const float* k_a, float* RW) {
    const int tidx = otid(), bidx = obid(), gdim = ogdim();
    const int wave = tidx >> 6, lane = tidx & 63, fr = lane & 15, fq = lane >> 4;
    constexpr size_t AS = (size_t)T * 256;
#pragma unroll 1
    for (int u = bidx; u < T / 64; u += gdim) {
        const int t0 = u * 64;
        __syncthreads();
#pragma unroll 2
        for (int i = 0; i < 16; ++i) {
            const int id = tidx + 512 * i, tok = id >> 7, cc = id & 127, c = cc * 8, t = t0 + tok;
            const bf16* src = proj + (size_t)t * IN_COLS + A_COLS + c;
            const uint4 cu = *(const uint4*)src;
            uint4 pv = make_uint4(0u, 0u, 0u, 0u);
            if ((t & (SEQ - 1)) != 0) pv = *(const uint4*)(src - IN_COLS);
            const float4 m0 = *(const float4*)(mu + c), m1 = *(const float4*)(mu + c + 4);
            const unsigned cw[4] = {cu.x, cu.y, cu.z, cu.w}, pw[4] = {pv.x, pv.y, pv.z, pv.w};
            const float mm[8] = {m0.x, m0.y, m0.z, m0.w, m1.x, m1.y, m1.z, m1.w};
            float p[8];
#pragma unroll
            for (int j = 0; j < 4; ++j) {
                const float c0 = __uint_as_float(cw[j] << 16), c1 = __uint_as_float(cw[j] & 0xffff0000u), p0 = __uint_as_float(pw[j] << 16), p1 = __uint_as_float(pw[j] & 0xffff0000u);
                p[2 * j] = c0 + (p0 - c0) * mm[2 * j]; p[2 * j + 1] = c1 + (p1 - c1) * mm[2 * j + 1];
            }
            unsigned char* dst;
            if (c < 768) dst = ldsb + PREP_PL + tok * PL_STRIDE + c * 2;
            else {
                dst = ldsb + PREP_AL + tok * AL_STRIDE + (c - 768) * 2;
                if (c < 832) {
#pragma unroll
                    for (int j = 0; j < 8; ++j) { const float e2 = __expf(2.f * p[j]); p[j] = 1.f - 2.f / (e2 + 1.f); }
                } else if (c >= 896) {
#pragma unroll
                    for (int j = 0; j < 8; ++j) p[j] = 1.f / (1.f + __expf(-p[j]));
                }
            }
            *(uint4*)dst = make_uint4(pk2(p[0], p[1]), pk2(p[2], p[3]), pk2(p[4], p[5]), pk2(p[6], p[7]));
        }
        __syncthreads();
        if (tidx < 256) {
            const int tok = tidx >> 2, hd = tidx & 3;
            const unsigned char* kp = ldsb + PREP_PL + tok * PL_STRIDE + (256 + hd * 64) * 2;
            float ss = 0.f;
#pragma unroll 4
            for (int j = 0; j < 64; j += 2) { const unsigned w = *(const unsigned*)(kp + j * 2); const float2 kk2 = *(const float2*)(k_k + hd * 64 + j);
                const float x0 = __uint_as_float(w << 16) * kk2.x, x1 = __uint_as_float(w & 0xffff0000u) * kk2.y; ss += x0 * x0 + x1 * x1; }
            ((float*)(ldsb + PREP_KS))[tok * 4 + hd] = ss;
        }
        __syncthreads();
        const int n0 = wave * 32, hd = wave >> 1;
        bf16x8_t bw[2][2], ba[2][2], bg[2][4];
#pragma unroll
        for (int ct = 0; ct < 2; ++ct) {
            const int n = n0 + 16 * ct + fr;
#pragma unroll
            for (int ks = 0; ks < 2; ++ks) { bw[ct][ks] = *(const bf16x8_t*)(w2T + n * 64 + 32 * ks + 8 * fq); ba[ct][ks] = *(const bf16x8_t*)(a2T + n * 64 + 32 * ks + 8 * fq); }
#pragma unroll
            for (int ks = 0; ks < 4; ++ks) bg[ct][ks] = *(const bf16x8_t*)(g2T + n * 128 + 32 * ks + 8 * fq);
        }
#pragma unroll 1
        for (int rt = 0; rt < 4; ++rt) {
            const unsigned char* ar = ldsb + PREP_AL + (16 * rt + fr) * AL_STRIDE + 16 * fq;
            bf16x8_t af[8];
#pragma unroll
            for (int ks = 0; ks < 8; ++ks) af[ks] = *(const bf16x8_t*)(ar + 64 * ks);
#pragma unroll
            for (int ct = 0; ct < 2; ++ct) {
                f32x4_t cw_ = {0.f, 0.f, 0.f, 0.f}, ca_ = {0.f, 0.f, 0.f, 0.f}, cg_ = {0.f, 0.f, 0.f, 0.f};
#pragma unroll
                for (int ks = 0; ks < 2; ++ks) { cw_ = __builtin_amdgcn_mfma_f32_16x16x32_bf16(af[ks], bw[ct][ks], cw_, 0, 0, 0); ca_ = __builtin_amdgcn_mfma_f32_16x16x32_bf16(af[2 + ks], ba[ct][ks], ca_, 0, 0, 0); }
#pragma unroll
                for (int ks = 0; ks < 4; ++ks) cg_ = __builtin_amdgcn_mfma_f32_16x16x32_bf16(af[4 + ks], bg[ct][ks], cg_, 0, 0, 0);
                const int ch = n0 + 16 * ct + fr;
                const float w0c = w0[ch], a0c = a0[ch], kkc = k_k[ch], kac = k_a[ch];
#pragma unroll
                for (int rg = 0; rg < 4; ++rg) {
                    const int tok = 16 * rt + 4 * fq + rg;
                    const unsigned char* pr = ldsb + PREP_PL + tok * PL_STRIDE + ch * 2;
                    const float r = bf2f(*(const bf16*)pr), k = bf2f(*(const bf16*)(pr + 512)), v = bf2f(*(const bf16*)(pr + 1024));
                    const float zw = w0c + cw_[rg];
                    const float sp = (-zw > 20.f) ? -zw : __logf(1.f + __expf(-zw));
                    const float decay = __expf(-__expf(-sp - 0.5f));
                    const float a = 1.f / (1.f + __expf(-(a0c + ca_[rg])));
                    const float ss = ((const float*)(ldsb + PREP_KS))[tok * 4 + hd];
                    const float kk = k * kkc * rsqrtf(fmaxf(ss, 1e-24f));
                    float* o = RW + (size_t)(t0 + tok) * 256 + ch;
                    o[0] = r; o[AS] = decay; o[2 * AS] = k * (1.f + (a - 1.f) * kac); o[3 * AS] = v; o[4 * AS] = -kk; o[5 * AS] = kk * a; o[6 * AS] = cg_[rg];
                }
            }
        }
    }
}


template <int CTRL> __device__ __forceinline__ float dpp_f(float v) { return __int_as_float(__builtin_amdgcn_update_dpp(0, __float_as_int(v), CTRL, 0xF, 0xF, false)); }
constexpr int VT_STRIDE = 256 + 16;
__device__ __forceinline__ float gelu_fast(float x) { const float u = 1.5957691216057308f * (x + 0.044715f * x * x * x); return x / (1.f + __expf(-u)); }
__device__ __forceinline__ void gmlp_phase(unsigned char* ldsb, const bf16* proj, const float* ln_g, const float* ln_b, const bf16* wsb, const float* b_s, bf16* mix, int bidx, int gdim) {
    const int tidx = otid();
    const int wave = tidx >> 6, lane = tidx & 63, fr = lane & 15, fq = lane >> 4;
#pragma unroll 1
    for (int u = bidx; u < T / CHUNK; u += gdim) {
        const int t0 = u * CHUNK;
        __syncthreads();
        {
            const int tok = tidx >> 2, qd = tidx & 3;
            const bf16* pv = proj + (size_t)(t0 + tok) * IN_COLS + A_COLS + B_COLS + 256 + qd * 64;
            float s1 = 0.f, s2 = 0.f;
#pragma unroll 2
            for (int j = 0; j < 8; ++j) {
                const uint4 w = *(const uint4*)(pv + 8 * j);
                const unsigned ww[4] = {w.x, w.y, w.z, w.w};
#pragma unroll
                for (int i = 0; i < 4; ++i) { const float g0 = gelu_fast(__uint_as_float(ww[i] << 16)), g1 = gelu_fast(__uint_as_float(ww[i] & 0xffff0000u)); s1 += g0 + g1; s2 += g0 * g0 + g1 * g1; }
            }
            s1 += dpp_f<0xB1>(s1); s1 += dpp_f<0x4E>(s1); s2 += dpp_f<0xB1>(s2); s2 += dpp_f<0x4E>(s2);
            const float mean = s1 * (1.f / 256.f), var = fmaxf(s2 * (1.f / 256.f) - mean * mean, 0.f), rstd = rsqrtf(var + 1e-5f);
#pragma unroll 2
            for (int j = 0; j < 8; ++j) {
                const uint4 w = *(const uint4*)(pv + 8 * j);
                const unsigned ww[4] = {w.x, w.y, w.z, w.w};
#pragma unroll
                for (int i = 0; i < 4; ++i) {
                    const int ch = qd * 64 + 8 * j + 2 * i;
                    const float g0 = gelu_fast(__uint_as_float(ww[i] << 16)), g1 = gelu_fast(__uint_as_float(ww[i] & 0xffff0000u));
                    *(bf16*)(ldsb + ch * VT_STRIDE + tok * 2) = (bf16)f2bf((g0 - mean) * rstd * ln_g[ch] + ln_b[ch]);
                    *(bf16*)(ldsb + (ch + 1) * VT_STRIDE + tok * 2) = (bf16)f2bf((g1 - mean) * rstd * ln_g[ch + 1] + ln_b[ch + 1]);
                }
            }
        }
        __syncthreads();
        const int rt = wave, nks = (16 * rt + 15) / 32 + 1;
#pragma unroll 1
        for (int g = 0; g < 4; ++g) {
            bf16x8_t af[4];
#pragma unroll
            for (int ks = 0; ks < 4; ++ks) if (ks < nks) af[ks] = *(const bf16x8_t*)(wsb + ((size_t)g * CHUNK + 16 * rt + fr) * CHUNK + 32 * ks + 8 * fq);
            float bs[4];
#pragma unroll
            for (int rg = 0; rg < 4; ++rg) bs[rg] = b_s[g * CHUNK + 16 * rt + 4 * fq + rg];
#pragma unroll
            for (int ct = 0; ct < 4; ++ct) {
                const int ch = g * 64 + 16 * ct + fr;
                f32x4_t acc = {0.f, 0.f, 0.f, 0.f};
#pragma unroll
                for (int ks = 0; ks < 4; ++ks) if (ks < nks) {
                    const bf16x8_t bv = *(const bf16x8_t*)(ldsb + ch * VT_STRIDE + (32 * ks + 8 * fq) * 2);
                    acc = __builtin_amdgcn_mfma_f32_16x16x32_bf16(af[ks], bv, acc, 0, 0, 0);
                }
#pragma unroll
                for (int rg = 0; rg < 4; ++rg) {
                    const int t = t0 + 16 * rt + 4 * fq + rg;
                    const float uu = gelu_fast(bf2f(proj[(size_t)t * IN_COLS + A_COLS + B_COLS + ch]));
                    mix[(size_t)t * D + A_WIDTH + B_WIDTH + ch] = (bf16)f2bf(uu * (acc[rg] + bs[rg]));
                }
            }
        }
    }
}

typedef float f32x4c __attribute__((ext_vector_type(4)));
constexpr size_t CK_M3 = 0, CK_N2 = 8192, CK_R2 = 16384, CK_Y2 = 18432, CK_G15 = 22528, CK_BYTES = 22784;
__device__ __forceinline__ f32x4c mfma16(bf16x8_t a, bf16x8_t b, f32x4c c) { return __builtin_amdgcn_mfma_f32_16x16x32_bf16(a, b, c, 0, 0, 0); }
__device__ __forceinline__ bf16x8_t ldfrag(const unsigned char* p) { return *(const bf16x8_t*)p; }
constexpr int CP_RT = 0, CP_ATT = 2048, CP_VT = 4096, CP_BHT = 6144, CP_KHT = 8192, CP_AT = 10240, CP_BT = 12288, CP_KT = 14336, CP_G3I = 16384, CP_G4I = 16896, CP_WAVE = 17408;
constexpr int CP_LF = CP_AT, CP_TI = CP_AT + 1024, CP_LAKT = CP_AT + 1536, CP_CI = CP_LF;
constexpr int CP_PT = CP_BT, CP_QT = CP_KT;
__device__ __forceinline__ void chunk_prep(unsigned char* ldsb, const float* RW, unsigned char* CK) {
    const int wave = owave(), bidx = obid(), gdim = ogdim();
    unsigned char* L = ldsb + wave * CP_WAVE;
    constexpr size_t AS = (size_t)T * 256;
#pragma unroll 1
    for (int cid = bidx * 8 + wave; cid < BATCH * 4 * (SEQ / 16); cid += gdim * 8) {
        const int lane = olane(), c = lane & 15, g = lane >> 4;
        const int bh = cid >> 7, ch = cid & 127, b = bh >> 2, h = bh & 3;
        const float* base = RW + (size_t)(b * SEQ + ch * 16) * 256 + h * 64 + lane;
        unsigned char* ck = CK + (size_t)cid * CK_BYTES;
        float gam = 1.f, bt[16], kt[16];
#pragma unroll
        for (int t = 0; t < 16; ++t) {
            const float* p = base + (size_t)t * 256;
            const float r = p[0], w = p[AS], k = p[2 * AS], v = p[3 * AS], a = p[4 * AS], bb = p[5 * AS];
            const float gp = gam; gam *= w;
            const float ig = 1.f / gam;
            bt[t] = bb * ig; kt[t] = k * ig;
            *(bf16*)(L + CP_AT + t * 128 + lane * 2) = (bf16)f2bf(a * gp);
            *(bf16*)(L + CP_RT + t * 128 + lane * 2) = (bf16)f2bf(r * gam);
            *(bf16*)(L + CP_BT + t * 128 + lane * 2) = (bf16)f2bf(bt[t]);
            *(bf16*)(L + CP_KT + t * 128 + lane * 2) = (bf16)f2bf(kt[t]);
            *(bf16*)(L + CP_ATT + lane * 32 + t * 2) = (bf16)f2bf(a * gp);
            *(bf16*)(L + CP_VT + lane * 32 + t * 2) = (bf16)f2bf(v);
        }
#pragma unroll
        for (int t = 0; t < 16; ++t) { *(bf16*)(L + CP_BHT + lane * 32 + t * 2) = (bf16)f2bf(bt[t] * gam); *(bf16*)(L + CP_KHT + lane * 32 + t * 2) = (bf16)f2bf(kt[t] * gam); }
        *(float*)(ck + CK_G15 + lane * 4) = gam;
        asm volatile("s_waitcnt lgkmcnt(0)" ::: "memory");
        const int kq2 = g & 1;
        const bf16x8_t zero8 = {0, 0, 0, 0, 0, 0, 0, 0};
        {
            f32x4c g1 = {0.f, 0.f, 0.f, 0.f}, g2 = g1, g3 = g1, g4 = g1;
#pragma unroll
            for (int ks = 0; ks < 2; ++ks) {
                const int ko = (32 * ks + 8 * g) * 2;
                const bf16x8_t xa = ldfrag(L + CP_AT + c * 128 + ko), xr = ldfrag(L + CP_RT + c * 128 + ko), yb = ldfrag(L + CP_BT + c * 128 + ko), yk = ldfrag(L + CP_KT + c * 128 + ko);
                g1 = mfma16(xa, yb, g1); g2 = mfma16(xa, yk, g2); g3 = mfma16(xr, yb, g3); g4 = mfma16(xr, yk, g4);
            }
            asm volatile("s_waitcnt lgkmcnt(0)" ::: "memory");
            unsigned lk[2] = {0u, 0u};
#pragma unroll
            for (int rg = 0; rg < 4; ++rg) {
                const int t = 4 * g + rg;
                *(float*)(L + CP_LF + (t * 16 + c) * 4) = c < t ? g1[rg] : 0.f;
                const unsigned v2 = f2bf(c < t ? g2[rg] : 0.f); lk[rg >> 1] |= v2 << (16 * (rg & 1));
                *(bf16*)(L + CP_G3I + t * 32 + c * 2) = (bf16)f2bf(c <= t ? g3[rg] : 0.f);
                *(bf16*)(L + CP_G4I + t * 32 + c * 2) = (bf16)f2bf(c <= t ? g4[rg] : 0.f);
            }
            *(uint2*)(L + CP_LAKT + c * 32 + 4 * g * 2) = make_uint2(lk[0], lk[1]);
        }
        asm volatile("s_waitcnt lgkmcnt(0)" ::: "memory");
        {
            float tc[16];
#pragma unroll
            for (int t = 0; t < 16; ++t) {
                float acc = (t == c) ? 1.f : 0.f;
#pragma unroll
                for (int s4 = 0; s4 < t; s4 += 4) {
                    const float4 l4 = *(const float4*)(L + CP_LF + (t * 16 + s4) * 4);
                    acc += l4.x * tc[s4];
                    if (s4 + 1 < t) acc += l4.y * tc[s4 + 1];
                    if (s4 + 2 < t) acc += l4.z * tc[s4 + 2];
                    if (s4 + 3 < t) acc += l4.w * tc[s4 + 3];
                }
                tc[t] = acc;
                if (g == 0) *(bf16*)(L + CP_TI + t * 32 + c * 2) = (bf16)f2bf(acc);
            }
        }
        asm volatile("s_waitcnt lgkmcnt(0)" ::: "memory");
        const bf16x8_t aT = g < 2 ? ldfrag(L + CP_TI + c * 32 + 8 * g * 2) : zero8;
#pragma unroll
        for (int ct = 0; ct < 4; ++ct) {
            const f32x4c z = {0.f, 0.f, 0.f, 0.f};
            const f32x4c p = mfma16(aT, ldfrag(L + CP_ATT + (16 * ct + c) * 32 + 8 * kq2 * 2), z);
            *(uint2*)(L + CP_PT + (16 * ct + c) * 32 + 4 * g * 2) = make_uint2(pk2(p[0], p[1]), pk2(p[2], p[3]));
        }
        {
            const f32x4c z = {0.f, 0.f, 0.f, 0.f};
            const f32x4c cm = mfma16(aT, ldfrag(L + CP_LAKT + c * 32 + 8 * kq2 * 2), z);
#pragma unroll
            for (int rg = 0; rg < 4; ++rg) *(bf16*)(L + CP_CI + (4 * g + rg) * 32 + c * 2) = (bf16)f2bf(cm[rg]);
        }
        asm volatile("s_waitcnt lgkmcnt(0)" ::: "memory");
        {
            const bf16x8_t aC = g < 2 ? ldfrag(L + CP_CI + c * 32 + 8 * g * 2) : zero8;
#pragma unroll
            for (int ct = 0; ct < 4; ++ct) {
                const f32x4c z = {0.f, 0.f, 0.f, 0.f};
                const f32x4c q = mfma16(aC, ldfrag(L + CP_VT + (16 * ct + c) * 32 + 8 * kq2 * 2), z);
                *(uint2*)(L + CP_QT + (16 * ct + c) * 32 + 4 * g * 2) = make_uint2(pk2(q[0], q[1]), pk2(q[2], q[3]));
            }
        }
        asm volatile("s_waitcnt lgkmcnt(0)" ::: "memory");
        {
            const bf16x8_t aG3 = g < 2 ? ldfrag(L + CP_G3I + c * 32 + 8 * g * 2) : zero8;
            const bf16x8_t aG34 = g < 2 ? ldfrag(L + CP_G3I + c * 32 + 8 * g * 2) : ldfrag(L + CP_G4I + c * 32 + 8 * (g - 2) * 2);
#pragma unroll
            for (int ct = 0; ct < 4; ++ct) {
                f32x4c r2;
#pragma unroll
                for (int rg = 0; rg < 4; ++rg) r2[rg] = bf2f(*(const bf16*)(L + CP_RT + (4 * g + rg) * 128 + (16 * ct + c) * 2));
                r2 = mfma16(aG3, ldfrag(L + CP_PT + (16 * ct + c) * 32 + 8 * kq2 * 2), r2);
                const int pp = 32 * (ct >> 1) + 8 * (c >> 2) + 4 * (ct & 1) + (c & 3);
#pragma unroll
                for (int rg = 0; rg < 4; ++rg) *(bf16*)(L + CP_ATT + ((4 * g + rg) * 64 + pp) * 2) = (bf16)f2bf(r2[rg]);
                const bf16x8_t bqv = g < 2 ? ldfrag(L + CP_QT + (16 * ct + c) * 32 + 8 * g * 2) : ldfrag(L + CP_VT + (16 * ct + c) * 32 + 8 * (g - 2) * 2);
                const f32x4c z = {0.f, 0.f, 0.f, 0.f};
                const f32x4c y2 = mfma16(aG34, bqv, z);
                *(f32x4c*)(ck + CK_Y2 + (ct * 64 + lane) * 16) = y2;
            }
        }
        asm volatile("s_waitcnt lgkmcnt(0)" ::: "memory");
        { const uint4 v0 = *(const uint4*)(L + CP_ATT + lane * 16), v1 = *(const uint4*)(L + CP_ATT + 1024 + lane * 16);
          *(uint4*)(ck + CK_R2 + lane * 16) = v0; *(uint4*)(ck + CK_R2 + 1024 + lane * 16) = v1; }
        asm volatile("s_waitcnt lgkmcnt(0)" ::: "memory");
#pragma unroll 1
        for (int jt = 0; jt < 4; ++jt) {
            const bf16x8_t aB = g < 2 ? ldfrag(L + CP_BHT + (16 * jt + c) * 32 + 8 * g * 2) : zero8;
            const bf16x8_t aBK = g < 2 ? ldfrag(L + CP_BHT + (16 * jt + c) * 32 + 8 * g * 2) : ldfrag(L + CP_KHT + (16 * jt + c) * 32 + 8 * (g - 2) * 2);
#pragma unroll
            for (int ct = 0; ct < 4; ++ct) {
                const f32x4c z = {0.f, 0.f, 0.f, 0.f};
                const f32x4c m2 = mfma16(aB, ldfrag(L + CP_PT + (16 * ct + c) * 32 + 8 * kq2 * 2), z);
                const int pp = 32 * (ct >> 1) + 8 * (c >> 2) + 4 * (ct & 1) + (c & 3);
#pragma unroll
                for (int rg = 0; rg < 4; ++rg) *(bf16*)(L + CP_ATT + ((4 * g + rg) * 64 + pp) * 2) = (bf16)f2bf(m2[rg]);
                const bf16x8_t bqv = g < 2 ? ldfrag(L + CP_QT + (16 * ct + c) * 32 + 8 * g * 2) : ldfrag(L + CP_VT + (16 * ct + c) * 32 + 8 * (g - 2) * 2);
                const f32x4c n2 = mfma16(aBK, bqv, z);
                *(uint2*)(ck + CK_N2 + ((ct * 4 + jt) * 64 + lane) * 8) = make_uint2(pk2(n2[0], n2[1]), pk2(n2[2], n2[3]));
            }
            asm volatile("s_waitcnt lgkmcnt(0)" ::: "memory");
            { const uint4 v0 = *(const uint4*)(L + CP_ATT + lane * 16), v1 = *(const uint4*)(L + CP_ATT + 1024 + lane * 16);
              *(uint4*)(ck + CK_M3 + jt * 2048 + lane * 16) = v0; *(uint4*)(ck + CK_M3 + jt * 2048 + 1024 + lane * 16) = v1; }
            asm volatile("s_waitcnt lgkmcnt(0)" ::: "memory");
        }
        asm volatile("s_waitcnt lgkmcnt(0)" ::: "memory");
    }
}
struct CkOps { bf16x8_t am[4][2], ar[2]; f32x4c y; uint2 n2[4]; f32x4c g15[4]; };
__device__ __forceinline__ void ck_load(CkOps& o, const unsigned char* ck, int it, int lane, int c, int g) {
#pragma unroll
    for (int ks = 0; ks < 2; ++ks) {
        o.ar[ks] = *(const bf16x8_t*)(ck + CK_R2 + (c * 64 + 32 * ks + 8 * g) * 2);
#pragma unroll
        for (int jt = 0; jt < 4; ++jt) o.am[jt][ks] = *(const bf16x8_t*)(ck + CK_M3 + ((16 * jt + c) * 64 + 32 * ks + 8 * g) * 2);
    }
    o.y = *(const f32x4c*)(ck + CK_Y2 + (it * 64 + lane) * 16);
#pragma unroll
    for (int jt = 0; jt < 4; ++jt) { o.n2[jt] = *(const uint2*)(ck + CK_N2 + ((it * 4 + jt) * 64 + lane) * 8); o.g15[jt] = *(const f32x4c*)(ck + CK_G15 + (16 * jt + 4 * g) * 4); }
}
__device__ __forceinline__ void ck_step(const CkOps& o, f32x4c (&hs)[4], float* yp, int ch, int g) {
    bf16x8_t hb[2];
#pragma unroll
    for (int ks = 0; ks < 2; ++ks) {
        union { unsigned u[4]; bf16x8_t v; } t_;
        t_.u[0] = cvtpk(hs[2 * ks][0], hs[2 * ks][1]); t_.u[1] = cvtpk(hs[2 * ks][2], hs[2 * ks][3]); t_.u[2] = cvtpk(hs[2 * ks + 1][0], hs[2 * ks + 1][1]); t_.u[3] = cvtpk(hs[2 * ks + 1][2], hs[2 * ks + 1][3]);
        hb[ks] = t_.v;
    }
    f32x4c y = mfma16(o.ar[0], hb[0], o.y); y = mfma16(o.ar[1], hb[1], y);
#pragma unroll
    for (int rg = 0; rg < 4; ++rg) yp[(size_t)(ch * 16 + 4 * g + rg) * 256] = y[rg];
#pragma unroll
    for (int jt = 0; jt < 4; ++jt) {
        f32x4c a = hs[jt] * o.g15[jt];
        a[0] += __uint_as_float(o.n2[jt].x << 16); a[1] += __uint_as_float(o.n2[jt].x & 0xffff0000u); a[2] += __uint_as_float(o.n2[jt].y << 16); a[3] += __uint_as_float(o.n2[jt].y & 0xffff0000u);
        a = mfma16(o.am[jt][0], hb[0], a); a = mfma16(o.am[jt][1], hb[1], a);
        hs[jt] = a;
    }
}
__device__ __forceinline__ void chunk_scan(const unsigned char* CK, float* Yout, int unit) {
    const int lane = olane(), c = lane & 15, g = lane >> 4;
    const int bh = unit >> 2, it = unit & 3, b = bh >> 2, h = bh & 3;
    f32x4c hs[4];
#pragma unroll
    for (int jt = 0; jt < 4; ++jt) hs[jt] = (f32x4c){0.f, 0.f, 0.f, 0.f};
    const unsigned char* ck = CK + (size_t)(bh * 128) * CK_BYTES;
    float* yp = Yout + (size_t)(b * SEQ) * 256 + h * 64 + 16 * it + c;
    CkOps oa, ob;
    ck_load(oa, ck, it, lane, c, g);
#pragma unroll 1
    for (int ch = 0; ch < SEQ / 16; ch += 2) {
        ck_load(ob, ck + CK_BYTES, it, lane, c, g);
        ck_step(oa, hs, yp, ch, g);
        ck_load(oa, ck + (ch + 2 < SEQ / 16 ? 2 : 0) * CK_BYTES, it, lane, c, g);
        ck_step(ob, hs, yp, ch + 1, g);
        ck += 2 * CK_BYTES;
    }
}


constexpr int LC_NS = 6, LC_SLOT = 13824, LC_R2 = 8192, LC_N2 = 10240, LC_Y2 = 12288, LC_G15 = 13312, LC_FLAGS = LC_NS * LC_SLOT;
__device__ __forceinline__ void lc_dma16(const void* gsrc, unsigned lds_dst) { unsigned keep;
    asm volatile("s_mov_b32 %0, m0\n\ts_mov_b32 m0, %2\n\ts_nop 0\n\tglobal_load_lds_dwordx4 %1, off\n\ts_mov_b32 m0, %0" : "=&s"(keep) : "v"(gsrc), "s"(lds_dst) : "memory"); }
__device__ __forceinline__ void lc_dma4(const void* gsrc, unsigned lds_dst) { unsigned keep;
    asm volatile("s_mov_b32 %0, m0\n\ts_mov_b32 m0, %2\n\ts_nop 0\n\tglobal_load_lds_dword %1, off\n\ts_mov_b32 m0, %0" : "=&s"(keep) : "v"(gsrc), "s"(lds_dst) : "memory"); }
__device__ __forceinline__ void chunk_scan_lc(unsigned char* ldsb, const unsigned char* CK, float* Yout, int unit, int wv) {
    typedef volatile __attribute__((address_space(3))) unsigned vlds_u32;
    vlds_u32* flags = (vlds_u32*)(unsigned)(uintptr_t)(ldsb + LC_FLAGS);
    const unsigned ring = (unsigned)(uintptr_t)ldsb;
    const int lane = olane(), c = lane & 15, g = lane >> 4;
    const int bh = unit >> 2, it = unit & 3, b = bh >> 2, h = bh & 3;
    const unsigned char* ck0 = CK + (size_t)(bh * 128) * CK_BYTES;
    if (wv >= 1 && wv <= 3) {
#pragma unroll 1
        for (int ch = 0; ch < SEQ / 16; ++ch) {
            while ((int)flags[4] + LC_NS <= ch) __builtin_amdgcn_s_sleep(1);
            const unsigned char* ck = ck0 + (size_t)ch * CK_BYTES;
            const unsigned slot = (unsigned)__builtin_amdgcn_readfirstlane((int)(ring + (unsigned)(ch % LC_NS) * LC_SLOT));
            if (wv == 1) {
#pragma unroll
                for (int i = 0; i < 4; ++i) lc_dma16(ck + CK_M3 + i * 1024 + lane * 16, slot + i * 1024);
                lc_dma16(ck + CK_R2 + lane * 16, slot + LC_R2);
            } else if (wv == 2) {
#pragma unroll
                for (int i = 4; i < 8; ++i) lc_dma16(ck + CK_M3 + i * 1024 + lane * 16, slot + i * 1024);
                lc_dma16(ck + CK_R2 + 1024 + lane * 16, slot + LC_R2 + 1024);
            } else {
                lc_dma16(ck + CK_N2 + it * 2048 + lane * 16, slot + LC_N2); lc_dma16(ck + CK_N2 + it * 2048 + 1024 + lane * 16, slot + LC_N2 + 1024);
                lc_dma16(ck + CK_Y2 + it * 1024 + lane * 16, slot + LC_Y2);
                lc_dma4(ck + CK_G15 + lane * 4, slot + LC_G15);
                lc_dma4(ck + CK_G15 + lane * 4, slot + LC_G15);
            }
            asm volatile("s_waitcnt vmcnt(10)" ::: "memory");
            if (ch >= 2) flags[wv - 1] = (unsigned)(ch - 1);
        }
        asm volatile("s_waitcnt vmcnt(0)" ::: "memory");
        flags[wv - 1] = (unsigned)(SEQ / 16);
    } else if (wv == 0) {
        f32x4c hs[4];
#pragma unroll
        for (int jt = 0; jt < 4; ++jt) hs[jt] = (f32x4c){0.f, 0.f, 0.f, 0.f};
        float* yp = Yout + (size_t)(b * SEQ) * 256 + h * 64 + 16 * it + c;
#pragma unroll 1
        for (int ch = 0; ch < SEQ / 16; ++ch) {
            while ((int)flags[0] <= ch || (int)flags[1] <= ch || (int)flags[2] <= ch) __builtin_amdgcn_s_sleep(1);
            asm volatile("" ::: "memory");
            const unsigned char* sl = ldsb + (ch % LC_NS) * LC_SLOT;
            CkOps o;
#pragma unroll
            for (int ks = 0; ks < 2; ++ks) {
                o.ar[ks] = *(const bf16x8_t*)(sl + LC_R2 + (c * 64 + 32 * ks + 8 * g) * 2);
#pragma unroll
                for (int jt = 0; jt < 4; ++jt) o.am[jt][ks] = *(const bf16x8_t*)(sl + ((16 * jt + c) * 64 + 32 * ks + 8 * g) * 2);
            }
            o.y = *(const f32x4c*)(sl + LC_Y2 + lane * 16);
#pragma unroll
            for (int jt = 0; jt < 4; ++jt) { o.n2[jt] = *(const uint2*)(sl + LC_N2 + (jt * 64 + lane) * 8); o.g15[jt] = *(const f32x4c*)(sl + LC_G15 + (16 * jt + 4 * g) * 4); }
            asm volatile("s_waitcnt lgkmcnt(0)" ::: "memory");
            flags[4] = (unsigned)(ch + 1);
            ck_step(o, hs, yp, ch, g);
        }
    }
}

__device__ __forceinline__ float red16(float v) { v += dpp_f<0xB1>(v); v += dpp_f<0x4E>(v); v += dpp_f<0x141>(v); v += dpp_f<0x140>(v); return v; }
struct ExpW { const float *w1, *w3, *w2, *s1, *s3, *s2; bf16 *WTUP, *WTDN; };
constexpr int CONV_ITEMS = 65 * 384, NCK_CONV = 22, CONV_SCAN = 128 * NCK_CONV * 4;
__device__ __forceinline__ ItemDesc expert_item(const ExpW& X, int it) {
    const int e = it / 384, r = it % 384, which = r >> 7, q = r & 127;
    ItemDesc d;
    if (which < 2) { d.W = which == 0 ? (e < 64 ? X.w1 + (size_t)e * D * DE : X.s1) : (e < 64 ? X.w3 + (size_t)e * D * DE : X.s3);
        const int kb = q >> 3, nb = q & 7, n0 = 32 * nb; d.N = DE; d.WT = X.WTUP + (size_t)e * 512 * D; d.K = D; d.k0 = 64 * kb; d.n0 = n0; d.drow0 = (n0 >> 7) * 256 + which * 128 + (n0 & 127); }
    else { d.W = e < 64 ? X.w2 + (size_t)e * DE * D : X.s2; const int kb = q >> 5, nb = q & 31; d.N = D; d.WT = X.WTDN + (size_t)e * D * DE; d.K = DE; d.k0 = 64 * kb; d.n0 = 32 * nb; d.drow0 = 32 * nb; }
    return d;
}
__device__ __forceinline__ void convert_item(const ExpW& X, int it, float* scr, int lane) {
    const int e = it / 384, r = it % 384, which = r >> 7, q = r & 127;
    if (which < 2) {
        const float* W = which == 0 ? (e < 64 ? X.w1 + (size_t)e * D * DE : X.s1) : (e < 64 ? X.w3 + (size_t)e * D * DE : X.s3);
        const int kb = q >> 3, nb = q & 7, n0 = 32 * nb;
        transpose_item(W, D, DE, X.WTUP + (size_t)e * 512 * D, 64 * kb, n0, (n0 >> 7) * 256 + which * 128 + (n0 & 127), scr, lane);
    } else {
        const float* W = e < 64 ? X.w2 + (size_t)e * DE * D : X.s2;
        const int kb = q >> 5, nb = q & 31;
        transpose_item(W, DE, D, X.WTDN + (size_t)e * D * DE, 64 * kb, 32 * nb, 32 * nb, scr, lane);
    }
}
typedef float f32x2_t __attribute__((ext_vector_type(2)));
__device__ __forceinline__ void rwkv_scan_phase(unsigned char* ldsb, float* RW, int bidx, int gdim, const ExpW& X) {
    const int tidx = otid();
    const int wave = tidx >> 6, lane = tidx & 63, c = lane >> 4, s = lane & 15;
    constexpr int CH = 32, ARRB = CH * 256, BUFB = 6 * ARRB, YOFF = 2 * BUFB;
    const int sstep = tidx >> 4, sq = tidx & 15;
#pragma unroll 1
    for (int u = bidx; u < BATCH * 4 * 4; u += gdim) {
        const int b = u >> 4, h = (u >> 2) & 3, q4 = u & 3, lrow = (wave & 3) * 4 + c, row = q4 * 16 + lrow;
        float* Yg = RW + (size_t)T * 256 * 7 + (size_t)(b * SEQ + sstep) * 256 + h * 64 + q4 * 16 + sq;
        const float* g0 = RW + (size_t)(b * SEQ + sstep) * 256 + h * 64 + sq * 4;
        constexpr size_t AS = (size_t)T * 256;
#define SCAN_LOAD(ckk) do { const float* g_ = g0 + (size_t)(ckk) * CH * 256; pf0 = *(const float4*)(g_ + 4 * AS); pf1 = *(const float4*)(g_ + 5 * AS); pf2 = *(const float4*)(g_ + 1 * AS); \
        pf3 = *(const float4*)(g_ + 2 * AS); pf4 = *(const float4*)(g_); pf5 = *(const float4*)(g_ + 3 * AS); } while (0)
#define SCAN_STORE(bufp) do { unsigned char* d_ = (bufp) + sstep * 256 + sq * 16; *(float4*)(d_) = pf0; *(float4*)(d_ + ARRB) = pf1; *(float4*)(d_ + 2 * ARRB) = pf2; \
        *(float4*)(d_ + 3 * ARRB) = pf3; *(float4*)(d_ + 4 * ARRB) = pf4; *(float4*)(d_ + 5 * ARRB) = pf5; } while (0)
#define SCAN_LOAD_TO(ckk, A0, A1, A2, A3, A4, A5) do { const float* g_ = g0 + (size_t)(ckk) * CH * 256; A0 = *(const float4*)(g_ + 4 * AS); A1 = *(const float4*)(g_ + 5 * AS); A2 = *(const float4*)(g_ + 1 * AS); \
        A3 = *(const float4*)(g_ + 2 * AS); A4 = *(const float4*)(g_); A5 = *(const float4*)(g_ + 3 * AS); } while (0)
#define SCAN_STORE_FROM(bufp, A0, A1, A2, A3, A4, A5) do { unsigned char* d_ = (bufp) + sstep * 256 + sq * 16; *(float4*)(d_) = A0; *(float4*)(d_ + ARRB) = A1; *(float4*)(d_ + 2 * ARRB) = A2; \
        *(float4*)(d_ + 3 * ARRB) = A3; *(float4*)(d_ + 4 * ARRB) = A4; *(float4*)(d_ + 5 * ARRB) = A5; } while (0)
        float4 pf0, pf1, pf2, pf3, pf4, pf5, pg0, pg1, pg2, pg3, pg4, pg5;
        SCAN_LOAD(0);
        SCAN_LOAD_TO(1, pg0, pg1, pg2, pg3, pg4, pg5);
        __syncthreads();
        SCAN_STORE(ldsb);
        __syncthreads();
        f32x2_t s01 = {0.f, 0.f}, s23 = {0.f, 0.f};
        float cv[32]; int pit = -1;
#define SCAN_CHUNK(CKE, LA, LB, LC, LD, LE, LF, SA, SB, SC, SD, SE, SF) do { const int ck = (CKE); \
            const unsigned char* buf = ldsb + (ck & 1) * BUFB; \
            unsigned char* nbuf = ldsb + ((ck + 1) & 1) * BUFB; \
            float* yb = (float*)(ldsb + YOFF + (ck & 1) * (CH * 16 * 4)); \
            const bool more = ck + 1 < SEQ / CH; \
            if (wave >= 4) { \
                float* scr = (float*)(ldsb + YOFF + 2 * CH * 16 * 4) + (wave - 4) * (64 * 36); \
                if (pit >= 0) item_finish(expert_item(X, pit), cv, scr, lane); \
                pit = -1; \
                if (ck < NCK_CONV) { pit = (u * NCK_CONV + ck) * 4 + (wave - 4); item_load(expert_item(X, pit), cv, lane); } \
            } \
            if (ck + 2 < SEQ / CH) SCAN_LOAD_TO(ck + 2, LA, LB, LC, LD, LE, LF); \
            if (wave < 4) { \
_Pragma("unroll 1") \
                for (int t8 = 0; t8 < CH; t8 += 8) { \
                    float yv[8]; \
_Pragma("unroll") \
                    for (int j = 0; j < 8; ++j) { \
                        const unsigned char* bp = buf + (t8 + j) * 256 + s * 16; \
                        const f32x2_t a01 = *(const f32x2_t*)(bp), a23 = *(const f32x2_t*)(bp + 8); \
                        const f32x2_t b01 = *(const f32x2_t*)(bp + ARRB), b23 = *(const f32x2_t*)(bp + ARRB + 8); \
                        const f32x2_t w01 = *(const f32x2_t*)(bp + 2 * ARRB), w23 = *(const f32x2_t*)(bp + 2 * ARRB + 8); \
                        const f32x2_t k01 = *(const f32x2_t*)(bp + 3 * ARRB), k23 = *(const f32x2_t*)(bp + 3 * ARRB + 8); \
                        const f32x2_t r01 = *(const f32x2_t*)(bp + 4 * ARRB), r23 = *(const f32x2_t*)(bp + 4 * ARRB + 8); \
                        const float v = *(const float*)(buf + 5 * ARRB + (t8 + j) * 256 + row * 4); \
                        f32x2_t d = s01 * a01 + s23 * a23; \
                        const float sa = red16(d.x + d.y); \
                        const f32x2_t vv = {v, v}, sv = {sa, sa}; \
                        s01 = (s01 * w01 + vv * k01) + sv * b01; s23 = (s23 * w23 + vv * k23) + sv * b23; \
                        d = s01 * r01 + s23 * r23; \
                        yv[j] = red16(d.x + d.y); \
                    } \
_Pragma("unroll") \
                    for (int j = 0; j < 8; ++j) yb[(t8 + j) * 16 + lrow] = yv[j]; \
                } \
            } \
            if (more) SCAN_STORE_FROM(nbuf, SA, SB, SC, SD, SE, SF); \
            __syncthreads(); \
            Yg[(size_t)ck * CH * 256] = yb[sstep * 16 + sq]; \
        } while (0)
#pragma unroll 1
        for (int ck2 = 0; ck2 < SEQ / CH; ck2 += 2) {
            SCAN_CHUNK(ck2, pf0, pf1, pf2, pf3, pf4, pf5, pg0, pg1, pg2, pg3, pg4, pg5);
            SCAN_CHUNK(ck2 + 1, pg0, pg1, pg2, pg3, pg4, pg5, pf0, pf1, pf2, pf3, pf4, pf5);
        }
#undef SCAN_CHUNK
#undef SCAN_LOAD_TO
#undef SCAN_STORE_FROM
        if (wave >= 4 && pit >= 0) item_finish(expert_item(X, pit), cv, (float*)(ldsb + YOFF + 2 * CH * 16 * 4) + (wave - 4) * (64 * 36), lane);
    }
#undef SCAN_LOAD
#undef SCAN_STORE
}
__device__ __forceinline__ void rwkv_post_phase(const float* RW, const float* r_k, const float* lnx_g, const float* lnx_b, bf16* mix) {
    const int tidx = otid(), bidx = obid(), gdim = ogdim();
    const int lane = tidx & 63, wave = tidx >> 6, stride = gdim * 8;
    constexpr size_t AS = (size_t)T * 256;
    const float4 rk4 = ((const float4*)r_k)[lane], lg4 = ((const float4*)lnx_g)[lane], lb4 = ((const float4*)lnx_b)[lane];
#pragma unroll 1
    for (int t0 = bidx * 8 + wave; t0 < T; t0 += 4 * stride) {
        float4 yv[4], rv[4], kv[4], vv[4], gv[4];
#pragma unroll
        for (int i = 0; i < 4; ++i) {
            const int t = t0 + i * stride < T ? t0 + i * stride : t0;
            const float4* p = (const float4*)(RW + (size_t)t * 256) + lane;
            yv[i] = p[7 * AS / 4]; rv[i] = p[0]; kv[i] = p[2 * AS / 4]; vv[i] = p[3 * AS / 4]; gv[i] = p[6 * AS / 4];
        }
#pragma unroll
        for (int i = 0; i < 4; ++i) {
            const int t = t0 + i * stride;
            const float mean = red16((yv[i].x + yv[i].y) + (yv[i].z + yv[i].w)) * (1.f / 64.f);
            const float4 d = make_float4(yv[i].x - mean, yv[i].y - mean, yv[i].z - mean, yv[i].w - mean);
            const float rstd = rsqrtf(red16(sq4(d)) * (1.f / 64.f) + 64e-5f);
            const float bonus = red16((rv[i].x * kv[i].x * rk4.x + rv[i].y * kv[i].y * rk4.y) + (rv[i].z * kv[i].z * rk4.z + rv[i].w * kv[i].w * rk4.w));
            const float o0 = (d.x * rstd * lg4.x + lb4.x + bonus * vv[i].x) * gv[i].x, o1 = (d.y * rstd * lg4.y + lb4.y + bonus * vv[i].y) * gv[i].y;
            const float o2 = (d.z * rstd * lg4.z + lb4.z + bonus * vv[i].z) * gv[i].z, o3 = (d.w * rstd * lg4.w + lb4.w + bonus * vv[i].w) * gv[i].w;
            if (t < T) ((uint2*)(mix + (size_t)t * D + A_WIDTH))[lane] = make_uint2(pk2(o0, o1), pk2(o2, o3));
        }
    }
}
__device__ __forceinline__ void route_topk(unsigned* hist, const float* logits, const float* ebias, int* top_idx, float* top_w, unsigned* counts) {
    const int tidx = otid(), bidx = obid(), gdim = ogdim();
    const int wave = tidx >> 6, lane = tidx & 63;
    __syncthreads();
    if (tidx < NE) hist[tidx] = 0u;
    __syncthreads();
#pragma unroll 1
    for (int t = bidx * 8 + wave; t < T; t += gdim * 8) {
        const float acc = logits[(size_t)t * 256 + lane];
        const float s = sigmoidf_(acc);
        const float bz = s + ebias[lane];
        int rk = 0;
        const int gbase = lane & ~7;
#pragma unroll
        for (int j = 0; j < 8; ++j) { const float o = shfl_idx(bz, gbase + j); rk += (o > bz || (o == bz && (gbase + j) < lane)) ? 1 : 0; }
        float gs = rk < 2 ? bz : 0.f;
        gs += shfl_idx(gs, lane ^ 1); gs += shfl_idx(gs, lane ^ 2); gs += shfl_idx(gs, lane ^ 4);
        int grk = 0;
        const int myg = lane >> 3;
#pragma unroll
        for (int g = 0; g < 8; ++g) { const float o = rdlane(gs, g * 8); grk += (o > gs || (o == gs && g < myg)) ? 1 : 0; }
        const float masked = grk < 4 ? bz : -INFINITY;
        int rank = 0;
#pragma unroll 8
        for (int j = 0; j < 64; ++j) { const float o = rdlane(masked, j); rank += (o > masked || (o == masked && j < lane)) ? 1 : 0; }
        const bool sel = rank < TOPK;
        const float ssum = wave_sum(sel ? s : 0.f);
        if (sel) {
            top_idx[t * TOPK + rank] = lane;
            top_w[t * TOPK + rank] = s / (ssum + 1e-20f) * 2.5f;
            atomicAdd(&hist[lane], 1u);
        }
    }
    __syncthreads();
    if (tidx < NE && hist[tidx]) atomicAdd(&counts[tidx], hist[tidx]);
}

typedef float f32x2c __attribute__((ext_vector_type(2)));
__device__ __forceinline__ void acc16(float (&y)[16], const uint4& v, float w) {
    const unsigned u[4] = {v.x, v.y, v.z, v.w};
#pragma unroll
    for (int i = 0; i < 4; ++i) {
        const f32x2c lo = __builtin_amdgcn_cvt_pk_f32_fp8((int)u[i], false), hi = __builtin_amdgcn_cvt_pk_f32_fp8((int)u[i], true);
        y[4 * i] += w * lo.x; y[4 * i + 1] += w * lo.y; y[4 * i + 2] += w * hi.x; y[4 * i + 3] += w * hi.y;
    }
}
template <bool NEXT>
__device__ __forceinline__ void combine_phase(const unsigned char* YB, const unsigned char* YS, const int* posi, const float* topw, const float* gy, const float* gate_base, float* x,
                                              const float* gn, const float* modn, bf16* hb) {
    const int tidx = otid(), bidx = obid(), gdim = ogdim();
    const int lane = tidx & 63, wave = tidx >> 6, stride = gdim * 8;
#pragma unroll 1
    for (int row0 = bidx * 8 + wave; row0 < T; row0 += 2 * stride) {
#pragma unroll
        for (int r = 0; r < 2; ++r) {
            const int row = row0 + r * stride;
            if (row < T) {
                const int b = row / SEQ;
                const int4 p0 = *(const int4*)(posi + row * TOPK), p1 = *(const int4*)(posi + row * TOPK + 4);
                const float4 w0 = *(const float4*)(topw + row * TOPK), w1 = *(const float4*)(topw + row * TOPK + 4);
                const int pp[8] = {p0.x, p0.y, p0.z, p0.w, p1.x, p1.y, p1.z, p1.w};
                const float ww[8] = {w0.x, w0.y, w0.z, w0.w, w1.x, w1.y, w1.z, w1.w};
                float y[16];
#pragma unroll
                for (int i = 0; i < 16; ++i) y[i] = 0.f;
                acc16(y, nt_load16((const uint4*)(YS + (size_t)row * D) + lane), 1.f / 16.f);
#pragma unroll
                for (int k = 0; k < TOPK; ++k) acc16(y, nt_load16((const uint4*)(YB + (size_t)pp[k] * D) + lane), ww[k] * (1.f / 16.f));
                float ss = 0.f;
#pragma unroll
                for (int i = 0; i < 16; ++i) ss += y[i] * y[i];
                const float rs = rsqrtf(wave_sum_fast(ss) * (1.f / D) + 1e-6f);
                float xn[16]; float s2 = 0.f;
#pragma unroll
                for (int q = 0; q < 4; ++q) {
                    const int c4 = 4 * lane + q;
                    const float4 gg = ((const float4*)gy)[c4], gt = ((const float4*)(gate_base + (size_t)b * 6 * D))[c4];
                    float4 v = ((const float4*)(x + (size_t)row * D))[c4];
                    v.x += gt.x * y[4 * q] * rs * gg.x; v.y += gt.y * y[4 * q + 1] * rs * gg.y; v.z += gt.z * y[4 * q + 2] * rs * gg.z; v.w += gt.w * y[4 * q + 3] * rs * gg.w;
                    ((float4*)(x + (size_t)row * D))[c4] = v;
                    xn[4 * q] = v.x; xn[4 * q + 1] = v.y; xn[4 * q + 2] = v.z; xn[4 * q + 3] = v.w;
                    s2 += sq4(v);
                }
                if (NEXT) {
                    const float r2 = rsqrtf(wave_sum_fast(s2) * (1.f / D) + 1e-6f);
                    const float* m = modn + (size_t)b * 6 * D;
                    float o[16];
#pragma unroll
                    for (int q = 0; q < 4; ++q) {
                        const int c4 = 4 * lane + q;
                        const float4 gg = ((const float4*)gn)[c4], sc = ((const float4*)(m + D))[c4], sh = ((const float4*)m)[c4];
                        o[4 * q] = xn[4 * q] * r2 * gg.x * (1.f + sc.x) + sh.x; o[4 * q + 1] = xn[4 * q + 1] * r2 * gg.y * (1.f + sc.y) + sh.y;
                        o[4 * q + 2] = xn[4 * q + 2] * r2 * gg.z * (1.f + sc.z) + sh.z; o[4 * q + 3] = xn[4 * q + 3] * r2 * gg.w * (1.f + sc.w) + sh.w;
                    }
                    ((uint4*)(hb + (size_t)row * D))[2 * lane] = make_uint4(pk2(o[0], o[1]), pk2(o[2], o[3]), pk2(o[4], o[5]), pk2(o[6], o[7]));
                    ((uint4*)(hb + (size_t)row * D))[2 * lane + 1] = make_uint4(pk2(o[8], o[9]), pk2(o[10], o[11]), pk2(o[12], o[13]), pk2(o[14], o[15]));
                }
            }
        }
    }
}
__device__ __forceinline__ void build_ps(int* ps, const unsigned* counts) {
    const int tidx = otid(), bidx = obid(), gdim = ogdim();
    __syncthreads();
    if (tidx == 0) {
        int acc = 0;
#pragma unroll 1
        for (int e = 0; e < NE; ++e) { ps[e] = acc; acc += ((int)__hip_atomic_load(&counts[e], __ATOMIC_RELAXED, __HIP_MEMORY_SCOPE_AGENT) + EBLK - 1) / EBLK * EBLK; }
        ps[NE] = acc;
    }
    __syncthreads();
}

__global__ void __launch_bounds__(NT) mk_fwd(Args args) {
    float* lds = (float*)lds_raw;
    if ((threadIdx.x & 63) == 0) *(volatile LAS int*)((LAS unsigned char*)lds_raw + WIDTAB_OFF + 4 * ((unsigned)__builtin_amdgcn_s_getreg(63492) & 63u)) = (int)(threadIdx.x >> 6);
    volatile LAS unsigned* misc = (volatile LAS unsigned*)((LAS unsigned char*)lds_raw + LDS_BYTES - 256);
    int* ps = (int*)(lds_raw + LDS_BYTES - 2048);
    if (threadIdx.x < 64) misc[threadIdx.x] = 0u;
    __syncthreads();
#define XBAR() xcd_barrier(bar)
    if (threadIdx.x < 512) { const int h_ = threadIdx.x >> 7, d_ = threadIdx.x & 127; const float* tb_ = args.in[10];
        ((float*)(lds_raw + BT_OFF))[threadIdx.x] = (tb_[t5_bucket(d_) * A_HEADS + h_] - tb_[31 * A_HEADS + h_]) * 1.4426950408889634f; }
    __syncthreads();
    unsigned* ctl = (unsigned*)(args.ws + WS_CTL);
    XcdBarrier bar = xcd_barrier_post(ctl + CW_BAR, misc);
#define GAS __attribute__((address_space(1)))
#define WSO(off) ((char*)({ char* _w = args.ws; asm volatile("" : "+s"(_w)); (GAS char*)_w + (off); }))
#define CNT ((unsigned*)WSO(WS_CTL) + CW_CNT)
#define CUR ((unsigned*)WSO(WS_CTL) + CW_CUR)
#define MOD ((float*)WSO(WS_MOD))
#define TOPI ((int*)WSO(WS_TOPI))
#define TOPW ((float*)WSO(WS_TOPW))
#define ROWT ((int*)WSO(WS_ROWT))
#define DST ((int*)WSO(WS_DST))
#define RW ((float*)WSO(WS_RW))
#define Y ((float*)WSO(WS_PROJ))
#define CHK ((unsigned char*)WSO(WS_CHK))
#define GU ((float*)WSO(WS_GU))
#define GVN ((float*)WSO(WS_GU) + (size_t)T * 256)
#define HBF ((bf16*)WSO(WS_HBF))
#define WTIN ((bf16*)WSO(WS_WTIN))
#define WTR ((bf16*)WSO(WS_WTR))
#define SMALLW(l_) ((bf16*)WSO(WS_SMALL) + (size_t)(l_) * 131072)
#define LOGIT ((float*)WSO(WS_LOGIT))
#define PROJB ((bf16*)WSO(WS_PROJ))
#define WTOUT ((bf16*)WSO(WS_WTOUT))
#define MIXB ((bf16*)WSO(WS_MIXB))
#define WTUP ((bf16*)WSO(WS_WTUP))
#define WTDN ((bf16*)WSO(WS_WTDN))
#define HBB ((bf16*)WSO(WS_HBB))
#define YB ((bf16*)WSO(WS_YB))
#define YS8 ((unsigned char*)WSO(WS_YS))
#define IN(k) ((const float*)(const GAS float*)args.in[({ int _k = (k); asm volatile("" : "+s"(_k)); _k; })])
#define out ((float*)(GAS float*)args.out)
#define gsz (ogdim() * NT)
#define GTID (obid() * NT + otid())

#pragma unroll 1
    for (int idx = GTID; idx < DEPTH * BATCH * 6 * D; idx += gsz) {
        const int n = idx % (6 * D), b = (idx / (6 * D)) % BATCH, l = idx / (6 * D * BATCH);
        float acc = IN(3)[l * 6 * D + n];
        const float* w = IN(2) + (size_t)l * D * 6 * D + n;
        const float* cr = IN(1) + b * D;
        for (int k = 0; k < D; ++k) acc += siluf_(cr[k]) * w[(size_t)k * 6 * D];
        MOD[idx] = acc;
    }
    {
    for (int l = 0; l < DEPTH; ++l) {
        transpose_matrix(IN(8) + (size_t)l * D * IN_COLS, D, IN_COLS, WTIN + (size_t)l * IN_COLS * D, lds);
        transpose_matrix(IN(9) + (size_t)l * D * D, D, D, WTOUT + (size_t)l * D * D, lds);
        transpose_matrix(IN(28) + (size_t)l * D * NE, D, NE, WTR + (size_t)l * 256 * D, lds);
        transpose_matrix(IN(15) + (size_t)l * 64 * 256, 64, 256, SMALLW(l), lds);
        transpose_matrix(IN(17) + (size_t)l * 64 * 256, 64, 256, SMALLW(l) + 16384, lds);
        transpose_matrix(IN(18) + (size_t)l * 128 * 256, 128, 256, SMALLW(l) + 32768, lds);
#pragma unroll 1
        for (int i = GTID; i < 4 * CHUNK * CHUNK; i += gsz) { const int s_ = i & 127, t_ = (i >> 7) & 127; (SMALLW(l) + 65536)[i] = (bf16)(s_ <= t_ ? f2bf((IN(26) + (size_t)l * 4 * CHUNK * CHUNK)[i]) : 0u); }
#pragma unroll 1
        for (int i = GTID; i < 192 * D / 8; i += gsz) ((uint4*)(WTR + (size_t)l * 256 * D + 64 * D))[i] = make_uint4(0u, 0u, 0u, 0u);
    }
    }
    XBAR();

#define xin (l == 0 ? IN(0) : (const float*)out)
#pragma unroll 1
    for (int l_ = 0; l_ < DEPTH; ++l_) {
        int l = l_; asm volatile("" : "+s"(l));
#define mod_l (MOD + (size_t)l * BATCH * 6 * D)
        const float lambda_init = l == 0 ? 0.2f : 0.8f - 0.6f * 0.7408182206817179f;
        if (l == 0) { row_phase<false, true>(xin, nullptr, nullptr, nullptr, nullptr, IN(4) + l * D, mod_l, 0, 1, HBF);
        XBAR(); }
        {
            pg8::Gemm g{HBF, WTIN + (size_t)l * IN_COLS * D, T, IN_COLS, D}; pg8::StaticOrder S; S.init(T, IN_COLS, ogdim(), obid());
            pg8::EpiBf16<0> E{PROJB, IN_COLS, nullptr, 0, 0, 1.f};
            pg8::gemm_phase<pg8::EpiBf16<0>, pg8::StaticOrder, true>((LAS unsigned char*)lds_raw, g, S, E);
        }
        XBAR();
        rwkv_prep_phase(lds_raw, PROJB, IN(13) + l * B_COLS, IN(14) + l * 256, SMALLW(l), IN(16) + l * 256, SMALLW(l) + 16384, SMALLW(l) + 32768, IN(19) + l * 256, IN(20) + l * 256, RW);
        XBAR();
        chunk_prep(lds_raw, RW, CHK);
        XBAR();
        {
            const int G_ = ogdim(), b_ = obid();
            if (b_ < 128) {
                const int wv_ = owave();
                if (otid() < 8) ((volatile LAS unsigned*)((LAS unsigned char*)lds_raw + LC_FLAGS))[otid()] = 0u;
                __syncthreads();
                if (wv_ < 4) chunk_scan_lc(lds_raw, CHK, RW + (size_t)T * 256 * 7, b_, wv_);
            }
            __syncthreads();
            attn_flash(lds_raw, PROJB, IN(11) + l * 256, IN(12) + l * 128, lambda_init, MIXB, b_, G_);
            __syncthreads();
            gmlp_phase(lds_raw, PROJB, IN(24) + l * 256, IN(25) + l * 256, SMALLW(l) + 65536, IN(27) + l * 4 * CHUNK, MIXB, b_ >= G_ / 2 ? b_ - G_ / 2 : b_ + G_ / 2, G_);
            __syncthreads();
            {
                const ExpW X{IN(30) + (size_t)l * NE * D * DE, IN(31) + (size_t)l * NE * D * DE, IN(32) + (size_t)l * NE * DE * D, IN(33) + (size_t)l * D * DE, IN(34) + (size_t)l * D * DE, IN(35) + (size_t)l * DE * D, WTUP, WTDN};
                const int wv_ = owave(), ln_ = olane(), st_ = G_ * 8;
                float* scr = lds + wv_ * (64 * 32);
                float ca[32], cb[32];
                const int it0 = b_ * 8 + wv_;
                item_load(expert_item(X, it0 < CONV_ITEMS ? it0 : CONV_ITEMS - 1), ca, ln_);
#pragma unroll 1
                for (int it = it0; it < CONV_ITEMS; it += 2 * st_) {
                    const int i1 = it + st_, i2 = it + 2 * st_;
                    item_load(expert_item(X, i1 < CONV_ITEMS ? i1 : CONV_ITEMS - 1), cb, ln_);
                    item_finish(expert_item(X, it), ca, scr, ln_);
                    item_load(expert_item(X, i2 < CONV_ITEMS ? i2 : CONV_ITEMS - 1), ca, ln_);
                    if (i1 < CONV_ITEMS) item_finish(expert_item(X, i1), cb, scr, ln_);
                }
            }
        }
        XBAR();
        rwkv_post_phase(RW, IN(21) + l * 256, IN(22) + l * 256, IN(23) + l * 256, MIXB);
        XBAR();
        {
            pg8::Gemm g{MIXB, WTOUT + (size_t)l * D * D, T, D, D}; pg8::StaticOrder S; S.init(T, D, ogdim(), obid());
            pg8::EpiBf16<0> E{(bf16*)Y, D, nullptr, 0, 0, 1.f};
            pg8::gemm_phase<pg8::EpiBf16<0>, pg8::StaticOrder, false>((LAS unsigned char*)lds_raw, g, S, E);
        }
        XBAR();
        row_phase<true, true>(xin, (const bf16*)Y, IN(5) + l * D, mod_l + 2 * D, out, IN(6) + l * D, mod_l, 3, 4, HBF);
#pragma unroll 1
        for (int i = GTID; i < P; i += gsz) ROWT[i] = 0;
        { const int t_ = otid(); if (obid() == 0 && t_ < NE) { CNT[t_] = 0u; CUR[t_] = 0u; } }
        XBAR();
        {
            pg8::Gemm g{HBF, WTR + (size_t)l * 256 * D, T, 256, D}; pg8::StaticOrder S; S.init(T, 256, ogdim(), obid());
            pg8::EpiF32 E{LOGIT, 256};
            pg8::gemm_phase<pg8::EpiF32, pg8::StaticOrder, false>((LAS unsigned char*)lds_raw, g, S, E);
        }
        {
            const int G_ = ogdim(); int c_ = obid() - 64; if (c_ < 0) c_ += G_;
            pg8::Gemm g{HBF, WTUP + (size_t)64 * 512 * D, T, 512, D}; pg8::StaticOrder S; S.init(T, 512, G_, c_);
            pg8::EpiSwiGLU E{HBB + (size_t)P * 256};
            pg8::gemm_phase<pg8::EpiSwiGLU, pg8::StaticOrder, false>((LAS unsigned char*)lds_raw, g, S, E);
        }
        XBAR();
        route_topk((unsigned*)lds_raw, LOGIT, IN(29) + l * NE, TOPI, TOPW, CNT);
        XBAR();
        build_ps(ps, CNT);
        {
            unsigned* lc = (unsigned*)lds_raw; unsigned* lb = lc + 64; unsigned* lc2 = lc + 128;
            const int t_ = otid();
            if (t_ < NE) { lc[t_] = 0u; lc2[t_] = 0u; }
            __syncthreads();
#pragma unroll 1
            for (int i = GTID; i < T * TOPK; i += gsz) atomicAdd(&lc[TOPI[i]], 1u);
            __syncthreads();
            if (t_ < NE) lb[t_] = lc[t_] ? atomicAdd(&CUR[t_], lc[t_]) : 0u;
            __syncthreads();
#pragma unroll 1
            for (int i = GTID; i < T * TOPK; i += gsz) {
                const int e = TOPI[i];
                const int pos = ps[e] + (int)(lb[e] + atomicAdd(&lc2[e], 1u));
                ROWT[pos] = i / TOPK; DST[i] = pos;
            }
        }
        XBAR();
        {
            pg8::Gemm g{HBF, WTUP, 0, 512, D}; pg8::GroupedOrder S; S.init(ps, 2, ogdim(), obid(), ROWT, (size_t)512 * D * 2, NBLK, 0);
            pg8::EpiSwiGLU E{HBB};
            pg8::gemm_phase<pg8::EpiSwiGLU, pg8::GroupedOrder, true>((LAS unsigned char*)lds_raw, g, S, E);
        }
        XBAR();
        {
            pg8::Gemm g{HBB, WTDN, 0, D, DE}; pg8::GroupedOrder S; S.init(ps, 4, ogdim(), obid(), nullptr, (size_t)D * DE * 2, NBLK, T / 256);
            pg8::EpiRows E{(unsigned char*)YB, YS8, NBLK};
            pg8::gemm_phase<pg8::EpiRows, pg8::GroupedOrder, true>((LAS unsigned char*)lds_raw, g, S, E);
        }
        XBAR();
        if (l + 1 < DEPTH) combine_phase<true>((const unsigned char*)YB, YS8, DST, TOPW, IN(7) + l * D, mod_l + 5 * D, out, IN(4) + (l + 1) * D, MOD + (size_t)(l + 1) * BATCH * 6 * D, HBF);
        else combine_phase<false>((const unsigned char*)YB, YS8, DST, TOPW, IN(7) + l * D, mod_l + 5 * D, out, nullptr, nullptr, nullptr);
        XBAR();
    }
}
#undef out
}

extern "C" void kernel_launch(void* const* d_in, const int* in_sizes, int n_in, void* d_out, int out_size, void* d_ws, size_t ws_size, hipStream_t stream) {
    static int grid = 0;
    if (grid == 0) {
        if (n_in != 36 || ws_size < WS_END) { fprintf(stderr, "kernel_launch: need 36 inputs and %zu bytes of workspace; got %d, %zu\n", (size_t)WS_END, n_in, ws_size); grid = -1; return; }
        int dev = 0, cus = 0, per_cu = 0;
        if (hipGetDevice(&dev) != hipSuccess || hipDeviceGetAttribute(&cus, hipDeviceAttributeMultiprocessorCount, dev) != hipSuccess) { grid = -1; return; }
        if (hipFuncSetAttribute((const void*)mk_fwd, hipFuncAttributeMaxDynamicSharedMemorySize, LDS_BYTES) != hipSuccess) { fprintf(stderr, "kernel_launch: hipFuncSetAttribute failed\n"); grid = -1; return; }
        if (hipOccupancyMaxActiveBlocksPerMultiprocessor(&per_cu, (const void*)mk_fwd, NT, LDS_BYTES) != hipSuccess || per_cu < 1) { fprintf(stderr, "kernel_launch: occupancy query says %d\n", per_cu); per_cu = 1; }
        (void)hipGetLastError();
        grid = cus;
        fprintf(stderr, "kernel_launch: grid %d (occupancy query %d per CU)\n", grid, per_cu);
    }
    if (grid < 0) return;
    (void)hipMemsetAsync((char*)d_ws + WS_CTL, 0, CTL_BYTES, stream);
    Args a{};
    for (int i = 0; i < 36; ++i) a.in[i] = (const float*)d_in[i];
    a.out = (float*)d_out; a.ws = (char*)d_ws;
    hipLaunchKernelGGL(mk_fwd, dim3(grid), dim3(NT), LDS_BYTES, stream, a);
}
```

```cpp
#include <hip/hip_runtime.h>
#include <cstdio>
#include <cstdint>
#include <cmath>

namespace {
constexpr int D = 1024, BATCH = 8, SEQ = 2048, T = BATCH * SEQ, DEPTH = 2;
constexpr int A_HEADS = 4, A_WIDTH = 512;
constexpr int B_WIDTH = 256, B_COLS = 1024, CHUNK = 128;
constexpr int A_COLS = 1536, IN_COLS = 3072;
constexpr int NE = 64, TOPK = 8, DE = 256;
constexpr int EBLK = 256;
constexpr int NBLK = T * TOPK / EBLK + NE;
constexpr int P = NBLK * EBLK;
constexpr int NT = 512;
constexpr int LDS_BYTES = 147456;

#define LAS __attribute__((address_space(3)))

__device__ __forceinline__ int olane() { int l; asm volatile("v_mbcnt_lo_u32_b32 %0, -1, 0\n\tv_mbcnt_hi_u32_b32 %0, -1, %0" : "=v"(l)); return l; }
__device__ __forceinline__ float shfl_idx(float v, int src) { return __int_as_float(__builtin_amdgcn_ds_bpermute(src << 2, __float_as_int(v))); }
__device__ __forceinline__ float wave_sum(float v) {
    const int l = olane();
#pragma unroll
    for (int o = 1; o < 64; o <<= 1) v += shfl_idx(v, l ^ o);
    return v;
}
__device__ __forceinline__ float wave_max(float v) {
    const int l = olane();
#pragma unroll
    for (int o = 1; o < 64; o <<= 1) v = fmaxf(v, shfl_idx(v, l ^ o));
    return v;
}
__device__ __forceinline__ float rdlane(float v, int src) { return __int_as_float(__builtin_amdgcn_readlane(__float_as_int(v), src)); }
__device__ __forceinline__ float sigmoidf_(float x) { return 1.f / (1.f + __expf(-x)); }
__device__ __forceinline__ float siluf_(float x) { return x / (1.f + __expf(-x)); }
__device__ __forceinline__ float gelu_tanh(float x) {
    const float u = 0.7978845608028654f * (x + 0.044715f * x * x * x);
    return 0.5f * x * (1.f + tanhf(u));
}

extern __shared__ __attribute__((aligned(16))) unsigned char lds_raw[];
constexpr int WIDTAB_OFF = 147456 - 768;
__device__ __forceinline__ int owave() {
    const unsigned key = (unsigned)__builtin_amdgcn_s_getreg(63492) & 63u;
    const int w = *(volatile __attribute__((address_space(3))) int*)((__attribute__((address_space(3))) unsigned char*)lds_raw + WIDTAB_OFF + 4 * key);
    return __builtin_amdgcn_readfirstlane(w);
}
__device__ __forceinline__ int olane_() { int l; asm volatile("v_mbcnt_lo_u32_b32 %0, -1, 0\n\tv_mbcnt_hi_u32_b32 %0, -1, %0" : "=v"(l)); return l; }
__device__ __forceinline__ int otid() { return owave() * 64 + olane_(); }
__device__ __forceinline__ int obid() { int b = blockIdx.x; asm volatile("" : "+s"(b)); return b; }
__device__ __forceinline__ int ogdim() { int g = gridDim.x; asm volatile("" : "+s"(g)); return g; }
typedef unsigned short bf16;
__device__ __forceinline__ float bf2f(bf16 v) { return __uint_as_float((unsigned)v << 16); }
typedef float f32x2cv __attribute__((ext_vector_type(2))); typedef __bf16 bf16x2cv __attribute__((ext_vector_type(2)));
__device__ __forceinline__ unsigned pk2(float lo, float hi) { const f32x2cv v = {lo, hi}; const bf16x2cv b = __builtin_convertvector(v, bf16x2cv); return __builtin_bit_cast(unsigned, b); }
__device__ __forceinline__ unsigned f2bf(float f) { return pk2(f, 0.f) & 0xffffu; }

#define XB_TMO      128
#define XB_XCNT(j)  (256  + 64 * (j))
#define XB_XSUB(j)  (1280 + 64 * (j))
#define XB_XGEN(j)  (2304 + 64 * (j))
#define XB_TOP      3328
#define XB_TOPGEN   3392
#define XCD_BAR_WORDS 3456
#define XB_SPIN_CAP (1u << 27)
__device__ __forceinline__ unsigned xb_ld(unsigned* p)              { return __hip_atomic_load(p, __ATOMIC_RELAXED, __HIP_MEMORY_SCOPE_AGENT); }
__device__ __forceinline__ unsigned xb_add(unsigned* p, unsigned v) { return __hip_atomic_fetch_add(p, v, __ATOMIC_RELAXED, __HIP_MEMORY_SCOPE_AGENT); }
__device__ __forceinline__ unsigned xb_xcc_id() { return (unsigned)__builtin_amdgcn_s_getreg((3 << 11) | 20) & 0xFu; }
#define XB_SPIN(cond, bar) do { unsigned _sp = 0; while (cond) { __builtin_amdgcn_s_sleep(1); \
    if ((++_sp & 255u) == 0u) { if (xb_ld(&(bar)[XB_TMO])) break; if (_sp > XB_SPIN_CAP) { atomicAdd(&(bar)[XB_TMO], 1u); break; } } } } while (0)
struct XcdBarrier { unsigned* bar; unsigned x; volatile LAS unsigned* st; };
__device__ __forceinline__ XcdBarrier xcd_barrier_post(unsigned* bar, volatile LAS unsigned* st) {
    XcdBarrier b; b.bar = bar; b.x = xb_xcc_id(); b.st = st;
    if (threadIdx.x == 0) (void)xb_add(&bar[XB_XCNT(b.x)], 1u);
    return b;
}
__device__ __forceinline__ void xcd_barrier_complete(unsigned* bar, unsigned x, unsigned& nloc, unsigned& nx) {
    const unsigned G = gridDim.x * gridDim.y * gridDim.z;
    unsigned sum, cnt, mine, sp = 0u;
    for (;;) {
        sum = 0u; cnt = 0u; mine = 0u;
#pragma unroll
        for (unsigned j = 0; j < 16; ++j) { const unsigned c = xb_ld(&bar[XB_XCNT(j)]); sum += c; cnt += (c > 0u) ? 1u : 0u; mine = (j == x) ? c : mine; }
        if (sum == G) break;
        __builtin_amdgcn_s_sleep(1);
        if ((++sp & 255u) == 0u) { if (xb_ld(&bar[XB_TMO])) break; if (sp > XB_SPIN_CAP) { atomicAdd(&bar[XB_TMO], 1u); break; } }
    }
    nloc = mine > 0u ? mine : 1u; nx = cnt > 0u ? cnt : 1u;
}
__device__ __forceinline__ void xcd_barrier(const XcdBarrier& b) {
    asm volatile("s_waitcnt vmcnt(0)" ::: "memory");
    __syncthreads();
    if (otid() == 0) {
        unsigned* bar = b.bar; asm volatile("" : "+s"(bar));
        unsigned bx = b.x; asm volatile("" : "+s"(bx));
        __builtin_amdgcn_s_waitcnt(0);
        unsigned nloc = b.st[0], nx = b.st[1];
        if (nloc == 0u) { xcd_barrier_complete(bar, bx, nloc, nx); b.st[0] = nloc; b.st[1] = nx; }
        const unsigned old = xb_add(&bar[XB_XSUB(bx)], 1u);
        const unsigned gen = old / nloc;
        if (old + 1u == (gen + 1u) * nloc) {
            __builtin_amdgcn_fence(__ATOMIC_RELEASE, "agent");
            asm volatile("s_waitcnt vmcnt(0)" ::: "memory");
            const unsigned og = xb_add(&bar[XB_TOP], 1u);
            const unsigned tg = og / nx;
            if (og + 1u == (tg + 1u) * nx) xb_add(&bar[XB_TOPGEN], 1u);
            else XB_SPIN(xb_ld(&bar[XB_TOPGEN]) == tg, bar);
            __builtin_amdgcn_fence(__ATOMIC_ACQUIRE, "agent");
            xb_add(&bar[XB_XGEN(bx)], 1u);
            asm volatile("s_waitcnt vmcnt(0)" ::: "memory");
        } else {
            XB_SPIN(xb_ld(&bar[XB_XGEN(bx)]) == gen, bar);
            __builtin_amdgcn_fence(__ATOMIC_ACQUIRE, "agent");
            asm volatile("s_waitcnt vmcnt(0)" ::: "memory");
        }
    }
    __syncthreads();
}

namespace pg8 {
#define PG8_LAS __attribute__((address_space(3)))
typedef unsigned short bf16_t;
typedef short bf16x8 __attribute__((ext_vector_type(8)));
typedef float f32x4 __attribute__((ext_vector_type(4)));
typedef unsigned u32x4 __attribute__((ext_vector_type(4)));
constexpr int BM = 256, BK = 64, HALF = 128, HTB = HALF * BK * 2  , STAGE_BYTES = 8 * HTB, NXCD = 8, WGM = 8;

__host__ __device__ __forceinline__ int lds_byte(int r, int c) { const int st = (r >> 4) * 2 + (c >> 5), rr = r & 15, cc = c & 31, ob = rr * 64 + cc * 2; return st * 1024 + (ob ^ (((ob >> 9) & 1) << 5)); }
__host__ __device__ __forceinline__ void stage_rc(int b, int& R, int& C) { const int st = b / 1024, sb = b % 1024, swz = sb ^ (((sb >> 9) & 1) << 5); R = (st >> 1) * 16 + swz / 64; C = (st & 1) * 32 + (swz % 64) / 2; }
__host__ __device__ __forceinline__ int perm32(int rho) { const int n = rho >> 4, i = rho & 15; return 8 * (i >> 2) + 4 * n + (i & 3); }

struct Unit { int pm, pn; size_t boff; };
struct Gemm { const bf16_t* A; const bf16_t* Bt; int M, N, K; };

struct StaticOrder {
    int nM, nN, nwg, G, c;
    __host__ __device__ __forceinline__ void init(int M, int N, int G_, int c_) { nM = M / BM; nN = N / BM; nwg = nM * nN; G = G_; c = c_; }
    __host__ __device__ __forceinline__ bool next(int i, Unit& u) const {
        const long L = (long)i * G + c; if (L >= nwg) return false;
        int wgid = (int)L; { const int q = nwg / NXCD, r = nwg % NXCD, xcd = wgid % NXCD, off = wgid / NXCD; wgid = (xcd < r ? xcd * (q + 1) : r * (q + 1) + (xcd - r) * q) + off; }
        const int nig = WGM * nN, gid = wgid / nig, fm = gid * WGM, gsz = (nM - fm) < WGM ? (nM - fm) : WGM;
        u.pm = fm + ((wgid % nig) % gsz); u.pn = (wgid % nig) / gsz; u.boff = 0; return true;
    }
    __device__ __forceinline__ unsigned arow(const Unit& u, int r) const { return (unsigned)(u.pm * BM + r); }
    __device__ __forceinline__ void a_ready(const Unit&) const {}
    __device__ __forceinline__ void done(const Unit&) const {}
};

__device__ __forceinline__ unsigned cvt_pk_bf16(float lo, float hi) { typedef float f2_ __attribute__((ext_vector_type(2))); typedef __bf16 b2_ __attribute__((ext_vector_type(2))); const f2_ v = {lo, hi}; const b2_ b = __builtin_convertvector(v, b2_); return __builtin_bit_cast(unsigned, b); }
typedef float f32x2 __attribute__((ext_vector_type(2)));
__device__ __forceinline__ f32x2 gelu_pk(f32x2 v) {
    const f32x2 av = __builtin_elementwise_abs(v), d = av * 0.2316418882f + 1.0f;
    f32x2 t; t.x = __builtin_amdgcn_rcpf(d.x); t.y = __builtin_amdgcn_rcpf(d.y);
    f32x2 q = t * 0.5307027145f + (-0.7265760135f); q = q * t + 0.7107068705f; q = q * t + (-0.142248368f); q = q * t + 0.127414796f; q = q * t;
    const f32x2 s = (v * v) * (-0.72134752044f);
    f32x2 e; e.x = __builtin_amdgcn_exp2f(s.x); e.y = __builtin_amdgcn_exp2f(s.y);
    const f32x2 m = v * (q * e), r = v - m;
    f32x2 o; o.x = v.x < 0.f ? m.x : r.x; o.y = v.y < 0.f ? m.y : r.y; return o;
}

template <int ACT  > struct EpiBf16 {
    static constexpr bool PERM = true, AFTER_DRAIN = false; static_assert(ACT == 0 || ACT == 1, "EpiBf16: ACT is 0 (none) or 1 (gelu_pk)");
    bf16_t* O; int ldc; const float* bias; int split_cols; size_t split_stride; float scale0;
    __device__ __forceinline__ void operator()(const f32x4 (&acc)[2][2][4][2], const Unit& u, int wr, int wc, int fr, int fq) const {
        const int row0 = u.pm * BM + wr * 64 + fr; int colt = u.pn * BM; bf16_t* base = O;
        float sc = 1.f; if (split_cols) { const int t = colt / split_cols; base += (size_t)t * split_stride; colt -= t * split_cols; if (t == 0) sc = scale0; }
        const int col0 = colt + wc * 32 + 8 * fq, bcol0 = u.pn * BM + wc * 32 + 8 * fq;
        f32x4 bv[2][2];
#pragma unroll
        for (int bj = 0; bj < 2; ++bj)
#pragma unroll
            for (int n = 0; n < 2; ++n) bv[bj][n] = bias ? *(const f32x4*)(bias + bcol0 + bj * HALF + 4 * n) : (f32x4){0.f, 0.f, 0.f, 0.f};
#pragma unroll
        for (int ai = 0; ai < 2; ++ai)
#pragma unroll
            for (int m = 0; m < 4; ++m) { bf16_t* rowp = base + (size_t)(row0 + ai * HALF + m * 16) * ldc + col0;
#pragma unroll
                for (int bj = 0; bj < 2; ++bj) { f32x4 v0 = acc[ai][bj][m][0] + bv[bj][0], v1 = acc[ai][bj][m][1] + bv[bj][1];
                    if (ACT == 1) { f32x2 a = gelu_pk((f32x2){v0[0], v0[1]}), b = gelu_pk((f32x2){v0[2], v0[3]}), c = gelu_pk((f32x2){v1[0], v1[1]}), d = gelu_pk((f32x2){v1[2], v1[3]});
                        v0 = (f32x4){a.x, a.y, b.x, b.y}; v1 = (f32x4){c.x, c.y, d.x, d.y}; }
                    v0 = v0 * sc; v1 = v1 * sc; u32x4 w; w.x = cvt_pk_bf16(v0[0], v0[1]); w.y = cvt_pk_bf16(v0[2], v0[3]); w.z = cvt_pk_bf16(v1[0], v1[1]); w.w = cvt_pk_bf16(v1[2], v1[3]);
                    *(u32x4*)(rowp + bj * HALF) = w; } }
    }
};

struct EpiF32 {
    static constexpr bool PERM = false, AFTER_DRAIN = false;
    float* C; int ldc;
    __device__ __forceinline__ void operator()(const f32x4 (&acc)[2][2][4][2], const Unit& u, int wr, int wc, int fr, int fq) const {
        const int row0 = u.pm * BM + wr * 64 + fr, col0 = u.pn * BM + wc * 32 + 4 * fq;
#pragma unroll
        for (int ai = 0; ai < 2; ++ai)
#pragma unroll
            for (int m = 0; m < 4; ++m) { float* rowp = C + (size_t)(row0 + ai * HALF + m * 16) * ldc + col0;
#pragma unroll
                for (int bj = 0; bj < 2; ++bj)
#pragma unroll
                    for (int n = 0; n < 2; ++n) *(f32x4*)(rowp + bj * HALF + n * 16) = acc[ai][bj][m][n]; }
    }
};

struct EpiSwiGLU {
    static constexpr bool PERM = true, AFTER_DRAIN = false;
    bf16_t* O;
    __device__ __forceinline__ void operator()(const f32x4 (&acc)[2][2][4][2], const Unit& u, int wr, int wc, int fr, int fq) const {
        const int row0 = u.pm * BM + wr * 64 + fr, col0 = u.pn * HALF + wc * 32 + 8 * fq;
#pragma unroll
        for (int ai = 0; ai < 2; ++ai)
#pragma unroll
            for (int m = 0; m < 4; ++m) {
                bf16_t* rowp = O + (size_t)(row0 + ai * HALF + m * 16) * 256 + col0;
                float hv[8];
#pragma unroll
                for (int n = 0; n < 2; ++n)
#pragma unroll
                    for (int j = 0; j < 4; ++j) { const float a = acc[ai][0][m][n][j], g = acc[ai][1][m][n][j]; hv[n * 4 + j] = a * __builtin_amdgcn_rcpf(1.f + __expf(-a)) * g; }
                u32x4 w; w.x = cvt_pk_bf16(hv[0], hv[1]); w.y = cvt_pk_bf16(hv[2], hv[3]); w.z = cvt_pk_bf16(hv[4], hv[5]); w.w = cvt_pk_bf16(hv[6], hv[7]);
                *(u32x4*)rowp = w;
            }
    }
};
__device__ __forceinline__ unsigned pack_fp8x4(const f32x4& v) {
    const float s = 16.f;
    int w = __builtin_amdgcn_cvt_pk_fp8_f32(__builtin_amdgcn_fmed3f(v[0] * s, -448.f, 448.f), __builtin_amdgcn_fmed3f(v[1] * s, -448.f, 448.f), 0, false);
    w = __builtin_amdgcn_cvt_pk_fp8_f32(__builtin_amdgcn_fmed3f(v[2] * s, -448.f, 448.f), __builtin_amdgcn_fmed3f(v[3] * s, -448.f, 448.f), w, true);
    return (unsigned)w;
}
struct EpiRows {
    static constexpr bool PERM = true, AFTER_DRAIN = false;
    unsigned char* O; unsigned char* O2; int shared_pm0;
    __device__ __forceinline__ void operator()(const f32x4 (&acc)[2][2][4][2], const Unit& u, int wr, int wc, int fr, int fq) const {
        unsigned char* base = u.pm < shared_pm0 ? O + (size_t)u.pm * BM * 1024 : O2 + (size_t)(u.pm - shared_pm0) * BM * 1024;
        const int row0 = wr * 64 + fr, col0 = u.pn * BM + wc * 32 + 8 * fq;
#pragma unroll
        for (int ai = 0; ai < 2; ++ai)
#pragma unroll
            for (int m = 0; m < 4; ++m) {
                unsigned char* rowp = base + (size_t)(row0 + ai * HALF + m * 16) * 1024 + col0;
#pragma unroll
                for (int bj = 0; bj < 2; ++bj) { typedef unsigned u32x2 __attribute__((ext_vector_type(2)));
                    u32x2 w; w.x = pack_fp8x4(acc[ai][bj][m][0]); w.y = pack_fp8x4(acc[ai][bj][m][1]);
                    *(u32x2*)(rowp + bj * HALF) = w; }
            }
    }
};
struct GroupedOrder {
    int nMr, nM, nN, nwg, G, c, spm0; const int* ps; const int* rows; size_t estride;
    __device__ __forceinline__ void init(const int* ps_, int nN_, int G_, int c_, const int* rows_, size_t estride_, int spm0_, int nshared) {
        ps = ps_; nMr = ps_[64] / BM; nM = nMr + nshared; nN = nN_; nwg = nM * nN; G = G_; c = c_; rows = rows_; estride = estride_; spm0 = spm0_; }
    __device__ __forceinline__ bool next(int i, Unit& u) const {
        const long L = (long)i * G + c; if (L >= nwg) return false;
        int wgid = (int)L; { const int q = nwg / NXCD, r = nwg % NXCD, xcd = wgid % NXCD, off = wgid / NXCD; wgid = (xcd < r ? xcd * (q + 1) : r * (q + 1) + (xcd - r) * q) + off; }
        const int nig = WGM * nN, gid = wgid / nig, fm = gid * WGM, gsz = (nM - fm) < WGM ? (nM - fm) : WGM;
        const int pmi = fm + ((wgid % nig) % gsz); u.pn = (wgid % nig) / gsz;
        if (pmi < nMr) { const int pj = ps[olane()];
            const int e = __popcll(__ballot(pmi * BM >= pj)) - 1; u.pm = pmi; u.boff = (size_t)e * estride; }
        else { u.pm = spm0 + (pmi - nMr); u.boff = (size_t)64 * estride; }
        return true;
    }
    __device__ __forceinline__ unsigned arow(const Unit& u, int r) const {
        if (rows) return u.pm < spm0 ? (unsigned)rows[u.pm * BM + r] : (unsigned)((u.pm - spm0) * BM + r);
        return (unsigned)(u.pm * BM + r);
    }
    __device__ __forceinline__ void a_ready(const Unit&) const {}
    __device__ __forceinline__ void done(const Unit&) const {}
};

template <class Epi, class Sched, bool ALIGN_EPI = false>
__device__ __forceinline__ void gemm_phase(PG8_LAS unsigned char* lds, const Gemm g, const Sched& S, const Epi& E) {
    const int wid = owave(), wr = wid >> 2, wc = wid & 3;
#define tid (wid * 64 + olane())
    int K = g.K; asm volatile("" : "+s"(K));
    const int nt = K / BK;
    unsigned voffB;
    { int R, C; stage_rc(tid * 16, R, C); const int Rb = Epi::PERM ? ((R & ~31) + perm32(R & 31)) : R; voffB = (unsigned)(Rb * K + C) * 2u; }
    const size_t r64step = (size_t)64 * K * 2;
    const unsigned rowbytes = (unsigned)K * 2u;
    const size_t kstep = (size_t)(BK * 2);
    const size_t hstep = (size_t)HALF * K * 2;
    const size_t tstep = 2 * hstep;
    const unsigned ldsw = (unsigned)wid * 1024u;
    int aoff, boff; { const int ln = olane(), fr = ln & 15, fq = ln >> 4; aoff = lds_byte(wr * 64 + fr, fq * 8); boff = lds_byte(wc * 32 + fr, fq * 8); }
#define PG8_SA(b, h) (((b) * 2 + (h)) * HTB)
#define PG8_SB(b, h) ((4 + (b) * 2 + (h)) * HTB)
#define PG8_STAGE(bufoff, gbase, voff) do { _Pragma("unroll") for (int _i = 0; _i < 2; ++_i) \
        __builtin_amdgcn_global_load_lds((const unsigned*)((const char*)(gbase) + (voff)[_i]), (PG8_LAS unsigned*)(lds + (bufoff) + ldsw + _i * 8192), 16, 0, 0); } while (0)
#define PG8_STAGEB(bufoff, gbase) do { _Pragma("unroll") for (int _i = 0; _i < 2; ++_i) \
        __builtin_amdgcn_global_load_lds((const unsigned*)((const char*)(gbase) + _i * r64step + voffB), (PG8_LAS unsigned*)(lds + (bufoff) + ldsw + _i * 8192), 16, 0, 0); } while (0)
#define PG8_LDA(dst, b, h) do { _Pragma("unroll") for (int m = 0; m < 4; ++m) _Pragma("unroll") for (int k = 0; k < 2; ++k) dst[m][k] = *(const PG8_LAS bf16x8*)(lds + PG8_SA(b, h) + aoff + m * 2048 + k * 1024); } while (0)
#define PG8_LDB(dst, b, h) do { _Pragma("unroll") for (int n = 0; n < 2; ++n) _Pragma("unroll") for (int k = 0; k < 2; ++k) dst[n][k] = *(const PG8_LAS bf16x8*)(lds + PG8_SB(b, h) + boff + n * 2048 + k * 1024); } while (0)
#define PG8_MMA(ai, bj, At, Bt) do { __builtin_amdgcn_s_setprio(1); _Pragma("unroll") for (int m = 0; m < 4; ++m) _Pragma("unroll") for (int n = 0; n < 2; ++n) _Pragma("unroll") for (int k = 0; k < 2; ++k) \
        acc[ai][bj][m][n] = __builtin_amdgcn_mfma_f32_16x16x32_bf16(Bt[n][k], At[m][k], acc[ai][bj][m][n], 0, 0, 0); __builtin_amdgcn_s_setprio(0); } while (0)
#define PG8_WAIT_V(n) asm volatile("s_waitcnt vmcnt(" #n ")" ::: "memory")
#define PG8_WAIT_L(n) asm volatile("s_waitcnt lgkmcnt(" #n ")" ::: "memory")
#define PG8_BAR __builtin_amdgcn_s_barrier()
#define PG8_SCHED __builtin_amdgcn_sched_barrier(0)
#define PG8_FILL(tb, u) do { int _t = tid; asm volatile("" : "+v"(_t)); if (_t < BM) rtab[(tb) * BM + _t] = S.arow(u, _t) * rowbytes; } while (0)
#define PG8_AOFF(dst, tb) do { int _t = tid; asm volatile("" : "+v"(_t)); _Pragma("unroll") for (int _i = 0; _i < 2; ++_i) { int _R, _C; stage_rc(_t * 16 + _i * 8192, _R, _C); \
        _Pragma("unroll") for (int _h = 0; _h < 2; ++_h) dst[_h][_i] = rtab[(tb) * BM + _h * HALF + _R] + (unsigned)_C * 2u; } } while (0)
    PG8_LAS unsigned* const rtab = (PG8_LAS unsigned*)(lds + STAGE_BYTES);
    Unit cur, nxt; int ui = 0, ctb = 0;
    if (!S.next(0, cur)) return;
    f32x4 acc[2][2][4][2];
#pragma unroll
    for (int a = 0; a < 2; ++a)
#pragma unroll
        for (int b = 0; b < 2; ++b)
#pragma unroll
            for (int m = 0; m < 4; ++m)
#pragma unroll
                for (int n = 0; n < 2; ++n) acc[a][b][m][n] = (f32x4){0.f, 0.f, 0.f, 0.f};
    bf16x8 At[4][2], B0[2][2], B1[2][2];
    const char* const Ab = (const char*)g.A;
    const char* cB = (const char*)g.Bt + cur.boff + (size_t)cur.pn * tstep;
    PG8_FILL(0, cur);
    __syncthreads();
    S.a_ready(cur);
    { unsigned cv[2][2]; PG8_AOFF(cv, 0);
    PG8_STAGEB(PG8_SB(0, 0), cB); PG8_STAGEB(PG8_SB(0, 1), cB + hstep); PG8_STAGE(PG8_SA(0, 0), Ab, cv[0]); PG8_STAGE(PG8_SA(0, 1), Ab, cv[1]);
    if (wr == 1) PG8_BAR;
    PG8_WAIT_V(2); PG8_BAR;
    PG8_STAGEB(PG8_SB(1, 0), cB + kstep); PG8_STAGE(PG8_SA(1, 0), Ab + kstep, cv[0]); PG8_STAGEB(PG8_SB(1, 1), cB + hstep + kstep);
    PG8_WAIT_V(6); PG8_BAR; }
    for (;;) {
        const bool has_next = S.next(ui + 1, nxt);
        const char* nB = has_next ? (const char*)g.Bt + nxt.boff + (size_t)nxt.pn * tstep : cB;
        if (has_next) PG8_FILL(ctb ^ 1, nxt);
        for (int t = 0; t < nt; t += 2) {
            const bool last = (t == nt - 2);
            const char* a1 = Ab + (size_t)(t + 1) * kstep;
            const char* a2 = last ? Ab : Ab + (size_t)(t + 2) * kstep; const char* b2 = last ? nB : cB + (size_t)(t + 2) * kstep;
            const char* a3 = a2 + kstep; const char* b3 = b2 + kstep;
            unsigned cv[2][2], s2[2][2];
            PG8_AOFF(cv, ctb); PG8_AOFF(s2, (last && has_next) ? (ctb ^ 1) : ctb);
            if (last && has_next) S.a_ready(nxt);
            PG8_LDB(B0, 0, 0); PG8_LDB(B1, 0, 1); PG8_SCHED; PG8_LDA(At, 0, 0); PG8_STAGE(PG8_SA(1, 1), a1, cv[1]);
            PG8_WAIT_V(8); PG8_WAIT_L(0); PG8_BAR; PG8_MMA(0, 0, At, B0); PG8_MMA(0, 1, At, B1); PG8_BAR; PG8_SCHED;
            PG8_LDA(At, 0, 1); PG8_STAGEB(PG8_SB(0, 0), b2); PG8_STAGEB(PG8_SB(0, 1), b2 + hstep); PG8_STAGE(PG8_SA(0, 0), a2, s2[0]);
            PG8_WAIT_V(8); PG8_WAIT_L(0); PG8_BAR; PG8_MMA(1, 0, At, B0); PG8_MMA(1, 1, At, B1); PG8_BAR; PG8_SCHED;
            PG8_LDB(B0, 1, 0); PG8_LDB(B1, 1, 1); PG8_SCHED; PG8_LDA(At, 1, 0); PG8_STAGE(PG8_SA(0, 1), a2, s2[1]);
            PG8_WAIT_V(8); PG8_WAIT_L(0); PG8_BAR; PG8_MMA(0, 0, At, B0); PG8_MMA(0, 1, At, B1); PG8_BAR; PG8_SCHED;
            PG8_LDA(At, 1, 1); PG8_STAGEB(PG8_SB(1, 0), b3); PG8_STAGEB(PG8_SB(1, 1), b3 + hstep); PG8_STAGE(PG8_SA(1, 0), a3, s2[0]);
            PG8_WAIT_V(8); PG8_WAIT_L(0); PG8_BAR; PG8_MMA(1, 0, At, B0); PG8_MMA(1, 1, At, B1); PG8_BAR; PG8_SCHED;
        }
        if constexpr (ALIGN_EPI) { if (wr == 0) PG8_BAR; }
        { const int ln = olane(); E(acc, cur, wr, wc, ln & 15, ln >> 4); } S.done(cur);
        if (!has_next) break;
#pragma unroll
        for (int a = 0; a < 2; ++a)
#pragma unroll
            for (int b = 0; b < 2; ++b)
#pragma unroll
                for (int m = 0; m < 4; ++m)
#pragma unroll
                    for (int n = 0; n < 2; ++n) acc[a][b][m][n] = (f32x4){0.f, 0.f, 0.f, 0.f};
        cur = nxt; cB = nB; ++ui; ctb ^= 1;
        if constexpr (ALIGN_EPI) { if (wr == 1) PG8_BAR; }
    }
    PG8_WAIT_V(0);
    if constexpr (!ALIGN_EPI) { if (wr == 0) PG8_BAR; }
    PG8_BAR;
#undef PG8_FILL
#undef tid
#undef PG8_SA
#undef PG8_SB
#undef PG8_STAGE
#undef PG8_STAGEB
#undef PG8_LDA
#undef PG8_LDB
#undef PG8_MMA
#undef PG8_WAIT_V
#undef PG8_WAIT_L
#undef PG8_BAR
#undef PG8_SCHED
#undef PG8_AOFF
}
}

struct Args { const float* in[36]; float* out; char* ws; };

constexpr size_t al256(size_t x) { return (x + 255) & ~(size_t)255; }
constexpr size_t MiB = (size_t)1 << 20;
constexpr size_t WS_CTL = 0;
constexpr size_t CTL_BYTES = 64 * 1024;
constexpr int CW_BAR = 0, CW_CNT = 8192, CW_CUR = 8192 + 64;
constexpr size_t WS_MOD = WS_CTL + CTL_BYTES;
constexpr size_t WS_TOPI = 512 * 1024;
constexpr size_t WS_TOPW = 1 * MiB;
constexpr size_t WS_ROWT = 1 * MiB + 512 * 1024;
constexpr size_t WS_DST = 2 * MiB + 512 * 1024;
constexpr size_t WS_SMALL = 3 * MiB + 256 * 1024;
constexpr size_t WS_WTR = 4 * MiB;
constexpr size_t WS_WTIN = 5 * MiB;
constexpr size_t WS_WTOUT = 17 * MiB;
constexpr size_t WS_WTUP = 21 * MiB;
constexpr size_t WS_WTDN = 86 * MiB;
constexpr size_t WS_HBF = 119 * MiB;
constexpr size_t WS_ARENA = 151 * MiB;
constexpr size_t WS_PROJ = WS_ARENA;
constexpr size_t WS_MIXB = WS_ARENA + 96 * MiB;
constexpr size_t WS_RW = WS_ARENA + 128 * MiB;
constexpr size_t WS_CHK = WS_ARENA + 256 * MiB;
constexpr size_t WS_GU = WS_ARENA + 256 * MiB;
constexpr size_t WS_HBB = WS_ARENA;
constexpr size_t WS_YB = WS_ARENA + 81 * MiB;
constexpr size_t WS_YS = WS_ARENA + 232 * MiB;
constexpr size_t WS_LOGIT = WS_YB;
constexpr size_t WS_END = WS_ARENA + 369 * MiB;
static_assert(WS_MOD + (size_t)DEPTH * BATCH * 6 * D * 4 <= WS_TOPI && WS_DST + (size_t)P * 4 <= WS_WTIN && WS_WTUP + (size_t)65 * 512 * 1024 * 2 <= WS_WTDN && WS_WTDN + (size_t)65 * 1024 * 256 * 2 <= WS_HBF, "ws map");
static_assert(WS_HBB + (size_t)(P + T) * 256 * 2 <= WS_YB && WS_YB + (size_t)P * 1024 * 2 <= WS_END, "ws map (moe)");

__device__ __forceinline__ void transpose_item(const float* W, int K, int N, bf16* WT, int k0, int n0, int drow0, float* scr, int lane) {
#pragma unroll 8
    for (int i = 0; i < 32; ++i) { const int kk = 2 * i + (lane >> 5); scr[kk * 33 + (lane & 31)] = W[(size_t)(k0 + kk) * N + n0 + (lane & 31)]; }
    asm volatile("s_waitcnt lgkmcnt(0)" ::: "memory");
    const int c = lane & 7;
#pragma unroll
    for (int j = 0; j < 4; ++j) { const int n = (lane >> 3) + 8 * j; const float* sp = scr + (8 * c) * 33 + n;
        uint4 o; o.x = pk2(sp[0 * 33], sp[1 * 33]); o.y = pk2(sp[2 * 33], sp[3 * 33]); o.z = pk2(sp[4 * 33], sp[5 * 33]); o.w = pk2(sp[6 * 33], sp[7 * 33]);
        *(uint4*)(WT + (size_t)(drow0 + n) * K + k0 + 8 * c) = o; }
    asm volatile("s_waitcnt lgkmcnt(0)" ::: "memory");
}
struct ItemDesc { const float* W; int N; bf16* WT; int K, k0, n0, drow0; };
__device__ __forceinline__ void item_load(const ItemDesc& d, float (&v)[32], int lane) {
    const float* p = d.W + (size_t)(d.k0 + (lane >> 3)) * d.N + d.n0 + 4 * (lane & 7);
#pragma unroll
    for (int j = 0; j < 8; ++j) { const float4 t = *(const float4*)(p + (size_t)(8 * j) * d.N); v[4 * j] = t.x; v[4 * j + 1] = t.y; v[4 * j + 2] = t.z; v[4 * j + 3] = t.w; }
}
__device__ __forceinline__ void item_finish(const ItemDesc& d, const float (&v)[32], float* scr, int lane) {
#pragma unroll
    for (int j = 0; j < 8; ++j) { const int k = 8 * j + (lane >> 3), sw = (8 * ((k >> 3) & 3)) ^ (4 * ((k >> 5) & 1));
        *(float4*)(scr + k * 32 + ((4 * (lane & 7)) ^ sw)) = make_float4(v[4 * j], v[4 * j + 1], v[4 * j + 2], v[4 * j + 3]); }
    asm volatile("s_waitcnt lgkmcnt(0)" ::: "memory");
    const int c = lane & 7, swc = (8 * (c & 3)) ^ (4 * (c >> 2));
#pragma unroll
    for (int j = 0; j < 4; ++j) { const int n = (lane >> 3) + 8 * j; const float* sp = scr + (8 * c) * 32 + (n ^ swc);
        uint4 o; o.x = pk2(sp[0 * 32], sp[1 * 32]); o.y = pk2(sp[2 * 32], sp[3 * 32]); o.z = pk2(sp[4 * 32], sp[5 * 32]); o.w = pk2(sp[6 * 32], sp[7 * 32]);
        *(uint4*)(d.WT + (size_t)(d.drow0 + n) * d.K + d.k0 + 8 * c) = o; }
    asm volatile("s_waitcnt lgkmcnt(0)" ::: "memory");
}
__device__ __forceinline__ void transpose_matrix(const float* W, int K, int N, bf16* WT, float* lds) {
    const int tidx = otid(), bidx = obid(), gdim = ogdim();
    const int wave = tidx >> 6, lane = tidx & 63;
    float* scr = lds + wave * (64 * 33);
    const int nblk = N / 32, nitems = (K / 64) * nblk;
#pragma unroll 1
    for (int it = bidx * 8 + wave; it < nitems; it += gdim * 8) {
        const int kb = it / nblk, nb = it % nblk;
        transpose_item(W, K, N, WT, 64 * kb, 32 * nb, 32 * nb, scr, lane);
    }
}
template <int CTRL> __device__ __forceinline__ float dpp_add(float v) { return v + __int_as_float(__builtin_amdgcn_update_dpp(0, __float_as_int(v), CTRL, 0xF, 0xF, false)); }
__device__ __forceinline__ float wave_sum_fast(float v) {
    v = dpp_add<0xB1>(v); v = dpp_add<0x4E>(v); v = dpp_add<0x141>(v); v = dpp_add<0x140>(v);
    const int vi = __float_as_int(v);
    return (__int_as_float(__builtin_amdgcn_readlane(vi, 0)) + __int_as_float(__builtin_amdgcn_readlane(vi, 16))) + (__int_as_float(__builtin_amdgcn_readlane(vi, 32)) + __int_as_float(__builtin_amdgcn_readlane(vi, 48)));
}
typedef unsigned u32x4n __attribute__((ext_vector_type(4)));
typedef unsigned u32x2n __attribute__((ext_vector_type(2)));
__device__ __forceinline__ uint4 nt_load16(const void* p) { const u32x4n v = __builtin_nontemporal_load((const u32x4n*)p); return make_uint4(v.x, v.y, v.z, v.w); }
__device__ __forceinline__ uint2 nt_load8(const void* p) { const u32x2n v = __builtin_nontemporal_load((const u32x2n*)p); return make_uint2(v.x, v.y); }
__device__ __forceinline__ float sq4(const float4& a) { return a.x * a.x + a.y * a.y + a.z * a.z + a.w * a.w; }
template <bool HAS_Y, bool HAS_H>
__device__ __forceinline__ void row_phase(const float* xin, const bf16* y, const float* gy, const float* gate_base, float* xout,
                                          const float* gn, const float* mod_l, int sh_idx, int sc_idx, bf16* hb) {
    const int tidx = otid(), bidx = obid(), gdim = ogdim();
    const int lane = tidx & 63, wave = tidx >> 6;
    float4 gyv[4], gnv[4];
#pragma unroll
    for (int j = 0; j < 4; ++j) { if (HAS_Y) gyv[j] = ((const float4*)gy)[lane + 64 * j]; if (HAS_H) gnv[j] = ((const float4*)gn)[lane + 64 * j]; }
#pragma unroll 1
    for (int row0 = (bidx * 8 + wave) * 4; row0 < T; row0 += gdim * 32) {
        const int b = row0 / SEQ;
        const float* m = mod_l + (size_t)b * 6 * D;
        float4 v[4][4], yv[4][4], gt[4], sc[4], sh[4];
#pragma unroll
        for (int r = 0; r < 4; ++r)
#pragma unroll
            for (int j = 0; j < 4; ++j) {
                v[r][j] = ((const float4*)(xin + (size_t)(row0 + r) * D))[lane + 64 * j];
                if (HAS_Y) { const uint2 yb_ = nt_load8((const uint2*)(y + (size_t)(row0 + r) * D) + lane + 64 * j);
                    yv[r][j] = make_float4(__uint_as_float(yb_.x << 16), __uint_as_float(yb_.x & 0xffff0000u), __uint_as_float(yb_.y << 16), __uint_as_float(yb_.y & 0xffff0000u)); }
            }
#pragma unroll
        for (int j = 0; j < 4; ++j) {
            if (HAS_Y) gt[j] = ((const float4*)(gate_base + (size_t)b * 6 * D))[lane + 64 * j];
            if (HAS_H) { sc[j] = ((const float4*)(m + sc_idx * D))[lane + 64 * j]; sh[j] = ((const float4*)(m + sh_idx * D))[lane + 64 * j]; }
        }
#pragma unroll
        for (int r = 0; r < 4; ++r) {
            const int row = row0 + r;
            if (HAS_Y) {
                const float rs = rsqrtf(wave_sum_fast((sq4(yv[r][0]) + sq4(yv[r][1])) + (sq4(yv[r][2]) + sq4(yv[r][3]))) * (1.f / D) + 1e-6f);
#pragma unroll
                for (int j = 0; j < 4; ++j) {
                    v[r][j].x += gt[j].x * yv[r][j].x * rs * gyv[j].x; v[r][j].y += gt[j].y * yv[r][j].y * rs * gyv[j].y;
                    v[r][j].z += gt[j].z * yv[r][j].z * rs * gyv[j].z; v[r][j].w += gt[j].w * yv[r][j].w * rs * gyv[j].w;
                    ((float4*)(xout + (size_t)row * D))[lane + 64 * j] = v[r][j];
                }
            }
            if (HAS_H) {
                const float rs = rsqrtf(wave_sum_fast((sq4(v[r][0]) + sq4(v[r][1])) + (sq4(v[r][2]) + sq4(v[r][3]))) * (1.f / D) + 1e-6f);
#pragma unroll
                for (int j = 0; j < 4; ++j) {
                    float4 o;
                    o.x = v[r][j].x * rs * gnv[j].x * (1.f + sc[j].x) + sh[j].x; o.y = v[r][j].y * rs * gnv[j].y * (1.f + sc[j].y) + sh[j].y;
                    o.z = v[r][j].z * rs * gnv[j].z * (1.f + sc[j].z) + sh[j].z; o.w = v[r][j].w * rs * gnv[j].w * (1.f + sc[j].w) + sh[j].w;
                    ((uint2*)(hb + (size_t)row * D))[lane + 64 * j] = make_uint2(pk2(o.x, o.y), pk2(o.z, o.w));
                }
            }
        }
    }
}

__device__ __forceinline__ int t5_bucket(int n) {
    if (n < 16) return n;
    int large = 16 + (int)(logf((float)n / 16.f) / logf(8.f) * 16.f);
    return large < 31 ? large : 31;
}
constexpr int BT_OFF = LDS_BYTES - 6144;
typedef float f32x16 __attribute__((ext_vector_type(16)));
typedef short bf16x8_t __attribute__((ext_vector_type(8)));
typedef short s16x4_t __attribute__((ext_vector_type(4)));
__device__ __forceinline__ unsigned cvtpk(float lo, float hi) { return pk2(lo, hi); }
#define ATT_C 0.18033688011112042f
template <bool NEAR>
__device__ __forceinline__ void att_scores(f32x16& x, const float* bt_h, int qrow, int kvb) {
#pragma unroll
    for (int r = 0; r < 16; ++r) {
        float v = x[r];
        if (NEAR) { const int dist = qrow - (kvb + (r & 3) + 8 * (r >> 2)); v += bt_h[dist < 0 ? 0 : (dist > 127 ? 127 : dist)]; if (dist < 0) v = -INFINITY; }
        x[r] = v;
    }
}
__device__ __forceinline__ void attn_phase(unsigned char* ldsb, const bf16* proj, const float* lam_par, const float* subln, float lambda_init, bf16* mix, int bidx, int gdim) {
    const int tidx = otid();
    const int wave = tidx >> 6, lane = tidx & 63, qg = wave >> 1, kh = wave & 1, lq = lane & 31, hi = lane >> 5;
    float l01 = lam_par[lane] * lam_par[64 + lane], l23 = lam_par[128 + lane] * lam_par[192 + lane];
    l01 = wave_sum(l01); l23 = wave_sum(l23);
    const float lam = __expf(l01) - __expf(l23) + lambda_init;
    float* stat = (float*)(ldsb + 65536);
    const int vtr = (4 * hi + ((lane & 15) >> 2)) * 64 + (16 * ((lane >> 4) & 1) + 4 * (lane & 3)) * 2;
#pragma unroll 1
    for (int u = bidx; u < BATCH * A_HEADS * 8; u += gdim) {
        const int b = u >> 5, h = (u >> 3) & 3, pi = u & 7;
        const float* bt_h = (const float*)(ldsb + BT_OFF) + h * 128;
#pragma unroll 1
        for (int half = 0; half < 2; ++half) {
            const int qb = half == 0 ? 15 - pi : pi, R0 = qb * 128, r0 = R0 + 32 * qg, ntile = 2 * qb + 2, qrow = r0 + lq;
            const char* kbase = (const char*)(proj + (size_t)(b * SEQ) * IN_COLS + A_WIDTH + h * 128);
            { const char* qb_ = (const char*)(proj + (size_t)(b * SEQ + r0) * IN_COLS + h * 128); const unsigned qo = (unsigned)(lq * IN_COLS + 8 * hi) * 2u;
#pragma unroll
              for (int m = 0; m < 2; ++m)
#pragma unroll
                  for (int s4 = 0; s4 < 4; ++s4) {
                      const uint4 qw = *(const uint4*)(qb_ + qo + (m * 64 + 16 * s4) * 2);
                      const unsigned qq[4] = {qw.x, qw.y, qw.z, qw.w}; union { unsigned u[4]; bf16x8_t v; } qs;
#pragma unroll
                      for (int w = 0; w < 4; ++w) qs.u[w] = cvtpk(__uint_as_float(qq[w] << 16) * ATT_C, __uint_as_float(qq[w] & 0xffff0000u) * ATT_C);
                      *(bf16x8_t*)(ldsb + 73728 + ((wave * 8 + m * 4 + s4) * 64 + lane) * 16) = qs.v; } }
            const int c0 = tidx, c1 = tidx + 512;
            const int sr0 = c0 >> 4, sc0 = c0 & 15, sr1 = c1 >> 4, sc1 = c1 & 15;
            const unsigned so0 = (unsigned)(sr0 * IN_COLS + sc0 * 8) * 2u, so1 = (unsigned)(sr1 * IN_COLS + sc1 * 8) * 2u;
            const int kdst0 = sr0 * 256 + ((sc0 ^ (sr0 & 15)) << 4), kdst1 = sr1 * 256 + ((sc1 ^ (sr1 & 15)) << 4);
#define VDST(sr, sc) ((((sc) >> 2) * 4096) + (((sr) >> 4) * 1024) + ((((sr) >> 3) & 1) * 512) + (((sr) & 7) * 64) + (((sc) & 3) * 16))
            const int vdst0 = VDST(sr0, sc0), vdst1 = VDST(sr1, sc1);
            float m1 = -1e30f, l1 = 0.f, m2 = -1e30f, l2 = 0.f, iv1 = 0.f, iv2 = 0.f;
            f32x16 o[4];
#pragma unroll
            for (int pass = 0; pass < 2; ++pass) {
                if (pass == 1) {
#pragma unroll
                    for (int e = 0; e < 4; ++e)
#pragma unroll
                        for (int r = 0; r < 16; ++r) o[e][r] = 0.f;
                }
                uint4 ka0, ka1, va0, va1, kb0, kb1, vb0, vb1;
                ka0 = *(const uint4*)(kbase + so0); ka1 = *(const uint4*)(kbase + so1);
                if (pass) { va0 = *(const uint4*)(kbase + 1024 + so0); va1 = *(const uint4*)(kbase + 1024 + so1); }
                { const char* kt = kbase + (size_t)64 * IN_COLS * 2;
                  kb0 = *(const uint4*)(kt + so0); kb1 = *(const uint4*)(kt + so1);
                  if (pass) { vb0 = *(const uint4*)(kt + 1024 + so0); vb1 = *(const uint4*)(kt + 1024 + so1); } }
                __syncthreads();
                *(uint4*)(ldsb + kdst0) = ka0; *(uint4*)(ldsb + kdst1) = ka1;
                if (pass) { *(uint4*)(ldsb + 16384 + vdst0) = va0; *(uint4*)(ldsb + 16384 + vdst1) = va1; }
                __syncthreads();
#define ATT_ITER(JJ, LK0, LK1, LV0, LV1, WK0, WK1, WV0, WV1) do { \
                    const int j = j0 + (JJ); \
                    unsigned char* buf = ldsb + (JJ) * 32768; \
                    unsigned char* nbuf = ldsb + ((JJ) ^ 1) * 32768; \
                    const bool more = j + 1 < ntile; \
                    if (j + 2 < ntile) { \
                        const char* kt = kbase + (size_t)(64 * (j + 2)) * IN_COLS * 2; \
                        LK0 = *(const uint4*)(kt + so0); LK1 = *(const uint4*)(kt + so1); \
                        if (pass) { LV0 = *(const uint4*)(kt + 1024 + so0); LV1 = *(const uint4*)(kt + 1024 + so1); } \
                    } \
                    const int kv0 = 64 * j + 32 * kh; \
                    if (kv0 <= r0 + 31) { \
                        f32x16 st1, st2; \
_Pragma("unroll") \
                        for (int r = 0; r < 16; ++r) { st1[r] = 0.f; st2[r] = 0.f; } \
                        const int krow = 32 * kh + lq; \
_Pragma("unroll") \
                        for (int s4 = 0; s4 < 4; ++s4) { \
                            const bf16x8_t a1 = *(const bf16x8_t*)(buf + krow * 256 + (((2 * s4 + hi) ^ (krow & 15)) << 4)); \
                            const bf16x8_t a2 = *(const bf16x8_t*)(buf + krow * 256 + (((8 + 2 * s4 + hi) ^ (krow & 15)) << 4)); \
                            const bf16x8_t q1 = *(const bf16x8_t*)(ldsb + 73728 + ((wave * 8 + s4) * 64 + lane) * 16), q2 = *(const bf16x8_t*)(ldsb + 73728 + ((wave * 8 + 4 + s4) * 64 + lane) * 16); \
                            st1 = __builtin_amdgcn_mfma_f32_32x32x16_bf16(a1, q1, st1, 0, 0, 0); \
                            st2 = __builtin_amdgcn_mfma_f32_32x32x16_bf16(a2, q2, st2, 0, 0, 0); \
                        } \
                        const int kvb = kv0 + 4 * hi; \
                        if (kv0 + 31 + 113 > r0) { att_scores<true>(st1, bt_h, qrow, kvb); att_scores<true>(st2, bt_h, qrow, kvb); } \
                        else { att_scores<false>(st1, bt_h, qrow, kvb); att_scores<false>(st2, bt_h, qrow, kvb); } \
                        if (pass == 0) { \
                            float t1 = st1[0], t2 = st2[0]; \
_Pragma("unroll") \
                            for (int r = 1; r < 16; ++r) { t1 = fmaxf(t1, st1[r]); t2 = fmaxf(t2, st2[r]); } \
                            const float n1 = fmaxf(m1, t1), n2 = fmaxf(m2, t2); \
                            float a1 = 0.f, a2 = 0.f; \
_Pragma("unroll") \
                            for (int r = 0; r < 16; ++r) { a1 += __builtin_amdgcn_exp2f(st1[r] - n1); a2 += __builtin_amdgcn_exp2f(st2[r] - n2); } \
                            l1 = l1 * __builtin_amdgcn_exp2f(m1 - n1) + a1; l2 = l2 * __builtin_amdgcn_exp2f(m2 - n2) + a2; m1 = n1; m2 = n2; \
                        } else { \
_Pragma("unroll") \
                            for (int r = 0; r < 16; ++r) st1[r] = __builtin_amdgcn_exp2f(st1[r] - m1) * iv1 - __builtin_amdgcn_exp2f(st2[r] - m2) * iv2; \
                            const unsigned char* vb = buf + 16384 + vtr + (2 * kh) * 1024; \
_Pragma("unroll") \
                            for (int s2 = 0; s2 < 2; ++s2) { \
                                union { unsigned u[4]; bf16x8_t v; } pa; \
_Pragma("unroll") \
                                for (int w = 0; w < 4; ++w) pa.u[w] = cvtpk(st1[8 * s2 + 2 * w], st1[8 * s2 + 2 * w + 1]); \
_Pragma("unroll") \
                                for (int e = 0; e < 4; ++e) { \
                                    const s16x4_t lo = __builtin_bit_cast(s16x4_t, __builtin_amdgcn_ds_read_tr16_b64_v4i16((__attribute__((address_space(3))) s16x4_t*)(unsigned)(uintptr_t)(vb + e * 4096 + s2 * 1024))); \
                                    const s16x4_t hh = __builtin_bit_cast(s16x4_t, __builtin_amdgcn_ds_read_tr16_b64_v4i16((__attribute__((address_space(3))) s16x4_t*)(unsigned)(uintptr_t)(vb + e * 4096 + s2 * 1024 + 512))); \
                                    const bf16x8_t bv = (bf16x8_t){lo[0], lo[1], lo[2], lo[3], hh[0], hh[1], hh[2], hh[3]}; \
                                    o[e] = __builtin_amdgcn_mfma_f32_32x32x16_bf16(pa.v, bv, o[e], 0, 0, 0); \
                                } \
                            } \
                        } \
                    } \
                    if (more) { \
                        *(uint4*)(nbuf + kdst0) = WK0; *(uint4*)(nbuf + kdst1) = WK1; \
                        if (pass) { *(uint4*)(nbuf + 16384 + vdst0) = WV0; *(uint4*)(nbuf + 16384 + vdst1) = WV1; } \
                    } \
                    __syncthreads(); \
                } while (0)
#pragma unroll 1
                for (int j0 = 0; j0 < ntile; j0 += 2) {
                    ATT_ITER(0, ka0, ka1, va0, va1, kb0, kb1, vb0, vb1);
                    ATT_ITER(1, kb0, kb1, vb0, vb1, ka0, ka1, va0, va1);
                }
#undef ATT_ITER

                if (pass == 0) {
                    float4* sp = (float4*)stat;
                    sp[wave * 64 + lane] = make_float4(m1, l1, m2, l2);
                    __syncthreads();
                    float M1 = -1e30f, M2 = -1e30f;
                    float4 pr[4];
#pragma unroll
                    for (int i = 0; i < 4; ++i) { pr[i] = sp[(2 * qg + (i >> 1)) * 64 + lq + 32 * (i & 1)]; M1 = fmaxf(M1, pr[i].x); M2 = fmaxf(M2, pr[i].z); }
                    float L1 = 0.f, L2 = 0.f;
#pragma unroll
                    for (int i = 0; i < 4; ++i) { L1 += pr[i].y * __builtin_amdgcn_exp2f(pr[i].x - M1); L2 += pr[i].w * __builtin_amdgcn_exp2f(pr[i].z - M2); }
                    m1 = M1; m2 = M2; iv1 = 1.f / L1; iv2 = lam / L2;
                }
            }
            __syncthreads();
            float* ox = (float*)ldsb;
            if (kh == 1) {
#pragma unroll
                for (int e = 0; e < 4; ++e)
#pragma unroll
                    for (int r = 0; r < 16; ++r) ox[((qg * 4 + e) * 16 + r) * 64 + lane] = o[e][r];
            }
            __syncthreads();
            if (kh == 0) {
                float ss[16];
#pragma unroll
                for (int r = 0; r < 16; ++r) ss[r] = 0.f;
#pragma unroll
                for (int e = 0; e < 4; ++e)
#pragma unroll
                    for (int r = 0; r < 16; ++r) { o[e][r] += ox[((qg * 4 + e) * 16 + r) * 64 + lane]; ss[r] += o[e][r] * o[e][r]; }
                const int ln = olane(), lq2 = ln & 31, hi2 = ln >> 5;
                char* mb_ = (char*)(mix + (size_t)(b * SEQ + r0) * D + h * 128);
#pragma unroll
                for (int r = 0; r < 16; ++r) {
#pragma unroll
                    for (int of = 1; of < 32; of <<= 1) ss[r] += shfl_idx(ss[r], ln ^ of);
                    ss[r] = rsqrtf(ss[r] * (1.f / 128.f) + 1e-6f) * (1.f - lambda_init);
                }
#pragma unroll
                for (int e = 0; e < 4; ++e) {
                    const float g = subln[e * 32 + lq2];
#pragma unroll
                    for (int r = 0; r < 16; ++r) {
                        const unsigned q = (unsigned)((r & 3) + 8 * (r >> 2) + 4 * hi2);
                        *(bf16*)(mb_ + (q * D + e * 32 + lq2) * 2u) = (bf16)f2bf(o[e][r] * ss[r] * g);
                    }
                }
            }
        }
    }
#undef VDST
}

__device__ __forceinline__ void attn_flash(unsigned char* ldsb, const bf16* proj, const float* lam_par, const float* subln, float lambda_init, bf16* mix, int bidx, int gdim) {
    const int wave = owave(), qg = wave >> 1, kh = wave & 1;
    float* stat = (float*)(ldsb + 65536);
    float* asc = (float*)(ldsb + 69632) + wave * 64;
    float* ftab = (float*)(ldsb + 71680) + wave * 64;
#pragma unroll 1
    for (int u = bidx; u < BATCH * A_HEADS * 8; u += gdim) {
        const int b = u >> 5, h = (u >> 3) & 3, pi = u & 7;
        const float* bt_h = (const float*)(ldsb + BT_OFF) + h * 128;
#pragma unroll 1
        for (int half = 0; half < 2; ++half) {
            const int lane = olane(), lq = lane & 31, hi = lane >> 5;
            const int vtr = (4 * hi + ((lane & 15) >> 2)) * 64 + (16 * ((lane >> 4) & 1) + 4 * (lane & 3)) * 2;
            const int qb = half == 0 ? 15 - pi : pi, R0 = qb * 128, r0 = R0 + 32 * qg, ntile = 2 * qb + 2, qrow = r0 + lq;
            const char* kbase = (const char*)(proj + (size_t)(b * SEQ) * IN_COLS + A_WIDTH + h * 128);
            { const char* qb_ = (const char*)(proj + (size_t)(b * SEQ + r0) * IN_COLS + h * 128); const unsigned qo = (unsigned)(lq * IN_COLS + 8 * hi) * 2u;
#pragma unroll
              for (int m = 0; m < 2; ++m)
#pragma unroll
                  for (int s4 = 0; s4 < 4; ++s4) {
                      const uint4 qw = *(const uint4*)(qb_ + qo + (m * 64 + 16 * s4) * 2);
                      const unsigned qq[4] = {qw.x, qw.y, qw.z, qw.w}; union { unsigned u[4]; bf16x8_t v; } qs;
#pragma unroll
                      for (int w = 0; w < 4; ++w) qs.u[w] = cvtpk(__uint_as_float(qq[w] << 16) * ATT_C, __uint_as_float(qq[w] & 0xffff0000u) * ATT_C);
                      *(bf16x8_t*)(ldsb + 73728 + ((wave * 8 + m * 4 + s4) * 64 + lane) * 16) = qs.v; } }
            unsigned ksrc[2], vsrc[2];
#pragma unroll
            for (int i = 0; i < 2; ++i) {
                const int p = wave * 64 + i * 512 + lane, row = p >> 4, c = (p & 15) ^ (row & 15);
                ksrc[i] = (unsigned)(row * IN_COLS * 2 + c * 16);
                const int o = p * 16, eb = o >> 12, ks = (o >> 10) & 3, sub = (o >> 9) & 1, r8 = (o >> 6) & 7, c16 = (o >> 4) & 3, kv = ks * 16 + sub * 8 + r8, sc = eb * 4 + c16;
                vsrc[i] = (unsigned)(kv * IN_COLS * 2 + 1024 + sc * 16);
            }
#define ATT_DMA(kt, bufp) do { _Pragma("unroll") for (int i_ = 0; i_ < 2; ++i_) { \
                __builtin_amdgcn_global_load_lds((const unsigned*)((kt) + ksrc[i_]), (__attribute__((address_space(3))) unsigned*)(unsigned)(uintptr_t)((bufp) + (wave * 64 + i_ * 512) * 16), 16, 0, 0); \
                __builtin_amdgcn_global_load_lds((const unsigned*)((kt) + vsrc[i_]), (__attribute__((address_space(3))) unsigned*)(unsigned)(uintptr_t)((bufp) + 16384 + (wave * 64 + i_ * 512) * 16), 16, 0, 0); } } while (0)
            float m1 = -1e30f, l1 = 0.f, m2 = -1e30f, l2 = 0.f;
            f32x16 o1[4], o2[4];
#pragma unroll
            for (int e = 0; e < 4; ++e)
#pragma unroll
                for (int r = 0; r < 16; ++r) { o1[e][r] = 0.f; o2[e][r] = 0.f; }
            __syncthreads();
            ATT_DMA(kbase, ldsb);
            asm volatile("s_waitcnt vmcnt(0)" ::: "memory");
            __syncthreads();
#pragma unroll 1
            for (int j = 0; j < ntile; ++j) {
                unsigned char* buf = ldsb + (j & 1) * 32768;
                unsigned char* nbuf = ldsb + ((j + 1) & 1) * 32768;
                const bool more = j + 1 < ntile;
                if (more) ATT_DMA(kbase + (size_t)(64 * (j + 1)) * IN_COLS * 2, nbuf);
                const int kv0 = 64 * j + 32 * kh;
                if (kv0 <= r0 + 31) {
                    f32x16 st1, st2;
#pragma unroll
                    for (int r = 0; r < 16; ++r) { st1[r] = 0.f; st2[r] = 0.f; }
                    const int krow = 32 * kh + lq;
#pragma unroll
                    for (int s4 = 0; s4 < 4; ++s4) {
                        const bf16x8_t a1 = *(const bf16x8_t*)(buf + krow * 256 + (((2 * s4 + hi) ^ (krow & 15)) << 4));
                        const bf16x8_t a2 = *(const bf16x8_t*)(buf + krow * 256 + (((8 + 2 * s4 + hi) ^ (krow & 15)) << 4));
                        const bf16x8_t q1 = *(const bf16x8_t*)(ldsb + 73728 + ((wave * 8 + s4) * 64 + lane) * 16), q2 = *(const bf16x8_t*)(ldsb + 73728 + ((wave * 8 + 4 + s4) * 64 + lane) * 16);
                        st1 = __builtin_amdgcn_mfma_f32_32x32x16_bf16(a1, q1, st1, 0, 0, 0);
                        st2 = __builtin_amdgcn_mfma_f32_32x32x16_bf16(a2, q2, st2, 0, 0, 0);
                    }
                    const int kvb = kv0 + 4 * hi;
                    if (kv0 + 31 + 113 > r0) { att_scores<true>(st1, bt_h, qrow, kvb); att_scores<true>(st2, bt_h, qrow, kvb); }
                    else { att_scores<false>(st1, bt_h, qrow, kvb); att_scores<false>(st2, bt_h, qrow, kvb); }
                    float t1 = st1[0], t2 = st2[0];
#pragma unroll
                    for (int r = 1; r < 16; ++r) { t1 = fmaxf(t1, st1[r]); t2 = fmaxf(t2, st2[r]); }
                    { const auto ra = __builtin_amdgcn_permlane32_swap(__float_as_uint(t1), __float_as_uint(t1), false, false); t1 = fmaxf(__uint_as_float(ra[0]), __uint_as_float(ra[1]));
                      const auto rb = __builtin_amdgcn_permlane32_swap(__float_as_uint(t2), __float_as_uint(t2), false, false); t2 = fmaxf(__uint_as_float(rb[0]), __uint_as_float(rb[1])); }
                    if (__builtin_amdgcn_ballot_w64(t1 > m1 + 8.f || t2 > m2 + 8.f) != 0ull) {
                        const float n1 = fmaxf(m1, t1), n2 = fmaxf(m2, t2);
                        const float a1 = __builtin_amdgcn_exp2f(m1 - n1), a2 = __builtin_amdgcn_exp2f(m2 - n2);
                        l1 *= a1; l2 *= a2; m1 = n1; m2 = n2;
                        if (hi == 0) { asc[lq] = a1; asc[32 + lq] = a2; }
                        asm volatile("s_waitcnt lgkmcnt(0)" ::: "memory");
#pragma unroll
                        for (int g = 0; g < 4; ++g) {
                            const float4 f1 = *(const float4*)(asc + 8 * g + 4 * hi), f2 = *(const float4*)(asc + 32 + 8 * g + 4 * hi);
#pragma unroll
                            for (int e = 0; e < 4; ++e) {
                                o1[e][4 * g] *= f1.x; o1[e][4 * g + 1] *= f1.y; o1[e][4 * g + 2] *= f1.z; o1[e][4 * g + 3] *= f1.w;
                                o2[e][4 * g] *= f2.x; o2[e][4 * g + 1] *= f2.y; o2[e][4 * g + 2] *= f2.z; o2[e][4 * g + 3] *= f2.w;
                            }
                        }
                        asm volatile("s_waitcnt lgkmcnt(0)" ::: "memory");
                    }
                    float s1 = 0.f, s2 = 0.f;
#pragma unroll
                    for (int r = 0; r < 16; ++r) { st1[r] = __builtin_amdgcn_exp2f(st1[r] - m1); s1 += st1[r]; st2[r] = __builtin_amdgcn_exp2f(st2[r] - m2); s2 += st2[r]; }
                    l1 += s1; l2 += s2;
                    const unsigned char* vb = buf + 16384 + vtr + (2 * kh) * 1024;
#pragma unroll
                    for (int s2i = 0; s2i < 2; ++s2i) {
                        union { unsigned u[4]; bf16x8_t v; } pa, pb;
#pragma unroll
                        for (int w = 0; w < 4; ++w) { pa.u[w] = cvtpk(st1[8 * s2i + 2 * w], st1[8 * s2i + 2 * w + 1]); pb.u[w] = cvtpk(st2[8 * s2i + 2 * w], st2[8 * s2i + 2 * w + 1]); }
#pragma unroll
                        for (int e = 0; e < 4; ++e) {
                            const s16x4_t lo = __builtin_bit_cast(s16x4_t, __builtin_amdgcn_ds_read_tr16_b64_v4i16((__attribute__((address_space(3))) s16x4_t*)(unsigned)(uintptr_t)(vb + e * 4096 + s2i * 1024)));
                            const s16x4_t hh = __builtin_bit_cast(s16x4_t, __builtin_amdgcn_ds_read_tr16_b64_v4i16((__attribute__((address_space(3))) s16x4_t*)(unsigned)(uintptr_t)(vb + e * 4096 + s2i * 1024 + 512)));
                            const bf16x8_t bv = (bf16x8_t){lo[0], lo[1], lo[2], lo[3], hh[0], hh[1], hh[2], hh[3]};
                            o1[e] = __builtin_amdgcn_mfma_f32_32x32x16_bf16(pa.v, bv, o1[e], 0, 0, 0);
                            o2[e] = __builtin_amdgcn_mfma_f32_32x32x16_bf16(pb.v, bv, o2[e], 0, 0, 0);
                        }
                    }
                }
                asm volatile("s_waitcnt vmcnt(0)" ::: "memory");
                __syncthreads();
            }
            { const auto ra = __builtin_amdgcn_permlane32_swap(__float_as_uint(l1), __float_as_uint(l1), false, false); l1 = __uint_as_float(ra[0]) + __uint_as_float(ra[1]);
              const auto rb = __builtin_amdgcn_permlane32_swap(__float_as_uint(l2), __float_as_uint(l2), false, false); l2 = __uint_as_float(rb[0]) + __uint_as_float(rb[1]); }
            if (hi == 0) ((float4*)stat)[wave * 32 + lq] = make_float4(m1, l1, m2, l2);
            __syncthreads();
            float lam;
            { float l01 = lam_par[lane] * lam_par[64 + lane], l23 = lam_par[128 + lane] * lam_par[192 + lane];
              l01 = wave_sum_fast(l01); l23 = wave_sum_fast(l23); lam = __expf(l01) - __expf(l23) + lambda_init; }
            if (hi == 0) {
                const float4 pb = ((const float4*)stat)[(wave ^ 1) * 32 + lq];
                const float M1 = fmaxf(m1, pb.x), M2 = fmaxf(m2, pb.z);
                const float e1 = __builtin_amdgcn_exp2f(m1 - M1), e2 = __builtin_amdgcn_exp2f(m2 - M2);
                const float L1 = l1 * e1 + pb.y * __builtin_amdgcn_exp2f(pb.x - M1), L2 = l2 * e2 + pb.w * __builtin_amdgcn_exp2f(pb.z - M2);
                ftab[lq] = e1 / L1; ftab[32 + lq] = -lam * e2 / L2;
            }
            asm volatile("s_waitcnt lgkmcnt(0)" ::: "memory");
#pragma unroll
            for (int g = 0; g < 4; ++g) {
                const float4 f1 = *(const float4*)(ftab + 8 * g + 4 * hi), f2 = *(const float4*)(ftab + 32 + 8 * g + 4 * hi);
#pragma unroll
                for (int e = 0; e < 4; ++e) {
                    o1[e][4 * g] = o1[e][4 * g] * f1.x + o2[e][4 * g] * f2.x; o1[e][4 * g + 1] = o1[e][4 * g + 1] * f1.y + o2[e][4 * g + 1] * f2.y;
                    o1[e][4 * g + 2] = o1[e][4 * g + 2] * f1.z + o2[e][4 * g + 2] * f2.z; o1[e][4 * g + 3] = o1[e][4 * g + 3] * f1.w + o2[e][4 * g + 3] * f2.w;
                }
            }
            __syncthreads();
            float* ox = (float*)ldsb;
            if (kh == 1) {
#pragma unroll
                for (int e = 0; e < 4; ++e)
#pragma unroll
                    for (int r = 0; r < 16; ++r) ox[((qg * 4 + e) * 16 + r) * 64 + lane] = o1[e][r];
            }
            __syncthreads();
            if (kh == 0) {
                float ss[16];
#pragma unroll
                for (int r = 0; r < 16; ++r) ss[r] = 0.f;
#pragma unroll
                for (int e = 0; e < 4; ++e)
#pragma unroll
                    for (int r = 0; r < 16; ++r) { o1[e][r] += ox[((qg * 4 + e) * 16 + r) * 64 + lane]; ss[r] += o1[e][r] * o1[e][r]; }
                const int ln = olane(), lq2 = ln & 31, hi2 = ln >> 5;
                char* mb_ = (char*)(mix + (size_t)(b * SEQ + r0) * D + h * 128);
#pragma unroll
                for (int r = 0; r < 16; ++r) {
#pragma unroll
                    for (int of = 1; of < 32; of <<= 1) ss[r] += shfl_idx(ss[r], ln ^ of);
                    ss[r] = rsqrtf(ss[r] * (1.f / 128.f) + 1e-6f) * (1.f - lambda_init);
                }
#pragma unroll
                for (int e = 0; e < 4; ++e) {
                    const float g = subln[e * 32 + lq2];
#pragma unroll
                    for (int r = 0; r < 16; ++r) {
                        const unsigned q = (unsigned)((r & 3) + 8 * (r >> 2) + 4 * hi2);
                        *(bf16*)(mb_ + (q * D + e * 32 + lq2) * 2u) = (bf16)f2bf(o1[e][r] * ss[r] * g);
                    }
                }
            }
        }
    }
#undef ATT_DMA
#undef VDST
}

typedef float f32x4_t __attribute__((ext_vector_type(4)));
constexpr int PL_STRIDE = 1536 + 16, AL_STRIDE = 512 + 16;
constexpr int PREP_PL = 0, PREP_AL = 64 * PL_STRIDE, PREP_KS = PREP_AL + 64 * AL_STRIDE;
__device__ __forceinline__ void rwkv_prep_phase(unsigned char* ldsb, const bf16* proj, const float* mu, const float* w0, const bf16* w2T, const float* a0, const bf16* a2T, const bf16* g2T,
                                                const float* k_k, const float* k_a, float* RW) {
    const int tidx = otid(), bidx = obid(), gdim = ogdim();
    const int wave = tidx >> 6, lane = tidx & 63, fr = lane & 15, fq = lane >> 4;
    constexpr size_t AS = (size_t)T * 256;
#pragma unroll 1
    for (int u = bidx; u < T / 64; u += gdim) {
        const int t0 = u * 64;
        __syncthreads();
#pragma unroll 2
        for (int i = 0; i < 16; ++i) {
            const int id = tidx + 512 * i, tok = id >> 7, cc = id & 127, c = cc * 8, t = t0 + tok;
            const bf16* src = proj + (size_t)t * IN_COLS + A_COLS + c;
            const uint4 cu = *(const uint4*)src;
            uint4 pv = make_uint4(0u, 0u, 0u, 0u);
            if ((t & (SEQ - 1)) != 0) pv = *(const uint4*)(src - IN_COLS);
            const float4 m0 = *(const float4*)(mu + c), m1 = *(const float4*)(mu + c + 4);
            const unsigned cw[4] = {cu.x, cu.y, cu.z, cu.w}, pw[4] = {pv.x, pv.y, pv.z, pv.w};
            const float mm[8] = {m0.x, m0.y, m0.z, m0.w, m1.x, m1.y, m1.z, m1.w};
            float p[8];
#pragma unroll
            for (int j = 0; j < 4; ++j) {
                const float c0 = __uint_as_float(cw[j] << 16), c1 = __uint_as_float(cw[j] & 0xffff0000u), p0 = __uint_as_float(pw[j] << 16), p1 = __uint_as_float(pw[j] & 0xffff0000u);
                p[2 * j] = c0 + (p0 - c0) * mm[2 * j]; p[2 * j + 1] = c1 + (p1 - c1) * mm[2 * j + 1];
            }
            unsigned char* dst;
            if (c < 768) dst = ldsb + PREP_PL + tok * PL_STRIDE + c * 2;
            else {
                dst = ldsb + PREP_AL + tok * AL_STRIDE + (c - 768) * 2;
                if (c < 832) {
#pragma unroll
                    for (int j = 0; j < 8; ++j) { const float e2 = __expf(2.f * p[j]); p[j] = 1.f - 2.f / (e2 + 1.f); }
                } else if (c >= 896) {
#pragma unroll
                    for (int j = 0; j < 8; ++j) p[j] = 1.f / (1.f + __expf(-p[j]));
                }
            }
            *(uint4*)dst = make_uint4(pk2(p[0], p[1]), pk2(p[2], p[3]), pk2(p[4], p[5]), pk2(p[6], p[7]));
        }
        __syncthreads();
        if (tidx < 256) {
            const int tok = tidx >> 2, hd = tidx & 3;
            const unsigned char* kp = ldsb + PREP_PL + tok * PL_STRIDE + (256 + hd * 64) * 2;
            float ss = 0.f;
#pragma unroll 4
            for (int j = 0; j < 64; j += 2) { const unsigned w = *(const unsigned*)(kp + j * 2); const float2 kk2 = *(const float2*)(k_k + hd * 64 + j);
                const float x0 = __uint_as_float(w << 16) * kk2.x, x1 = __uint_as_float(w & 0xffff0000u) * kk2.y; ss += x0 * x0 + x1 * x1; }
            ((float*)(ldsb + PREP_KS))[tok * 4 + hd] = ss;
        }
        __syncthreads();
        const int n0 = wave * 32, hd = wave >> 1;
        bf16x8_t bw[2][2], ba[2][2], bg[2][4];
#pragma unroll
        for (int ct = 0; ct < 2; ++ct) {
            const int n = n0 + 16 * ct + fr;
#pragma unroll
            for (int ks = 0; ks < 2; ++ks) { bw[ct][ks] = *(const bf16x8_t*)(w2T + n * 64 + 32 * ks + 8 * fq); ba[ct][ks] = *(const bf16x8_t*)(a2T + n * 64 + 32 * ks + 8 * fq); }
#pragma unroll
            for (int ks = 0; ks < 4; ++ks) bg[ct][ks] = *(const bf16x8_t*)(g2T + n * 128 + 32 * ks + 8 * fq);
        }
#pragma unroll 1
        for (int rt = 0; rt < 4; ++rt) {
            const unsigned char* ar = ldsb + PREP_AL + (16 * rt + fr) * AL_STRIDE + 16 * fq;
            bf16x8_t af[8];
#pragma unroll
            for (int ks = 0; ks < 8; ++ks) af[ks] = *(const bf16x8_t*)(ar + 64 * ks);
#pragma unroll
            for (int ct = 0; ct < 2; ++ct) {
                f32x4_t cw_ = {0.f, 0.f, 0.f, 0.f}, ca_ = {0.f, 0.f, 0.f, 0.f}, cg_ = {0.f, 0.f, 0.f, 0.f};
#pragma unroll
                for (int ks = 0; ks < 2; ++ks) { cw_ = __builtin_amdgcn_mfma_f32_16x16x32_bf16(af[ks], bw[ct][ks], cw_, 0, 0, 0); ca_ = __builtin_amdgcn_mfma_f32_16x16x32_bf16(af[2 + ks], ba[ct][ks], ca_, 0, 0, 0); }
#pragma unroll
                for (int ks = 0; ks < 4; ++ks) cg_ = __builtin_amdgcn_mfma_f32_16x16x32_bf16(af[4 + ks], bg[ct][ks], cg_, 0, 0, 0);
                const int ch = n0 + 16 * ct + fr;
                const float w0c = w0[ch], a0c = a0[ch], kkc = k_k[ch], kac = k_a[ch];
#pragma unroll
                for (int rg = 0; rg < 4; ++rg) {
                    const int tok = 16 * rt + 4 * fq + rg;
                    const unsigned char* pr = ldsb + PREP_PL + tok * PL_STRIDE + ch * 2;
                    const float r = bf2f(*(const bf16*)pr), k = bf2f(*(const bf16*)(pr + 512)), v = bf2f(*(const bf16*)(pr + 1024));
                    const float zw = w0c + cw_[rg];
                    const float sp = (-zw > 20.f) ? -zw : __logf(1.f + __expf(-zw));
                    const float decay = __expf(-__expf(-sp - 0.5f));
                    const float a = 1.f / (1.f + __expf(-(a0c + ca_[rg])));
                    const float ss = ((const float*)(ldsb + PREP_KS))[tok * 4 + hd];
                    const float kk = k * kkc * rsqrtf(fmaxf(ss, 1e-24f));
                    float* o = RW + (size_t)(t0 + tok) * 256 + ch;
                    o[0] = r; o[AS] = decay; o[2 * AS] = k * (1.f + (a - 1.f) * kac); o[3 * AS] = v; o[4 * AS] = -kk; o[5 * AS] = kk * a; o[6 * AS] = cg_[rg];
                }
            }
        }
    }
}


template <int CTRL> __device__ __forceinline__ float dpp_f(float v) { return __int_as_float(__builtin_amdgcn_update_dpp(0, __float_as_int(v), CTRL, 0xF, 0xF, false)); }
constexpr int VT_STRIDE = 256 + 16;
__device__ __forceinline__ float gelu_fast(float x) { const float u = 1.5957691216057308f * (x + 0.044715f * x * x * x); return x / (1.f + __expf(-u)); }
__device__ __forceinline__ void gmlp_phase(unsigned char* ldsb, const bf16* proj, const float* ln_g, const float* ln_b, const bf16* wsb, const float* b_s, bf16* mix, int bidx, int gdim) {
    const int tidx = otid();
    const int wave = tidx >> 6, lane = tidx & 63, fr = lane & 15, fq = lane >> 4;
#pragma unroll 1
    for (int u = bidx; u < T / CHUNK; u += gdim) {
        const int t0 = u * CHUNK;
        __syncthreads();
        {
            const int tok = tidx >> 2, qd = tidx & 3;
            const bf16* pv = proj + (size_t)(t0 + tok) * IN_COLS + A_COLS + B_COLS + 256 + qd * 64;
            float s1 = 0.f, s2 = 0.f;
#pragma unroll 2
            for (int j = 0; j < 8; ++j) {
                const uint4 w = *(const uint4*)(pv + 8 * j);
                const unsigned ww[4] = {w.x, w.y, w.z, w.w};
#pragma unroll
                for (int i = 0; i < 4; ++i) { const float g0 = gelu_fast(__uint_as_float(ww[i] << 16)), g1 = gelu_fast(__uint_as_float(ww[i] & 0xffff0000u)); s1 += g0 + g1; s2 += g0 * g0 + g1 * g1; }
            }
            s1 += dpp_f<0xB1>(s1); s1 += dpp_f<0x4E>(s1); s2 += dpp_f<0xB1>(s2); s2 += dpp_f<0x4E>(s2);
            const float mean = s1 * (1.f / 256.f), var = fmaxf(s2 * (1.f / 256.f) - mean * mean, 0.f), rstd = rsqrtf(var + 1e-5f);
#pragma unroll 2
            for (int j = 0; j < 8; ++j) {
                const uint4 w = *(const uint4*)(pv + 8 * j);
                const unsigned ww[4] = {w.x, w.y, w.z, w.w};
#pragma unroll
                for (int i = 0; i < 4; ++i) {
                    const int ch = qd * 64 + 8 * j + 2 * i;
                    const float g0 = gelu_fast(__uint_as_float(ww[i] << 16)), g1 = gelu_fast(__uint_as_float(ww[i] & 0xffff0000u));
                    *(bf16*)(ldsb + ch * VT_STRIDE + tok * 2) = (bf16)f2bf((g0 - mean) * rstd * ln_g[ch] + ln_b[ch]);
                    *(bf16*)(ldsb + (ch + 1) * VT_STRIDE + tok * 2) = (bf16)f2bf((g1 - mean) * rstd * ln_g[ch + 1] + ln_b[ch + 1]);
                }
            }
        }
        __syncthreads();
        const int rt = wave, nks = (16 * rt + 15) / 32 + 1;
#pragma unroll 1
        for (int g = 0; g < 4; ++g) {
            bf16x8_t af[4];
#pragma unroll
            for (int ks = 0; ks < 4; ++ks) if (ks < nks) af[ks] = *(const bf16x8_t*)(wsb + ((size_t)g * CHUNK + 16 * rt + fr) * CHUNK + 32 * ks + 8 * fq);
            float bs[4];
#pragma unroll
            for (int rg = 0; rg < 4; ++rg) bs[rg] = b_s[g * CHUNK + 16 * rt + 4 * fq + rg];
#pragma unroll
            for (int ct = 0; ct < 4; ++ct) {
                const int ch = g * 64 + 16 * ct + fr;
                f32x4_t acc = {0.f, 0.f, 0.f, 0.f};
#pragma unroll
                for (int ks = 0; ks < 4; ++ks) if (ks < nks) {
                    const bf16x8_t bv = *(const bf16x8_t*)(ldsb + ch * VT_STRIDE + (32 * ks + 8 * fq) * 2);
                    acc = __builtin_amdgcn_mfma_f32_16x16x32_bf16(af[ks], bv, acc, 0, 0, 0);
                }
#pragma unroll
                for (int rg = 0; rg < 4; ++rg) {
                    const int t = t0 + 16 * rt + 4 * fq + rg;
                    const float uu = gelu_fast(bf2f(proj[(size_t)t * IN_COLS + A_COLS + B_COLS + ch]));
                    mix[(size_t)t * D + A_WIDTH + B_WIDTH + ch] = (bf16)f2bf(uu * (acc[rg] + bs[rg]));
                }
            }
        }
    }
}

typedef float f32x4c __attribute__((ext_vector_type(4)));
constexpr size_t CK_M3 = 0, CK_N2 = 8192, CK_R2 = 16384, CK_Y2 = 18432, CK_G15 = 22528, CK_BYTES = 22784;
__device__ __forceinline__ f32x4c mfma16(bf16x8_t a, bf16x8_t b, f32x4c c) { return __builtin_amdgcn_mfma_f32_16x16x32_bf16(a, b, c, 0, 0, 0); }
__device__ __forceinline__ bf16x8_t ldfrag(const unsigned char* p) { return *(const bf16x8_t*)p; }
constexpr int CP_RT = 0, CP_ATT = 2048, CP_VT = 4096, CP_BHT = 6144, CP_KHT = 8192, CP_AT = 10240, CP_BT = 12288, CP_KT = 14336, CP_G3I = 16384, CP_G4I = 16896, CP_WAVE = 17408;
constexpr int CP_LF = CP_AT, CP_TI = CP_AT + 1024, CP_LAKT = CP_AT + 1536, CP_CI = CP_LF;
constexpr int CP_PT = CP_BT, CP_QT = CP_KT;
__device__ __forceinline__ void chunk_prep(unsigned char* ldsb, const float* RW, unsigned char* CK) {
    const int wave = owave(), bidx = obid(), gdim = ogdim();
    unsigned char* L = ldsb + wave * CP_WAVE;
    constexpr size_t AS = (size_t)T * 256;
#pragma unroll 1
    for (int cid = bidx * 8 + wave; cid < BATCH * 4 * (SEQ / 16); cid += gdim * 8) {
        const int lane = olane(), c = lane & 15, g = lane >> 4;
        const int bh = cid >> 7, ch = cid & 127, b = bh >> 2, h = bh & 3;
        const float* base = RW + (size_t)(b * SEQ + ch * 16) * 256 + h * 64 + lane;
        unsigned char* ck = CK + (size_t)cid * CK_BYTES;
        float gam = 1.f, bt[16], kt[16];
#pragma unroll
        for (int t = 0; t < 16; ++t) {
            const float* p = base + (size_t)t * 256;
            const float r = p[0], w = p[AS], k = p[2 * AS], v = p[3 * AS], a = p[4 * AS], bb = p[5 * AS];
            const float gp = gam; gam *= w;
            const float ig = 1.f / gam;
            bt[t] = bb * ig; kt[t] = k * ig;
            *(bf16*)(L + CP_AT + t * 128 + lane * 2) = (bf16)f2bf(a * gp);
            *(bf16*)(L + CP_RT + t * 128 + lane * 2) = (bf16)f2bf(r * gam);
            *(bf16*)(L + CP_BT + t * 128 + lane * 2) = (bf16)f2bf(bt[t]);
            *(bf16*)(L + CP_KT + t * 128 + lane * 2) = (bf16)f2bf(kt[t]);
            *(bf16*)(L + CP_ATT + lane * 32 + t * 2) = (bf16)f2bf(a * gp);
            *(bf16*)(L + CP_VT + lane * 32 + t * 2) = (bf16)f2bf(v);
        }
#pragma unroll
        for (int t = 0; t < 16; ++t) { *(bf16*)(L + CP_BHT + lane * 32 + t * 2) = (bf16)f2bf(bt[t] * gam); *(bf16*)(L + CP_KHT + lane * 32 + t * 2) = (bf16)f2bf(kt[t] * gam); }
        *(float*)(ck + CK_G15 + lane * 4) = gam;
        asm volatile("s_waitcnt lgkmcnt(0)" ::: "memory");
        const int kq2 = g & 1;
        const bf16x8_t zero8 = {0, 0, 0, 0, 0, 0, 0, 0};
        {
            f32x4c g1 = {0.f, 0.f, 0.f, 0.f}, g2 = g1, g3 = g1, g4 = g1;
#pragma unroll
            for (int ks = 0; ks < 2; ++ks) {
                const int ko = (32 * ks + 8 * g) * 2;
                const bf16x8_t xa = ldfrag(L + CP_AT + c * 128 + ko), xr = ldfrag(L + CP_RT + c * 128 + ko), yb = ldfrag(L + CP_BT + c * 128 + ko), yk = ldfrag(L + CP_KT + c * 128 + ko);
                g1 = mfma16(xa, yb, g1); g2 = mfma16(xa, yk, g2); g3 = mfma16(xr, yb, g3); g4 = mfma16(xr, yk, g4);
            }
            asm volatile("s_waitcnt lgkmcnt(0)" ::: "memory");
            unsigned lk[2] = {0u, 0u};
#pragma unroll
            for (int rg = 0; rg < 4; ++rg) {
                const int t = 4 * g + rg;
                *(float*)(L + CP_LF + (t * 16 + c) * 4) = c < t ? g1[rg] : 0.f;
                const unsigned v2 = f2bf(c < t ? g2[rg] : 0.f); lk[rg >> 1] |= v2 << (16 * (rg & 1));
                *(bf16*)(L + CP_G3I + t * 32 + c * 2) = (bf16)f2bf(c <= t ? g3[rg] : 0.f);
                *(bf16*)(L + CP_G4I + t * 32 + c * 2) = (bf16)f2bf(c <= t ? g4[rg] : 0.f);
            }
            *(uint2*)(L + CP_LAKT + c * 32 + 4 * g * 2) = make_uint2(lk[0], lk[1]);
        }
        asm volatile("s_waitcnt lgkmcnt(0)" ::: "memory");
        {
            float tc[16];
#pragma unroll
            for (int t = 0; t < 16; ++t) {
                float acc = (t == c) ? 1.f : 0.f;
#pragma unroll
                for (int s4 = 0; s4 < t; s4 += 4) {
                    const float4 l4 = *(const float4*)(L + CP_LF + (t * 16 + s4) * 4);
                    acc += l4.x * tc[s4];
                    if (s4 + 1 < t) acc += l4.y * tc[s4 + 1];
                    if (s4 + 2 < t) acc += l4.z * tc[s4 + 2];
                    if (s4 + 3 < t) acc += l4.w * tc[s4 + 3];
                }
                tc[t] = acc;
                if (g == 0) *(bf16*)(L + CP_TI + t * 32 + c * 2) = (bf16)f2bf(acc);
            }
        }
        asm volatile("s_waitcnt lgkmcnt(0)" ::: "memory");
        const bf16x8_t aT = g < 2 ? ldfrag(L + CP_TI + c * 32 + 8 * g * 2) : zero8;
#pragma unroll
        for (int ct = 0; ct < 4; ++ct) {
            const f32x4c z = {0.f, 0.f, 0.f, 0.f};
            const f32x4c p = mfma16(aT, ldfrag(L + CP_ATT + (16 * ct + c) * 32 + 8 * kq2 * 2), z);
            *(uint2*)(L + CP_PT + (16 * ct + c) * 32 + 4 * g * 2) = make_uint2(pk2(p[0], p[1]), pk2(p[2], p[3]));
        }
        {
            const f32x4c z = {0.f, 0.f, 0.f, 0.f};
            const f32x4c cm = mfma16(aT, ldfrag(L + CP_LAKT + c * 32 + 8 * kq2 * 2), z);
#pragma unroll
            for (int rg = 0; rg < 4; ++rg) *(bf16*)(L + CP_CI + (4 * g + rg) * 32 + c * 2) = (bf16)f2bf(cm[rg]);
        }
        asm volatile("s_waitcnt lgkmcnt(0)" ::: "memory");
        {
            const bf16x8_t aC = g < 2 ? ldfrag(L + CP_CI + c * 32 + 8 * g * 2) : zero8;
#pragma unroll
            for (int ct = 0; ct < 4; ++ct) {
                const f32x4c z = {0.f, 0.f, 0.f, 0.f};
                const f32x4c q = mfma16(aC, ldfrag(L + CP_VT + (16 * ct + c) * 32 + 8 * kq2 * 2), z);
                *(uint2*)(L + CP_QT + (16 * ct + c) * 32 + 4 * g * 2) = make_uint2(pk2(q[0], q[1]), pk2(q[2], q[3]));
            }
        }
        asm volatile("s_waitcnt lgkmcnt(0)" ::: "memory");
        {
            const bf16x8_t aG3 = g < 2 ? ldfrag(L + CP_G3I + c * 32 + 8 * g * 2) : zero8;
            const bf16x8_t aG34 = g < 2 ? ldfrag(L + CP_G3I + c * 32 + 8 * g * 2) : ldfrag(L + CP_G4I + c * 32 + 8 * (g - 2) * 2);
#pragma unroll
            for (int ct = 0; ct < 4; ++ct) {
                f32x4c r2;
#pragma unroll
                for (int rg = 0; rg < 4; ++rg) r2[rg] = bf2f(*(const bf16*)(L + CP_RT + (4 * g + rg) * 128 + (16 * ct + c) * 2));
                r2 = mfma16(aG3, ldfrag(L + CP_PT + (16 * ct + c) * 32 + 8 * kq2 * 2), r2);
                const int pp = 32 * (ct >> 1) + 8 * (c >> 2) + 4 * (ct & 1) + (c & 3);
#pragma unroll
                for (int rg = 0; rg < 4; ++rg) *(bf16*)(L + CP_ATT + ((4 * g + rg) * 64 + pp) * 2) = (bf16)f2bf(r2[rg]);
                const bf16x8_t bqv = g < 2 ? ldfrag(L + CP_QT + (16 * ct + c) * 32 + 8 * g * 2) : ldfrag(L + CP_VT + (16 * ct + c) * 32 + 8 * (g - 2) * 2);
                const f32x4c z = {0.f, 0.f, 0.f, 0.f};
                const f32x4c y2 = mfma16(aG34, bqv, z);
                *(f32x4c*)(ck + CK_Y2 + (ct * 64 + lane) * 16) = y2;
            }
        }
        asm volatile("s_waitcnt lgkmcnt(0)" ::: "memory");
        { const uint4 v0 = *(const uint4*)(L + CP_ATT + lane * 16), v1 = *(const uint4*)(L + CP_ATT + 1024 + lane * 16);
          *(uint4*)(ck + CK_R2 + lane * 16) = v0; *(uint4*)(ck + CK_R2 + 1024 + lane * 16) = v1; }
        asm volatile("s_waitcnt lgkmcnt(0)" ::: "memory");
#pragma unroll 1
        for (int jt = 0; jt < 4; ++jt) {
            const bf16x8_t aB = g < 2 ? ldfrag(L + CP_BHT + (16 * jt + c) * 32 + 8 * g * 2) : zero8;
            const bf16x8_t aBK = g < 2 ? ldfrag(L + CP_BHT + (16 * jt + c) * 32 + 8 * g * 2) : ldfrag(L + CP_KHT + (16 * jt + c) * 32 + 8 * (g - 2) * 2);
#pragma unroll
            for (int ct = 0; ct < 4; ++ct) {
                const f32x4c z = {0.f, 0.f, 0.f, 0.f};
                const f32x4c m2 = mfma16(aB, ldfrag(L + CP_PT + (16 * ct + c) * 32 + 8 * kq2 * 2), z);
                const int pp = 32 * (ct >> 1) + 8 * (c >> 2) + 4 * (ct & 1) + (c & 3);
#pragma unroll
                for (int rg = 0; rg < 4; ++rg) *(bf16*)(L + CP_ATT + ((4 * g + rg) * 64 + pp) * 2) = (bf16)f2bf(m2[rg]);
                const bf16x8_t bqv = g < 2 ? ldfrag(L + CP_QT + (16 * ct + c) * 32 + 8 * g * 2) : ldfrag(L + CP_VT + (16 * ct + c) * 32 + 8 * (g - 2) * 2);
                const f32x4c n2 = mfma16(aBK, bqv, z);
                *(uint2*)(ck + CK_N2 + ((ct * 4 + jt) * 64 + lane) * 8) = make_uint2(pk2(n2[0], n2[1]), pk2(n2[2], n2[3]));
            }
            asm volatile("s_waitcnt lgkmcnt(0)" ::: "memory");
            { const uint4 v0 = *(const uint4*)(L + CP_ATT + lane * 16), v1 = *(const uint4*)(L + CP_ATT + 1024 + lane * 16);
              *(uint4*)(ck + CK_M3 + jt * 2048 + lane * 16) = v0; *(uint4*)(ck + CK_M3 + jt * 2048 + 1024 + lane * 16) = v1; }
            asm volatile("s_waitcnt lgkmcnt(0)" ::: "memory");
        }
        asm volatile("s_waitcnt lgkmcnt(0)" ::: "memory");
    }
}
struct CkOps { bf16x8_t am[4][2], ar[2]; f32x4c y; uint2 n2[4]; f32x4c g15[4]; };
__device__ __forceinline__ void ck_load(CkOps& o, const unsigned char* ck, int it, int lane, int c, int g) {
#pragma unroll
    for (int ks = 0; ks < 2; ++ks) {
        o.ar[ks] = *(const bf16x8_t*)(ck + CK_R2 + (c * 64 + 32 * ks + 8 * g) * 2);
#pragma unroll
        for (int jt = 0; jt < 4; ++jt) o.am[jt][ks] = *(const bf16x8_t*)(ck + CK_M3 + ((16 * jt + c) * 64 + 32 * ks + 8 * g) * 2);
    }
    o.y = *(const f32x4c*)(ck + CK_Y2 + (it * 64 + lane) * 16);
#pragma unroll
    for (int jt = 0; jt < 4; ++jt) { o.n2[jt] = *(const uint2*)(ck + CK_N2 + ((it * 4 + jt) * 64 + lane) * 8); o.g15[jt] = *(const f32x4c*)(ck + CK_G15 + (16 * jt + 4 * g) * 4); }
}
__device__ __forceinline__ void ck_step(const CkOps& o, f32x4c (&hs)[4], float* yp, int ch, int g) {
    bf16x8_t hb[2];
#pragma unroll
    for (int ks = 0; ks < 2; ++ks) {
        union { unsigned u[4]; bf16x8_t v; } t_;
        t_.u[0] = cvtpk(hs[2 * ks][0], hs[2 * ks][1]); t_.u[1] = cvtpk(hs[2 * ks][2], hs[2 * ks][3]); t_.u[2] = cvtpk(hs[2 * ks + 1][0], hs[2 * ks + 1][1]); t_.u[3] = cvtpk(hs[2 * ks + 1][2], hs[2 * ks + 1][3]);
        hb[ks] = t_.v;
    }
    f32x4c y = mfma16(o.ar[0], hb[0], o.y); y = mfma16(o.ar[1], hb[1], y);
#pragma unroll
    for (int rg = 0; rg < 4; ++rg) yp[(size_t)(ch * 16 + 4 * g + rg) * 256] = y[rg];
#pragma unroll
    for (int jt = 0; jt < 4; ++jt) {
        f32x4c a = hs[jt] * o.g15[jt];
        a[0] += __uint_as_float(o.n2[jt].x << 16); a[1] += __uint_as_float(o.n2[jt].x & 0xffff0000u); a[2] += __uint_as_float(o.n2[jt].y << 16); a[3] += __uint_as_float(o.n2[jt].y & 0xffff0000u);
        a = mfma16(o.am[jt][0], hb[0], a); a = mfma16(o.am[jt][1], hb[1], a);
        hs[jt] = a;
    }
}
__device__ __forceinline__ void chunk_scan(const unsigned char* CK, float* Yout, int unit) {
    const int lane = olane(), c = lane & 15, g = lane >> 4;
    const int bh = unit >> 2, it = unit & 3, b = bh >> 2, h = bh & 3;
    f32x4c hs[4];
#pragma unroll
    for (int jt = 0; jt < 4; ++jt) hs[jt] = (f32x4c){0.f, 0.f, 0.f, 0.f};
    const unsigned char* ck = CK + (size_t)(bh * 128) * CK_BYTES;
    float* yp = Yout + (size_t)(b * SEQ) * 256 + h * 64 + 16 * it + c;
    CkOps oa, ob;
    ck_load(oa, ck, it, lane, c, g);
#pragma unroll 1
    for (int ch = 0; ch < SEQ / 16; ch += 2) {
        ck_load(ob, ck + CK_BYTES, it, lane, c, g);
        ck_step(oa, hs, yp, ch, g);
        ck_load(oa, ck + (ch + 2 < SEQ / 16 ? 2 : 0) * CK_BYTES, it, lane, c, g);
        ck_step(ob, hs, yp, ch + 1, g);
        ck += 2 * CK_BYTES;
    }
}


constexpr int LC_NS = 6, LC_SLOT = 13824, LC_R2 = 8192, LC_N2 = 10240, LC_Y2 = 12288, LC_G15 = 13312, LC_FLAGS = LC_NS * LC_SLOT;
__device__ __forceinline__ void lc_dma16(const void* gsrc, unsigned lds_dst) { unsigned keep;
    asm volatile("s_mov_b32 %0, m0\n\ts_mov_b32 m0, %2\n\ts_nop 0\n\tglobal_load_lds_dwordx4 %1, off\n\ts_mov_b32 m0, %0" : "=&s"(keep) : "v"(gsrc), "s"(lds_dst) : "memory"); }
__device__ __forceinline__ void lc_dma4(const void* gsrc, unsigned lds_dst) { unsigned keep;
    asm volatile("s_mov_b32 %0, m0\n\ts_mov_b32 m0, %2\n\ts_nop 0\n\tglobal_load_lds_dword %1, off\n\ts_mov_b32 m0, %0" : "=&s"(keep) : "v"(gsrc), "s"(lds_dst) : "memory"); }
__device__ __forceinline__ void chunk_scan_lc(unsigned char* ldsb, const unsigned char* CK, float* Yout, int unit, int wv) {
    typedef volatile __attribute__((address_space(3))) unsigned vlds_u32;
    vlds_u32* flags = (vlds_u32*)(unsigned)(uintptr_t)(ldsb + LC_FLAGS);
    const unsigned ring = (unsigned)(uintptr_t)ldsb;
    const int lane = olane(), c = lane & 15, g = lane >> 4;
    const int bh = unit >> 2, it = unit & 3, b = bh >> 2, h = bh & 3;
    const unsigned char* ck0 = CK + (size_t)(bh * 128) * CK_BYTES;
    if (wv >= 1 && wv <= 3) {
#pragma unroll 1
        for (int ch = 0; ch < SEQ / 16; ++ch) {
            while ((int)flags[4] + LC_NS <= ch) __builtin_amdgcn_s_sleep(1);
            const unsigned char* ck = ck0 + (size_t)ch * CK_BYTES;
            const unsigned slot = (unsigned)__builtin_amdgcn_readfirstlane((int)(ring + (unsigned)(ch % LC_NS) * LC_SLOT));
            if (wv == 1) {
#pragma unroll
                for (int i = 0; i < 4; ++i) lc_dma16(ck + CK_M3 + i * 1024 + lane * 16, slot + i * 1024);
                lc_dma16(ck + CK_R2 + lane * 16, slot + LC_R2);
            } else if (wv == 2) {
#pragma unroll
                for (int i = 4; i < 8; ++i) lc_dma16(ck + CK_M3 + i * 1024 + lane * 16, slot + i * 1024);
                lc_dma16(ck + CK_R2 + 1024 + lane * 16, slot + LC_R2 + 1024);
            } else {
                lc_dma16(ck + CK_N2 + it * 2048 + lane * 16, slot + LC_N2); lc_dma16(ck + CK_N2 + it * 2048 + 1024 + lane * 16, slot + LC_N2 + 1024);
                lc_dma16(ck + CK_Y2 + it * 1024 + lane * 16, slot + LC_Y2);
                lc_dma4(ck + CK_G15 + lane * 4, slot + LC_G15);
                lc_dma4(ck + CK_G15 + lane * 4, slot + LC_G15);
            }
            asm volatile("s_waitcnt vmcnt(10)" ::: "memory");
            if (ch >= 2) flags[wv - 1] = (unsigned)(ch - 1);
        }
        asm volatile("s_waitcnt vmcnt(0)" ::: "memory");
        flags[wv - 1] = (unsigned)(SEQ / 16);
    } else if (wv == 0) {
        f32x4c hs[4];
#pragma unroll
        for (int jt = 0; jt < 4; ++jt) hs[jt] = (f32x4c){0.f, 0.f, 0.f, 0.f};
        float* yp = Yout + (size_t)(b * SEQ) * 256 + h * 64 + 16 * it + c;
#pragma unroll 1
        for (int ch = 0; ch < SEQ / 16; ++ch) {
            while ((int)flags[0] <= ch || (int)flags[1] <= ch || (int)flags[2] <= ch) __builtin_amdgcn_s_sleep(1);
            asm volatile("" ::: "memory");
            const unsigned char* sl = ldsb + (ch % LC_NS) * LC_SLOT;
            CkOps o;
#pragma unroll
            for (int ks = 0; ks < 2; ++ks) {
                o.ar[ks] = *(const bf16x8_t*)(sl + LC_R2 + (c * 64 + 32 * ks + 8 * g) * 2);
#pragma unroll
                for (int jt = 0; jt < 4; ++jt) o.am[jt][ks] = *(const bf16x8_t*)(sl + ((16 * jt + c) * 64 + 32 * ks + 8 * g) * 2);
            }
            o.y = *(const f32x4c*)(sl + LC_Y2 + lane * 16);
#pragma unroll
            for (int jt = 0; jt < 4; ++jt) { o.n2[jt] = *(const uint2*)(sl + LC_N2 + (jt * 64 + lane) * 8); o.g15[jt] = *(const f32x4c*)(sl + LC_G15 + (16 * jt + 4 * g) * 4); }
            asm volatile("s_waitcnt lgkmcnt(0)" ::: "memory");
            flags[4] = (unsigned)(ch + 1);
            ck_step(o, hs, yp, ch, g);
        }
    }
}

__device__ __forceinline__ float red16(float v) { v += dpp_f<0xB1>(v); v += dpp_f<0x4E>(v); v += dpp_f<0x141>(v); v += dpp_f<0x140>(v); return v; }
#define GAS __attribute__((address_space(1)))
#define WSO(off) ((char*)({ char* _w = args.ws; asm volatile("" : "+s"(_w)); (GAS char*)_w + (off); }))
#define IN(k) ((const float*)(const GAS float*)args.in[({ int _k = (k); asm volatile("" : "+s"(_k)); _k; })])
struct ExpW { const float *w1, *w3, *w2, *s1, *s3, *s2; bf16 *WTUP, *WTDN; };
constexpr int CONV_ITEMS = 65 * 384, CONV_E8A = 20, CONV_E8 = 32  , NCK_CONV = 22, CONV_SCAN = 128 * NCK_CONV * 4;
__device__ __forceinline__ ItemDesc expert_item(const ExpW& X, int it) {
    const int e = it / 384, r = it % 384, which = r >> 7, q = r & 127;
    ItemDesc d;
    if (which < 2) { d.W = which == 0 ? (e < 64 ? X.w1 + (size_t)e * D * DE : X.s1) : (e < 64 ? X.w3 + (size_t)e * D * DE : X.s3);
        const int kb = q >> 3, nb = q & 7, n0 = 32 * nb; d.N = DE; d.WT = X.WTUP + (size_t)e * 512 * D; d.K = D; d.k0 = 64 * kb; d.n0 = n0; d.drow0 = (n0 >> 7) * 256 + which * 128 + (n0 & 127); }
    else { d.W = e < 64 ? X.w2 + (size_t)e * DE * D : X.s2; const int kb = q >> 5, nb = q & 31; d.N = D; d.WT = X.WTDN + (size_t)e * D * DE; d.K = DE; d.k0 = 64 * kb; d.n0 = 32 * nb; d.drow0 = 32 * nb; }
    return d;
}
#define KAS __attribute__((address_space(4)))
__device__ __forceinline__ const float* karg_in(int k) { asm volatile("" : "+s"(k)); return (const float*)(const GAS float*)((const float* const KAS*)__builtin_amdgcn_kernarg_segment_ptr())[k]; }
__device__ __forceinline__ char* karg_ws(size_t off) { char* w = ((char* const KAS*)__builtin_amdgcn_kernarg_segment_ptr())[37]; asm volatile("" : "+s"(w)); return (char*)((GAS char*)w + off); }
static_assert(sizeof(Args) == 38 * 8, "Args layout");
__device__ __forceinline__ ItemDesc expert_item2(int l, int it) {
    const int e = it / 384, r = it % 384, which = r >> 7, q = r & 127;
    ItemDesc d;
    if (which < 2) { d.W = e < 64 ? karg_in(30 + which) + ((size_t)l * NE + e) * D * DE : karg_in(33 + which) + (size_t)l * D * DE;
        const int kb = q >> 3, nb = q & 7, n0 = 32 * nb; d.N = DE; d.WT = (bf16*)karg_ws(WS_WTUP) + (size_t)e * 512 * D; d.K = D; d.k0 = 64 * kb; d.n0 = n0; d.drow0 = (n0 >> 7) * 256 + which * 128 + (n0 & 127); }
    else { d.W = e < 64 ? karg_in(32) + ((size_t)l * NE + e) * DE * D : karg_in(35) + (size_t)l * DE * D; const int kb = q >> 5, nb = q & 31; d.N = D; d.WT = (bf16*)karg_ws(WS_WTDN) + (size_t)e * D * DE; d.K = DE; d.k0 = 64 * kb; d.n0 = 32 * nb; d.drow0 = 32 * nb; }
    return d;
}
template <bool UP>
__device__ __forceinline__ void convert_span(int l, int j0, int j1, int ci, int cnt, float* lds) {
    const int wv_ = owave(), ln_ = olane(), st_ = cnt * 8;
    float* scr = lds + wv_ * (64 * 32);
    float ca[32], cb[32];
#define CS_ITEM(j) (UP ? ((j) >> 8) * 384 + ((j) & 255) : ((j) >> 7) * 384 + 256 + ((j) & 127))
    const int it0 = j0 + ci * 8 + wv_;
    { const int jc = it0 < j1 ? it0 : j1 - 1; item_load(expert_item2(l, CS_ITEM(jc)), ca, ln_); }
#pragma unroll 1
    for (int it = it0; it < j1; it += 2 * st_) {
        const int i1 = it + st_, i2 = it + 2 * st_;
        { const int jc = i1 < j1 ? i1 : j1 - 1; item_load(expert_item2(l, CS_ITEM(jc)), cb, ln_); }
        item_finish(expert_item2(l, CS_ITEM(it)), ca, scr, ln_);
        { const int jc = i2 < j1 ? i2 : j1 - 1; item_load(expert_item2(l, CS_ITEM(jc)), ca, ln_); }
        if (i1 < j1) item_finish(expert_item2(l, CS_ITEM(i1)), cb, scr, ln_);
    }
#undef CS_ITEM
}
__device__ __forceinline__ void convert_item(const ExpW& X, int it, float* scr, int lane) {
    const int e = it / 384, r = it % 384, which = r >> 7, q = r & 127;
    if (which < 2) {
        const float* W = which == 0 ? (e < 64 ? X.w1 + (size_t)e * D * DE : X.s1) : (e < 64 ? X.w3 + (size_t)e * D * DE : X.s3);
        const int kb = q >> 3, nb = q & 7, n0 = 32 * nb;
        transpose_item(W, D, DE, X.WTUP + (size_t)e * 512 * D, 64 * kb, n0, (n0 >> 7) * 256 + which * 128 + (n0 & 127), scr, lane);
    } else {
        const float* W = e < 64 ? X.w2 + (size_t)e * DE * D : X.s2;
        const int kb = q >> 5, nb = q & 31;
        transpose_item(W, DE, D, X.WTDN + (size_t)e * D * DE, 64 * kb, 32 * nb, 32 * nb, scr, lane);
    }
}
typedef float f32x2_t __attribute__((ext_vector_type(2)));
__device__ __forceinline__ void rwkv_scan_phase(unsigned char* ldsb, float* RW, int bidx, int gdim, const ExpW& X) {
    const int tidx = otid();
    const int wave = tidx >> 6, lane = tidx & 63, c = lane >> 4, s = lane & 15;
    constexpr int CH = 32, ARRB = CH * 256, BUFB = 6 * ARRB, YOFF = 2 * BUFB;
    const int sstep = tidx >> 4, sq = tidx & 15;
#pragma unroll 1
    for (int u = bidx; u < BATCH * 4 * 4; u += gdim) {
        const int b = u >> 4, h = (u >> 2) & 3, q4 = u & 3, lrow = (wave & 3) * 4 + c, row = q4 * 16 + lrow;
        float* Yg = RW + (size_t)T * 256 * 7 + (size_t)(b * SEQ + sstep) * 256 + h * 64 + q4 * 16 + sq;
        const float* g0 = RW + (size_t)(b * SEQ + sstep) * 256 + h * 64 + sq * 4;
        constexpr size_t AS = (size_t)T * 256;
#define SCAN_LOAD(ckk) do { const float* g_ = g0 + (size_t)(ckk) * CH * 256; pf0 = *(const float4*)(g_ + 4 * AS); pf1 = *(const float4*)(g_ + 5 * AS); pf2 = *(const float4*)(g_ + 1 * AS); \
        pf3 = *(const float4*)(g_ + 2 * AS); pf4 = *(const float4*)(g_); pf5 = *(const float4*)(g_ + 3 * AS); } while (0)
#define SCAN_STORE(bufp) do { unsigned char* d_ = (bufp) + sstep * 256 + sq * 16; *(float4*)(d_) = pf0; *(float4*)(d_ + ARRB) = pf1; *(float4*)(d_ + 2 * ARRB) = pf2; \
        *(float4*)(d_ + 3 * ARRB) = pf3; *(float4*)(d_ + 4 * ARRB) = pf4; *(float4*)(d_ + 5 * ARRB) = pf5; } while (0)
#define SCAN_LOAD_TO(ckk, A0, A1, A2, A3, A4, A5) do { const float* g_ = g0 + (size_t)(ckk) * CH * 256; A0 = *(const float4*)(g_ + 4 * AS); A1 = *(const float4*)(g_ + 5 * AS); A2 = *(const float4*)(g_ + 1 * AS); \
        A3 = *(const float4*)(g_ + 2 * AS); A4 = *(const float4*)(g_); A5 = *(const float4*)(g_ + 3 * AS); } while (0)
#define SCAN_STORE_FROM(bufp, A0, A1, A2, A3, A4, A5) do { unsigned char* d_ = (bufp) + sstep * 256 + sq * 16; *(float4*)(d_) = A0; *(float4*)(d_ + ARRB) = A1; *(float4*)(d_ + 2 * ARRB) = A2; \
        *(float4*)(d_ + 3 * ARRB) = A3; *(float4*)(d_ + 4 * ARRB) = A4; *(float4*)(d_ + 5 * ARRB) = A5; } while (0)
        float4 pf0, pf1, pf2, pf3, pf4, pf5, pg0, pg1, pg2, pg3, pg4, pg5;
        SCAN_LOAD(0);
        SCAN_LOAD_TO(1, pg0, pg1, pg2, pg3, pg4, pg5);
        __syncthreads();
        SCAN_STORE(ldsb);
        __syncthreads();
        f32x2_t s01 = {0.f, 0.f}, s23 = {0.f, 0.f};
        float cv[32]; int pit = -1;
#define SCAN_CHUNK(CKE, LA, LB, LC, LD, LE, LF, SA, SB, SC, SD, SE, SF) do { const int ck = (CKE); \
            const unsigned char* buf = ldsb + (ck & 1) * BUFB; \
            unsigned char* nbuf = ldsb + ((ck + 1) & 1) * BUFB; \
            float* yb = (float*)(ldsb + YOFF + (ck & 1) * (CH * 16 * 4)); \
            const bool more = ck + 1 < SEQ / CH; \
            if (wave >= 4) { \
                float* scr = (float*)(ldsb + YOFF + 2 * CH * 16 * 4) + (wave - 4) * (64 * 36); \
                if (pit >= 0) item_finish(expert_item(X, pit), cv, scr, lane); \
                pit = -1; \
                if (ck < NCK_CONV) { pit = (u * NCK_CONV + ck) * 4 + (wave - 4); item_load(expert_item(X, pit), cv, lane); } \
            } \
            if (ck + 2 < SEQ / CH) SCAN_LOAD_TO(ck + 2, LA, LB, LC, LD, LE, LF); \
            if (wave < 4) { \
_Pragma("unroll 1") \
                for (int t8 = 0; t8 < CH; t8 += 8) { \
                    float yv[8]; \
_Pragma("unroll") \
                    for (int j = 0; j < 8; ++j) { \
                        const unsigned char* bp = buf + (t8 + j) * 256 + s * 16; \
                        const f32x2_t a01 = *(const f32x2_t*)(bp), a23 = *(const f32x2_t*)(bp + 8); \
                        const f32x2_t b01 = *(const f32x2_t*)(bp + ARRB), b23 = *(const f32x2_t*)(bp + ARRB + 8); \
                        const f32x2_t w01 = *(const f32x2_t*)(bp + 2 * ARRB), w23 = *(const f32x2_t*)(bp + 2 * ARRB + 8); \
                        const f32x2_t k01 = *(const f32x2_t*)(bp + 3 * ARRB), k23 = *(const f32x2_t*)(bp + 3 * ARRB + 8); \
                        const f32x2_t r01 = *(const f32x2_t*)(bp + 4 * ARRB), r23 = *(const f32x2_t*)(bp + 4 * ARRB + 8); \
                        const float v = *(const float*)(buf + 5 * ARRB + (t8 + j) * 256 + row * 4); \
                        f32x2_t d = s01 * a01 + s23 * a23; \
                        const float sa = red16(d.x + d.y); \
                        const f32x2_t vv = {v, v}, sv = {sa, sa}; \
                        s01 = (s01 * w01 + vv * k01) + sv * b01; s23 = (s23 * w23 + vv * k23) + sv * b23; \
                        d = s01 * r01 + s23 * r23; \
                        yv[j] = red16(d.x + d.y); \
                    } \
_Pragma("unroll") \
                    for (int j = 0; j < 8; ++j) yb[(t8 + j) * 16 + lrow] = yv[j]; \
                } \
            } \
            if (more) SCAN_STORE_FROM(nbuf, SA, SB, SC, SD, SE, SF); \
            __syncthreads(); \
            Yg[(size_t)ck * CH * 256] = yb[sstep * 16 + sq]; \
        } while (0)
#pragma unroll 1
        for (int ck2 = 0; ck2 < SEQ / CH; ck2 += 2) {
            SCAN_CHUNK(ck2, pf0, pf1, pf2, pf3, pf4, pf5, pg0, pg1, pg2, pg3, pg4, pg5);
            SCAN_CHUNK(ck2 + 1, pg0, pg1, pg2, pg3, pg4, pg5, pf0, pf1, pf2, pf3, pf4, pf5);
        }
#undef SCAN_CHUNK
#undef SCAN_LOAD_TO
#undef SCAN_STORE_FROM
        if (wave >= 4 && pit >= 0) item_finish(expert_item(X, pit), cv, (float*)(ldsb + YOFF + 2 * CH * 16 * 4) + (wave - 4) * (64 * 36), lane);
    }
#undef SCAN_LOAD
#undef SCAN_STORE
}
__device__ __forceinline__ void rwkv_post_phase(const float* RW, const float* r_k, const float* lnx_g, const float* lnx_b, bf16* mix) {
    const int tidx = otid(), bidx = obid(), gdim = ogdim();
    const int lane = tidx & 63, wave = tidx >> 6, stride = gdim * 8;
    constexpr size_t AS = (size_t)T * 256;
    const float4 rk4 = ((const float4*)r_k)[lane], lg4 = ((const float4*)lnx_g)[lane], lb4 = ((const float4*)lnx_b)[lane];
#pragma unroll 1
    for (int t0 = bidx * 8 + wave; t0 < T; t0 += 4 * stride) {
        float4 yv[4], rv[4], kv[4], vv[4], gv[4];
#pragma unroll
        for (int i = 0; i < 4; ++i) {
            const int t = t0 + i * stride < T ? t0 + i * stride : t0;
            const float4* p = (const float4*)(RW + (size_t)t * 256) + lane;
            yv[i] = p[7 * AS / 4]; rv[i] = p[0]; kv[i] = p[2 * AS / 4]; vv[i] = p[3 * AS / 4]; gv[i] = p[6 * AS / 4];
        }
#pragma unroll
        for (int i = 0; i < 4; ++i) {
            const int t = t0 + i * stride;
            const float mean = red16((yv[i].x + yv[i].y) + (yv[i].z + yv[i].w)) * (1.f / 64.f);
            const float4 d = make_float4(yv[i].x - mean, yv[i].y - mean, yv[i].z - mean, yv[i].w - mean);
            const float rstd = rsqrtf(red16(sq4(d)) * (1.f / 64.f) + 64e-5f);
            const float bonus = red16((rv[i].x * kv[i].x * rk4.x + rv[i].y * kv[i].y * rk4.y) + (rv[i].z * kv[i].z * rk4.z + rv[i].w * kv[i].w * rk4.w));
            const float o0 = (d.x * rstd * lg4.x + lb4.x + bonus * vv[i].x) * gv[i].x, o1 = (d.y * rstd * lg4.y + lb4.y + bonus * vv[i].y) * gv[i].y;
            const float o2 = (d.z * rstd * lg4.z + lb4.z + bonus * vv[i].z) * gv[i].z, o3 = (d.w * rstd * lg4.w + lb4.w + bonus * vv[i].w) * gv[i].w;
            if (t < T) ((uint2*)(mix + (size_t)t * D + A_WIDTH))[lane] = make_uint2(pk2(o0, o1), pk2(o2, o3));
        }
    }
}
__device__ __forceinline__ int med3i(int a, int b, int c) { int r; asm("v_med3_i32 %0, %1, %2, %3" : "=v"(r) : "v"(a), "v"(b), "v"(c)); return r; }
constexpr int RT_LD = 68;
__device__ __forceinline__ void route_topk_tok(const float* lrow, const float* lbias, int* top_idx, float* top_w, unsigned* hist, int t) {
    float gs[8];
#pragma unroll
    for (int i = 0; i < 8; ++i) gs[i] = 0.f;
#pragma unroll 1
    for (int g = 0; g < 8; ++g) {
        const float4 a = *(const float4*)(lrow + 8 * g), b = *(const float4*)(lrow + 8 * g + 4), ea = *(const float4*)(lbias + 8 * g), eb = *(const float4*)(lbias + 8 * g + 4);
        const float vv[8] = {a.x, a.y, a.z, a.w, b.x, b.y, b.z, b.w}, ee[8] = {ea.x, ea.y, ea.z, ea.w, eb.x, eb.y, eb.z, eb.w};
        float m1 = -INFINITY, m2 = -INFINITY;
#pragma unroll
        for (int j = 0; j < 8; ++j) { const float v = __builtin_amdgcn_rcpf(1.f + __expf(-vv[j])) + ee[j]; m2 = fmaxf(m2, fminf(m1, v)); m1 = fmaxf(m1, v); }
#pragma unroll
        for (int i = 7; i > 0; --i) gs[i] = gs[i - 1];
        gs[0] = m1 + m2;
    }
    unsigned keepmask = 0u;
#pragma unroll
    for (int g = 0; g < 8; ++g) { int rk = 0;
#pragma unroll
        for (int g2 = 0; g2 < 8; ++g2) if (g2 != g) rk += (gs[7 - g2] > gs[7 - g] || (gs[7 - g2] == gs[7 - g] && g2 < g)) ? 1 : 0;
        keepmask |= rk < 4 ? (1u << g) : 0u; }
    int L[8];
#pragma unroll
    for (int i = 0; i < 8; ++i) L[i] = (int)0x80000000;
#pragma unroll 1
    for (int g = 0; g < 8; ++g) {
        const float4 a = *(const float4*)(lrow + 8 * g), b = *(const float4*)(lrow + 8 * g + 4), ea = *(const float4*)(lbias + 8 * g), eb = *(const float4*)(lbias + 8 * g + 4);
        const float vv[8] = {a.x, a.y, a.z, a.w, b.x, b.y, b.z, b.w}, ee[8] = {ea.x, ea.y, ea.z, ea.w, eb.x, eb.y, eb.z, eb.w};
        const bool keep = (keepmask >> g) & 1u;
#pragma unroll
        for (int j = 0; j < 8; ++j) { const float v = __builtin_amdgcn_rcpf(1.f + __expf(-vv[j])) + ee[j]; const int bb = __float_as_int(v);
            int k = bb ^ ((bb >> 31) & 0x7fffffff); k = (k & ~63) | (63 - 8 * g - j); k = keep ? k : (int)0x80000000;
            int n[8]; n[0] = max(L[0], k);
#pragma unroll
            for (int i = 1; i < 8; ++i) n[i] = med3i(L[i - 1], L[i], k);
#pragma unroll
            for (int i = 0; i < 8; ++i) L[i] = n[i]; }
    }
    int bi[8]; float sw[8]; float ssum = 0.f;
#pragma unroll
    for (int r = 0; r < 8; ++r) { bi[r] = 63 - (L[r] & 63); sw[r] = sigmoidf_(lrow[bi[r]]); ssum += sw[r]; }
    const float inv = 2.5f / (ssum + 1e-20f);
    *(int4*)(top_idx + t * TOPK) = make_int4(bi[0], bi[1], bi[2], bi[3]); *(int4*)(top_idx + t * TOPK + 4) = make_int4(bi[4], bi[5], bi[6], bi[7]);
    *(float4*)(top_w + t * TOPK) = make_float4(sw[0] * inv, sw[1] * inv, sw[2] * inv, sw[3] * inv); *(float4*)(top_w + t * TOPK + 4) = make_float4(sw[4] * inv, sw[5] * inv, sw[6] * inv, sw[7] * inv);
#pragma unroll
    for (int r = 0; r < 8; ++r) atomicAdd(&hist[bi[r]], 1u);
}

typedef float f32x2c __attribute__((ext_vector_type(2)));
__device__ __forceinline__ void acc16(float (&y)[16], const uint4& v, float w) {
    const unsigned u[4] = {v.x, v.y, v.z, v.w};
#pragma unroll
    for (int i = 0; i < 4; ++i) {
        const f32x2c lo = __builtin_amdgcn_cvt_pk_f32_fp8((int)u[i], false), hi = __builtin_amdgcn_cvt_pk_f32_fp8((int)u[i], true);
        y[4 * i] += w * lo.x; y[4 * i + 1] += w * lo.y; y[4 * i + 2] += w * hi.x; y[4 * i + 3] += w * hi.y;
    }
}
template <bool NEXT>
__device__ __forceinline__ void combine_phase(const unsigned char* YB, const unsigned char* YS, const int* posi, const float* topw, const float* gy, const float* gate_base, float* x,
                                              const float* gn, const float* modn, bf16* hb) {
    const int tidx = otid(), bidx = obid(), gdim = ogdim();
    const int lane = tidx & 63, wave = tidx >> 6, stride = gdim * 8;
#pragma unroll 1
    for (int row0 = bidx * 8 + wave; row0 < T; row0 += 2 * stride) {
#pragma unroll
        for (int r = 0; r < 2; ++r) {
            const int row = row0 + r * stride;
            if (row < T) {
                const int b = row / SEQ;
                const int4 p0 = *(const int4*)(posi + row * TOPK), p1 = *(const int4*)(posi + row * TOPK + 4);
                const float4 w0 = *(const float4*)(topw + row * TOPK), w1 = *(const float4*)(topw + row * TOPK + 4);
                const int pp[8] = {p0.x, p0.y, p0.z, p0.w, p1.x, p1.y, p1.z, p1.w};
                const float ww[8] = {w0.x, w0.y, w0.z, w0.w, w1.x, w1.y, w1.z, w1.w};
                float y[16];
#pragma unroll
                for (int i = 0; i < 16; ++i) y[i] = 0.f;
                acc16(y, nt_load16((const uint4*)(YS + (size_t)row * D) + lane), 1.f / 16.f);
#pragma unroll
                for (int k = 0; k < TOPK; ++k) acc16(y, nt_load16((const uint4*)(YB + (size_t)pp[k] * D) + lane), ww[k] * (1.f / 16.f));
                float ss = 0.f;
#pragma unroll
                for (int i = 0; i < 16; ++i) ss += y[i] * y[i];
                const float rs = rsqrtf(wave_sum_fast(ss) * (1.f / D) + 1e-6f);
                float xn[16]; float s2 = 0.f;
#pragma unroll
                for (int q = 0; q < 4; ++q) {
                    const int c4 = 4 * lane + q;
                    const float4 gg = ((const float4*)gy)[c4], gt = ((const float4*)(gate_base + (size_t)b * 6 * D))[c4];
                    float4 v = ((const float4*)(x + (size_t)row * D))[c4];
                    v.x += gt.x * y[4 * q] * rs * gg.x; v.y += gt.y * y[4 * q + 1] * rs * gg.y; v.z += gt.z * y[4 * q + 2] * rs * gg.z; v.w += gt.w * y[4 * q + 3] * rs * gg.w;
                    ((float4*)(x + (size_t)row * D))[c4] = v;
                    xn[4 * q] = v.x; xn[4 * q + 1] = v.y; xn[4 * q + 2] = v.z; xn[4 * q + 3] = v.w;
                    s2 += sq4(v);
                }
                if (NEXT) {
                    const float r2 = rsqrtf(wave_sum_fast(s2) * (1.f / D) + 1e-6f);
                    const float* m = modn + (size_t)b * 6 * D;
                    float o[16];
#pragma unroll
                    for (int q = 0; q < 4; ++q) {
                        const int c4 = 4 * lane + q;
                        const float4 gg = ((const float4*)gn)[c4], sc = ((const float4*)(m + D))[c4], sh = ((const float4*)m)[c4];
                        o[4 * q] = xn[4 * q] * r2 * gg.x * (1.f + sc.x) + sh.x; o[4 * q + 1] = xn[4 * q + 1] * r2 * gg.y * (1.f + sc.y) + sh.y;
                        o[4 * q + 2] = xn[4 * q + 2] * r2 * gg.z * (1.f + sc.z) + sh.z; o[4 * q + 3] = xn[4 * q + 3] * r2 * gg.w * (1.f + sc.w) + sh.w;
                    }
                    ((uint4*)(hb + (size_t)row * D))[2 * lane] = make_uint4(pk2(o[0], o[1]), pk2(o[2], o[3]), pk2(o[4], o[5]), pk2(o[6], o[7]));
                    ((uint4*)(hb + (size_t)row * D))[2 * lane + 1] = make_uint4(pk2(o[8], o[9]), pk2(o[10], o[11]), pk2(o[12], o[13]), pk2(o[14], o[15]));
                }
            }
        }
    }
}
__device__ __forceinline__ void build_ps(int* ps, const unsigned* counts) {
    const int tidx = otid(), bidx = obid(), gdim = ogdim();
    __syncthreads();
    if (tidx == 0) {
        int acc = 0;
#pragma unroll 1
        for (int e = 0; e < NE; ++e) { ps[e] = acc; acc += ((int)__hip_atomic_load(&counts[e], __ATOMIC_RELAXED, __HIP_MEMORY_SCOPE_AGENT) + EBLK - 1) / EBLK * EBLK; }
        ps[NE] = acc;
    }
    __syncthreads();
}

__global__ void __launch_bounds__(NT) mk_fwd(Args args) {
    float* lds = (float*)lds_raw;
    if ((threadIdx.x & 63) == 0) *(volatile LAS int*)((LAS unsigned char*)lds_raw + WIDTAB_OFF + 4 * ((unsigned)__builtin_amdgcn_s_getreg(63492) & 63u)) = (int)(threadIdx.x >> 6);
    volatile LAS unsigned* misc = (volatile LAS unsigned*)((LAS unsigned char*)lds_raw + LDS_BYTES - 256);
    int* ps = (int*)(lds_raw + LDS_BYTES - 2048);
    if (threadIdx.x < 64) misc[threadIdx.x] = 0u;
    __syncthreads();
#define XBAR() xcd_barrier(bar)
    if (threadIdx.x < 512) { const int h_ = threadIdx.x >> 7, d_ = threadIdx.x & 127; const float* tb_ = args.in[10];
        ((float*)(lds_raw + BT_OFF))[threadIdx.x] = (tb_[t5_bucket(d_) * A_HEADS + h_] - tb_[31 * A_HEADS + h_]) * 1.4426950408889634f; }
    __syncthreads();
    unsigned* ctl = (unsigned*)(args.ws + WS_CTL);
    XcdBarrier bar = xcd_barrier_post(ctl + CW_BAR, misc);
#define CNT ((unsigned*)WSO(WS_CTL) + CW_CNT)
#define CUR ((unsigned*)WSO(WS_CTL) + CW_CUR)
#define MOD ((float*)WSO(WS_MOD))
#define TOPI ((int*)WSO(WS_TOPI))
#define TOPW ((float*)WSO(WS_TOPW))
#define ROWT ((int*)WSO(WS_ROWT))
#define DST ((int*)WSO(WS_DST))
#define RW ((float*)WSO(WS_RW))
#define Y ((float*)WSO(WS_PROJ))
#define CHK ((unsigned char*)WSO(WS_CHK))
#define GU ((float*)WSO(WS_GU))
#define GVN ((float*)WSO(WS_GU) + (size_t)T * 256)
#define HBF ((bf16*)WSO(WS_HBF))
#define WTIN ((bf16*)WSO(WS_WTIN))
#define WTR ((bf16*)WSO(WS_WTR))
#define SMALLW(l_) ((bf16*)WSO(WS_SMALL) + (size_t)(l_) * 131072)
#define LOGIT ((float*)WSO(WS_LOGIT))
#define PROJB ((bf16*)WSO(WS_PROJ))
#define WTOUT ((bf16*)WSO(WS_WTOUT))
#define MIXB ((bf16*)WSO(WS_MIXB))
#define WTUP ((bf16*)WSO(WS_WTUP))
#define WTDN ((bf16*)WSO(WS_WTDN))
#define HBB ((bf16*)WSO(WS_HBB))
#define YB ((bf16*)WSO(WS_YB))
#define YS8 ((unsigned char*)WSO(WS_YS))
#define out ((float*)(GAS float*)args.out)
#define gsz (ogdim() * NT)
#define GTID (obid() * NT + otid())

#pragma unroll 1
    for (int idx = GTID; idx < DEPTH * BATCH * 6 * D; idx += gsz) {
        const int n = idx % (6 * D), b = (idx / (6 * D)) % BATCH, l = idx / (6 * D * BATCH);
        float acc = IN(3)[l * 6 * D + n];
        const float* w = IN(2) + (size_t)l * D * 6 * D + n;
        const float* cr = IN(1) + b * D;
        for (int k = 0; k < D; ++k) acc += siluf_(cr[k]) * w[(size_t)k * 6 * D];
        MOD[idx] = acc;
    }
    {
    for (int l = 0; l < DEPTH; ++l) {
        transpose_matrix(IN(8) + (size_t)l * D * IN_COLS, D, IN_COLS, WTIN + (size_t)l * IN_COLS * D, lds);
        transpose_matrix(IN(9) + (size_t)l * D * D, D, D, WTOUT + (size_t)l * D * D, lds);
        transpose_matrix(IN(28) + (size_t)l * D * NE, D, NE, WTR + (size_t)l * 256 * D, lds);
        transpose_matrix(IN(15) + (size_t)l * 64 * 256, 64, 256, SMALLW(l), lds);
        transpose_matrix(IN(17) + (size_t)l * 64 * 256, 64, 256, SMALLW(l) + 16384, lds);
        transpose_matrix(IN(18) + (size_t)l * 128 * 256, 128, 256, SMALLW(l) + 32768, lds);
#pragma unroll 1
        for (int i = GTID; i < 4 * CHUNK * CHUNK; i += gsz) { const int s_ = i & 127, t_ = (i >> 7) & 127; (SMALLW(l) + 65536)[i] = (bf16)(s_ <= t_ ? f2bf((IN(26) + (size_t)l * 4 * CHUNK * CHUNK)[i]) : 0u); }
#pragma unroll 1
        for (int i = GTID; i < 192 * D / 8; i += gsz) ((uint4*)(WTR + (size_t)l * 256 * D + 64 * D))[i] = make_uint4(0u, 0u, 0u, 0u);
    }
    }
    XBAR();

#define xin (l == 0 ? IN(0) : (const float*)out)
#pragma unroll 1
    for (int l_ = 0; l_ < DEPTH; ++l_) {
        int l = l_; asm volatile("" : "+s"(l));
#define mod_l (MOD + (size_t)l * BATCH * 6 * D)
        const float lambda_init = l == 0 ? 0.2f : 0.8f - 0.6f * 0.7408182206817179f;
        if (l == 0) { row_phase<false, true>(xin, nullptr, nullptr, nullptr, nullptr, IN(4) + l * D, mod_l, 0, 1, HBF);
        XBAR(); }
        {
            pg8::Gemm g{HBF, WTIN + (size_t)l * IN_COLS * D, T, IN_COLS, D}; pg8::StaticOrder S; S.init(T, IN_COLS, ogdim(), obid());
            pg8::EpiBf16<0> E{PROJB, IN_COLS, nullptr, 0, 0, 1.f};
            pg8::gemm_phase<pg8::EpiBf16<0>, pg8::StaticOrder, true>((LAS unsigned char*)lds_raw, g, S, E);
        }
        XBAR();
        rwkv_prep_phase(lds_raw, PROJB, IN(13) + l * B_COLS, IN(14) + l * 256, SMALLW(l), IN(16) + l * 256, SMALLW(l) + 16384, SMALLW(l) + 32768, IN(19) + l * 256, IN(20) + l * 256, RW);
        XBAR();
        chunk_prep(lds_raw, RW, CHK);
        XBAR();
        {
            const int G_ = ogdim(), b_ = obid();
            if (b_ < 128) {
                const int wv_ = owave();
                if (otid() < 8) ((volatile LAS unsigned*)((LAS unsigned char*)lds_raw + LC_FLAGS))[otid()] = 0u;
                __syncthreads();
                if (wv_ < 4) chunk_scan_lc(lds_raw, CHK, RW + (size_t)T * 256 * 7, b_, wv_);
            }
            __syncthreads();
            attn_flash(lds_raw, PROJB, IN(11) + l * 256, IN(12) + l * 128, lambda_init, MIXB, b_, G_);
            __syncthreads();
            gmlp_phase(lds_raw, PROJB, IN(24) + l * 256, IN(25) + l * 256, SMALLW(l) + 65536, IN(27) + l * 4 * CHUNK, MIXB, b_ >= G_ / 2 ? b_ - G_ / 2 : b_ + G_ / 2, G_);
            __syncthreads();
            if (b_ >= G_ / 2) {
                convert_span<true>(l, CONV_E8 * 256, 65 * 256, b_ - G_ / 2, G_ - G_ / 2, lds);
            }
        }
        XBAR();
        rwkv_post_phase(RW, IN(21) + l * 256, IN(22) + l * 256, IN(23) + l * 256, MIXB);
        XBAR();
        {
            pg8::Gemm g{MIXB, WTOUT + (size_t)l * D * D, T, D, D}; pg8::StaticOrder S; S.init(T, D, ogdim(), obid());
            pg8::EpiBf16<0> E{(bf16*)Y, D, nullptr, 0, 0, 1.f};
            pg8::gemm_phase<pg8::EpiBf16<0>, pg8::StaticOrder, false>((LAS unsigned char*)lds_raw, g, S, E);
        }
        XBAR();
        row_phase<true, true>(xin, (const bf16*)Y, IN(5) + l * D, mod_l + 2 * D, out, IN(6) + l * D, mod_l, 3, 4, HBF);
#pragma unroll 1
        for (int i = GTID; i < P; i += gsz) ROWT[i] = 0;
        { const int t_ = otid(); if (obid() == 0 && t_ < NE) { CNT[t_] = 0u; CUR[t_] = 0u; } }
        XBAR();
        {
            pg8::Gemm g{HBF, WTR + (size_t)l * 256 * D, T, 256, D}; pg8::StaticOrder S; S.init(T, 256, ogdim(), obid());
            pg8::EpiF32 E{LOGIT, 256};
            pg8::gemm_phase<pg8::EpiF32, pg8::StaticOrder, false>((LAS unsigned char*)lds_raw, g, S, E);
            pg8::Unit u_;
            if (S.next(0, u_)) {
                __builtin_amdgcn_fence(__ATOMIC_RELEASE, "workgroup"); __syncthreads();
                float* ls = (float*)lds_raw; unsigned* hist = (unsigned*)(ls + 256 * RT_LD + 64); const int t_ = otid();
                if (t_ < NE) { hist[t_] = 0u; ls[256 * RT_LD + t_] = (IN(29) + l * NE)[t_]; }
                { const float* src = LOGIT + (size_t)u_.pm * 256 * 256;
#pragma unroll
                  for (int i = 0; i < 8; ++i) { const int idx = i * NT + t_, r = idx >> 4, c4 = idx & 15; *(float4*)(ls + r * RT_LD + 4 * c4) = *(const float4*)(src + (size_t)r * 256 + 4 * c4); } }
                __syncthreads();
                if (t_ < 256) route_topk_tok(ls + t_ * RT_LD, ls + 256 * RT_LD, TOPI, TOPW, hist, u_.pm * 256 + t_);
                __syncthreads();
                if (t_ < NE && hist[t_]) atomicAdd(&CNT[t_], hist[t_]);
                __syncthreads();
            }
        }
        {
            const int G_ = ogdim(); int c_ = obid() - 64; if (c_ < 0) c_ += G_;
            pg8::Gemm g{HBF, WTUP + (size_t)64 * 512 * D, T, 512, D}; pg8::StaticOrder S; S.init(T, 512, G_, c_);
            pg8::EpiSwiGLU E{HBB + (size_t)P * 256};
            pg8::gemm_phase<pg8::EpiSwiGLU, pg8::StaticOrder, false>((LAS unsigned char*)lds_raw, g, S, E);
            if (c_ < 192) {
                __syncthreads();
                if (c_ >= 128) convert_span<true>(l, 0, CONV_E8A * 256, c_ - 128, 64, lds);
                else convert_span<true>(l, CONV_E8A * 256, CONV_E8 * 256, c_, 128, lds);
            }
        }
        XBAR();
        build_ps(ps, CNT);
        {
            unsigned* lc = (unsigned*)lds_raw; unsigned* lb = lc + 64; unsigned* lc2 = lc + 128;
            const int t_ = otid();
            if (t_ < NE) { lc[t_] = 0u; lc2[t_] = 0u; }
            __syncthreads();
#pragma unroll 1
            for (int i = GTID; i < T * TOPK; i += gsz) atomicAdd(&lc[TOPI[i]], 1u);
            __syncthreads();
            if (t_ < NE) lb[t_] = lc[t_] ? atomicAdd(&CUR[t_], lc[t_]) : 0u;
            __syncthreads();
#pragma unroll 1
            for (int i = GTID; i < T * TOPK; i += gsz) {
                const int e = TOPI[i];
                const int pos = ps[e] + (int)(lb[e] + atomicAdd(&lc2[e], 1u));
                ROWT[pos] = i / TOPK; DST[i] = pos;
            }
        }
        XBAR();
        {
            pg8::Gemm g{HBF, WTUP, 0, 512, D}; pg8::GroupedOrder S; S.init(ps, 2, ogdim(), obid(), ROWT, (size_t)512 * D * 2, NBLK, 0);
            pg8::EpiSwiGLU E{HBB};
            pg8::gemm_phase<pg8::EpiSwiGLU, pg8::GroupedOrder, true>((LAS unsigned char*)lds_raw, g, S, E);
            {
                const int G_ = ogdim(), c_ = obid(), rem_ = S.nwg % G_, nidle_ = rem_ ? G_ - rem_ : 0;
                __syncthreads();
                if (nidle_ >= 64) { if (c_ >= rem_) convert_span<false>(l, 0, 65 * 128, c_ - rem_, nidle_, lds); }
                else convert_span<false>(l, 0, 65 * 128, c_, G_, lds);
            }
        }
        XBAR();
        {
            pg8::Gemm g{HBB, WTDN, 0, D, DE}; pg8::GroupedOrder S; S.init(ps, 4, ogdim(), obid(), nullptr, (size_t)D * DE * 2, NBLK, T / 256);
            pg8::EpiRows E{(unsigned char*)YB, YS8, NBLK};
            pg8::gemm_phase<pg8::EpiRows, pg8::GroupedOrder, true>((LAS unsigned char*)lds_raw, g, S, E);
        }
        XBAR();
        if (l + 1 < DEPTH) combine_phase<true>((const unsigned char*)YB, YS8, DST, TOPW, IN(7) + l * D, mod_l + 5 * D, out, IN(4) + (l + 1) * D, MOD + (size_t)(l + 1) * BATCH * 6 * D, HBF);
        else combine_phase<false>((const unsigned char*)YB, YS8, DST, TOPW, IN(7) + l * D, mod_l + 5 * D, out, nullptr, nullptr, nullptr);
        XBAR();
    }
}
#undef out
}

extern "C" void kernel_launch(void* const* d_in, const int* in_sizes, int n_in, void* d_out, int out_size, void* d_ws, size_t ws_size, hipStream_t stream) {
    static int grid = 0;
    if (grid == 0) {
        if (n_in != 36 || ws_size < WS_END) { fprintf(stderr, "kernel_launch: need 36 inputs and %zu bytes of workspace; got %d, %zu\n", (size_t)WS_END, n_in, ws_size); grid = -1; return; }
        int dev = 0, cus = 0, per_cu = 0;
        if (hipGetDevice(&dev) != hipSuccess || hipDeviceGetAttribute(&cus, hipDeviceAttributeMultiprocessorCount, dev) != hipSuccess) { grid = -1; return; }
        if (hipFuncSetAttribute((const void*)mk_fwd, hipFuncAttributeMaxDynamicSharedMemorySize, LDS_BYTES) != hipSuccess) { fprintf(stderr, "kernel_launch: hipFuncSetAttribute failed\n"); grid = -1; return; }
        if (hipOccupancyMaxActiveBlocksPerMultiprocessor(&per_cu, (const void*)mk_fwd, NT, LDS_BYTES) != hipSuccess || per_cu < 1) { fprintf(stderr, "kernel_launch: occupancy query says %d\n", per_cu); per_cu = 1; }
        (void)hipGetLastError();
        grid = cus;
        fprintf(stderr, "kernel_launch: grid %d (occupancy query %d per CU)\n", grid, per_cu);
    }
    if (grid < 0) return;
    (void)hipMemsetAsync((char*)d_ws + WS_CTL, 0, CTL_BYTES, stream);
    Args a{};
    for (int i = 0; i < 36; ++i) a.in[i] = (const float*)d_in[i];
    a.out = (float*)d_out; a.ws = (char*)d_ws;
    hipLaunchKernelGGL(mk_fwd, dim3(grid), dim3(NT), LDS_BYTES, stream, a);
}
```

```cpp
#include <hip/hip_runtime.h>
#include <cstdio>
#include <cstdint>
#include <cmath>

namespace {
constexpr int D = 1024, BATCH = 8, SEQ = 2048, T = BATCH * SEQ, DEPTH = 2;
constexpr int A_HEADS = 4, A_WIDTH = 512;
constexpr int B_WIDTH = 256, B_COLS = 1024, CHUNK = 128;
constexpr int A_COLS = 1536, IN_COLS = 3072;
constexpr int NE = 64, TOPK = 8, DE = 256;
constexpr int EBLK = 256;
constexpr int NBLK = T * TOPK / EBLK + NE;
constexpr int P = NBLK * EBLK;
constexpr int NT = 512;
constexpr int LDS_BYTES = 147456;

#define LAS __attribute__((address_space(3)))

__device__ __forceinline__ int olane() { int l; asm volatile("v_mbcnt_lo_u32_b32 %0, -1, 0\n\tv_mbcnt_hi_u32_b32 %0, -1, %0" : "=v"(l)); return l; }
__device__ __forceinline__ float shfl_idx(float v, int src) { return __int_as_float(__builtin_amdgcn_ds_bpermute(src << 2, __float_as_int(v))); }
__device__ __forceinline__ float wave_sum(float v) {
    const int l = olane();
#pragma unroll
    for (int o = 1; o < 64; o <<= 1) v += shfl_idx(v, l ^ o);
    return v;
}
__device__ __forceinline__ float wave_max(float v) {
    const int l = olane();
#pragma unroll
    for (int o = 1; o < 64; o <<= 1) v = fmaxf(v, shfl_idx(v, l ^ o));
    return v;
}
__device__ __forceinline__ float rdlane(float v, int src) { return __int_as_float(__builtin_amdgcn_readlane(__float_as_int(v), src)); }
__device__ __forceinline__ float sigmoidf_(float x) { return 1.f / (1.f + __expf(-x)); }
__device__ __forceinline__ float siluf_(float x) { return x / (1.f + __expf(-x)); }
__device__ __forceinline__ float gelu_tanh(float x) {
    const float u = 0.7978845608028654f * (x + 0.044715f * x * x * x);
    return 0.5f * x * (1.f + tanhf(u));
}

extern __shared__ __attribute__((aligned(16))) unsigned char lds_raw[];
constexpr int WIDTAB_OFF = 147456 - 768;
__device__ __forceinline__ int owave() {
    const unsigned key = (unsigned)__builtin_amdgcn_s_getreg(63492) & 63u;
    const int w = *(volatile __attribute__((address_space(3))) int*)((__attribute__((address_space(3))) unsigned char*)lds_raw + WIDTAB_OFF + 4 * key);
    return __builtin_amdgcn_readfirstlane(w);
}
__device__ __forceinline__ int olane_() { int l; asm volatile("v_mbcnt_lo_u32_b32 %0, -1, 0\n\tv_mbcnt_hi_u32_b32 %0, -1, %0" : "=v"(l)); return l; }
__device__ __forceinline__ int otid() { return owave() * 64 + olane_(); }
__device__ __forceinline__ int obid() { int b = blockIdx.x; asm volatile("" : "+s"(b)); return b; }
__device__ __forceinline__ int ogdim() { int g = gridDim.x; asm volatile("" : "+s"(g)); return g; }
typedef unsigned short bf16;
__device__ __forceinline__ float bf2f(bf16 v) { return __uint_as_float((unsigned)v << 16); }
typedef float f32x2cv __attribute__((ext_vector_type(2))); typedef __bf16 bf16x2cv __attribute__((ext_vector_type(2)));
__device__ __forceinline__ unsigned pk2(float lo, float hi) { const f32x2cv v = {lo, hi}; const bf16x2cv b = __builtin_convertvector(v, bf16x2cv); return __builtin_bit_cast(unsigned, b); }
__device__ __forceinline__ unsigned f2bf(float f) { return pk2(f, 0.f) & 0xffffu; }

#define XB_TMO      128
#define XB_XCNT(j)  (256  + 64 * (j))
#define XB_XSUB(j)  (1280 + 64 * (j))
#define XB_XGEN(j)  (2304 + 64 * (j))
#define XB_TOP      3328
#define XB_TOPGEN   3392
#define XCD_BAR_WORDS 3456
#define XB_SPIN_CAP (1u << 27)
__device__ __forceinline__ unsigned xb_ld(unsigned* p)              { return __hip_atomic_load(p, __ATOMIC_RELAXED, __HIP_MEMORY_SCOPE_AGENT); }
__device__ __forceinline__ unsigned xb_add(unsigned* p, unsigned v) { return __hip_atomic_fetch_add(p, v, __ATOMIC_RELAXED, __HIP_MEMORY_SCOPE_AGENT); }
__device__ __forceinline__ unsigned xb_xcc_id() { return (unsigned)__builtin_amdgcn_s_getreg((3 << 11) | 20) & 0xFu; }
#define XB_SPIN(cond, bar) do { unsigned _sp = 0; while (cond) { __builtin_amdgcn_s_sleep(1); \
    if ((++_sp & 255u) == 0u) { if (xb_ld(&(bar)[XB_TMO])) break; if (_sp > XB_SPIN_CAP) { atomicAdd(&(bar)[XB_TMO], 1u); break; } } } } while (0)
struct XcdBarrier { unsigned* bar; unsigned x; volatile LAS unsigned* st; };
__device__ __forceinline__ XcdBarrier xcd_barrier_post(unsigned* bar, volatile LAS unsigned* st) {
    XcdBarrier b; b.bar = bar; b.x = xb_xcc_id(); b.st = st;
    if (threadIdx.x == 0) (void)xb_add(&bar[XB_XCNT(b.x)], 1u);
    return b;
}
__device__ __forceinline__ void xcd_barrier_complete(unsigned* bar, unsigned x, unsigned& nloc, unsigned& nx) {
    const unsigned G = gridDim.x * gridDim.y * gridDim.z;
    unsigned sum, cnt, mine, sp = 0u;
    for (;;) {
        sum = 0u; cnt = 0u; mine = 0u;
#pragma unroll
        for (unsigned j = 0; j < 16; ++j) { const unsigned c = xb_ld(&bar[XB_XCNT(j)]); sum += c; cnt += (c > 0u) ? 1u : 0u; mine = (j == x) ? c : mine; }
        if (sum == G) break;
        __builtin_amdgcn_s_sleep(1);
        if ((++sp & 255u) == 0u) { if (xb_ld(&bar[XB_TMO])) break; if (sp > XB_SPIN_CAP) { atomicAdd(&bar[XB_TMO], 1u); break; } }
    }
    nloc = mine > 0u ? mine : 1u; nx = cnt > 0u ? cnt : 1u;
}
__device__ __forceinline__ void xcd_barrier(const XcdBarrier& b) {
    asm volatile("s_waitcnt vmcnt(0)" ::: "memory");
    __syncthreads();
    if (otid() == 0) {
        unsigned* bar = b.bar; asm volatile("" : "+s"(bar));
        unsigned bx = b.x; asm volatile("" : "+s"(bx));
        __builtin_amdgcn_s_waitcnt(0);
        unsigned nloc = b.st[0], nx = b.st[1];
        if (nloc == 0u) { xcd_barrier_complete(bar, bx, nloc, nx); b.st[0] = nloc; b.st[1] = nx; }
        const unsigned old = xb_add(&bar[XB_XSUB(bx)], 1u);
        const unsigned gen = old / nloc;
        if (old + 1u == (gen + 1u) * nloc) {
            __builtin_amdgcn_fence(__ATOMIC_RELEASE, "agent");
            asm volatile("s_waitcnt vmcnt(0)" ::: "memory");
            const unsigned og = xb_add(&bar[XB_TOP], 1u);
            const unsigned tg = og / nx;
            if (og + 1u == (tg + 1u) * nx) xb_add(&bar[XB_TOPGEN], 1u);
            else XB_SPIN(xb_ld(&bar[XB_TOPGEN]) == tg, bar);
            __builtin_amdgcn_fence(__ATOMIC_ACQUIRE, "agent");
            xb_add(&bar[XB_XGEN(bx)], 1u);
            asm volatile("s_waitcnt vmcnt(0)" ::: "memory");
        } else {
            XB_SPIN(xb_ld(&bar[XB_XGEN(bx)]) == gen, bar);
            __builtin_amdgcn_fence(__ATOMIC_ACQUIRE, "agent");
            asm volatile("s_waitcnt vmcnt(0)" ::: "memory");
        }
    }
    __syncthreads();
}

namespace pg8 {
#define PG8_LAS __attribute__((address_space(3)))
typedef unsigned short bf16_t;
typedef short bf16x8 __attribute__((ext_vector_type(8)));
typedef float f32x4 __attribute__((ext_vector_type(4)));
typedef unsigned u32x4 __attribute__((ext_vector_type(4)));
constexpr int BM = 256, BK = 64, HALF = 128, HTB = HALF * BK * 2  , STAGE_BYTES = 8 * HTB, NXCD = 8, WGM = 8;

__host__ __device__ __forceinline__ int lds_byte(int r, int c) { const int st = (r >> 4) * 2 + (c >> 5), rr = r & 15, cc = c & 31, ob = rr * 64 + cc * 2; return st * 1024 + (ob ^ (((ob >> 9) & 1) << 5)); }
__host__ __device__ __forceinline__ void stage_rc(int b, int& R, int& C) { const int st = b / 1024, sb = b % 1024, swz = sb ^ (((sb >> 9) & 1) << 5); R = (st >> 1) * 16 + swz / 64; C = (st & 1) * 32 + (swz % 64) / 2; }
__host__ __device__ __forceinline__ int perm32(int rho) { const int n = rho >> 4, i = rho & 15; return 8 * (i >> 2) + 4 * n + (i & 3); }

struct Unit { int pm, pn; size_t boff; int aux; };
struct Gemm { const bf16_t* A; const bf16_t* Bt; int M, N, K; };

struct StaticOrder {
    static constexpr bool DENSE = true;
    int nM, nN, nwg, G, c;
    __host__ __device__ __forceinline__ void init(int M, int N, int G_, int c_) { nM = M / BM; nN = N / BM; nwg = nM * nN; G = G_; c = c_; }
    __host__ __device__ __forceinline__ bool next(int i, Unit& u) const {
        const long L = (long)i * G + c; if (L >= nwg) return false;
        int wgid = (int)L; { const int q = nwg / NXCD, r = nwg % NXCD, xcd = wgid % NXCD, off = wgid / NXCD; wgid = (xcd < r ? xcd * (q + 1) : r * (q + 1) + (xcd - r) * q) + off; }
        const int nig = WGM * nN, gid = wgid / nig, fm = gid * WGM, gsz = (nM - fm) < WGM ? (nM - fm) : WGM;
        u.pm = fm + ((wgid % nig) % gsz); u.pn = (wgid % nig) / gsz; u.boff = 0; u.aux = 0; return true;
    }
    __device__ __forceinline__ unsigned arow(const Unit& u, int r) const { return (unsigned)(u.pm * BM + r); }
    __device__ __forceinline__ void a_ready(const Unit&) const {}
    __device__ __forceinline__ void done(const Unit&) const {}
};

__device__ __forceinline__ unsigned cvt_pk_bf16(float lo, float hi) { typedef float f2_ __attribute__((ext_vector_type(2))); typedef __bf16 b2_ __attribute__((ext_vector_type(2))); const f2_ v = {lo, hi}; const b2_ b = __builtin_convertvector(v, b2_); return __builtin_bit_cast(unsigned, b); }
typedef float f32x2 __attribute__((ext_vector_type(2)));
__device__ __forceinline__ f32x2 gelu_pk(f32x2 v) {
    const f32x2 av = __builtin_elementwise_abs(v), d = av * 0.2316418882f + 1.0f;
    f32x2 t; t.x = __builtin_amdgcn_rcpf(d.x); t.y = __builtin_amdgcn_rcpf(d.y);
    f32x2 q = t * 0.5307027145f + (-0.7265760135f); q = q * t + 0.7107068705f; q = q * t + (-0.142248368f); q = q * t + 0.127414796f; q = q * t;
    const f32x2 s = (v * v) * (-0.72134752044f);
    f32x2 e; e.x = __builtin_amdgcn_exp2f(s.x); e.y = __builtin_amdgcn_exp2f(s.y);
    const f32x2 m = v * (q * e), r = v - m;
    f32x2 o; o.x = v.x < 0.f ? m.x : r.x; o.y = v.y < 0.f ? m.y : r.y; return o;
}

template <int ACT  > struct EpiBf16 {
    static constexpr bool PERM = true, PERM2 = false, AFTER_DRAIN = false; static_assert(ACT == 0 || ACT == 1, "EpiBf16: ACT is 0 (none) or 1 (gelu_pk)");
    bf16_t* O; int ldc; const float* bias; int split_cols; size_t split_stride; float scale0;
    __device__ __forceinline__ void operator()(const f32x4 (&acc)[2][2][4][2], const Unit& u, int wr, int wc, int fr, int fq) const {
        const int row0 = u.pm * BM + wr * 64 + fr; int colt = u.pn * BM; bf16_t* base = O;
        float sc = 1.f; if (split_cols) { const int t = colt / split_cols; base += (size_t)t * split_stride; colt -= t * split_cols; if (t == 0) sc = scale0; }
        const int col0 = colt + wc * 32 + 8 * fq, bcol0 = u.pn * BM + wc * 32 + 8 * fq;
        f32x4 bv[2][2];
#pragma unroll
        for (int bj = 0; bj < 2; ++bj)
#pragma unroll
            for (int n = 0; n < 2; ++n) bv[bj][n] = bias ? *(const f32x4*)(bias + bcol0 + bj * HALF + 4 * n) : (f32x4){0.f, 0.f, 0.f, 0.f};
#pragma unroll
        for (int ai = 0; ai < 2; ++ai)
#pragma unroll
            for (int m = 0; m < 4; ++m) { bf16_t* rowp = base + (size_t)(row0 + ai * HALF + m * 16) * ldc + col0;
#pragma unroll
                for (int bj = 0; bj < 2; ++bj) { f32x4 v0 = acc[ai][bj][m][0] + bv[bj][0], v1 = acc[ai][bj][m][1] + bv[bj][1];
                    if (ACT == 1) { f32x2 a = gelu_pk((f32x2){v0[0], v0[1]}), b = gelu_pk((f32x2){v0[2], v0[3]}), c = gelu_pk((f32x2){v1[0], v1[1]}), d = gelu_pk((f32x2){v1[2], v1[3]});
                        v0 = (f32x4){a.x, a.y, b.x, b.y}; v1 = (f32x4){c.x, c.y, d.x, d.y}; }
                    v0 = v0 * sc; v1 = v1 * sc; u32x4 w; w.x = cvt_pk_bf16(v0[0], v0[1]); w.y = cvt_pk_bf16(v0[2], v0[3]); w.z = cvt_pk_bf16(v1[0], v1[1]); w.w = cvt_pk_bf16(v1[2], v1[3]);
                    *(u32x4*)(rowp + bj * HALF) = w; } }
    }
};

struct EpiF32 {
    static constexpr bool PERM = false, PERM2 = false, AFTER_DRAIN = false;
    float* C; int ldc;
    __device__ __forceinline__ void operator()(const f32x4 (&acc)[2][2][4][2], const Unit& u, int wr, int wc, int fr, int fq) const {
        const int row0 = u.pm * BM + wr * 64 + fr, col0 = u.pn * BM + wc * 32 + 4 * fq;
#pragma unroll
        for (int ai = 0; ai < 2; ++ai)
#pragma unroll
            for (int m = 0; m < 4; ++m) { float* rowp = C + (size_t)(row0 + ai * HALF + m * 16) * ldc + col0;
#pragma unroll
                for (int bj = 0; bj < 2; ++bj)
#pragma unroll
                    for (int n = 0; n < 2; ++n) *(f32x4*)(rowp + bj * HALF + n * 16) = acc[ai][bj][m][n]; }
    }
};

struct EpiLds {
    static constexpr bool PERM = false, PERM2 = false, AFTER_DRAIN = true;
    int ld;
    __device__ __forceinline__ void operator()(const f32x4 (&)[2][2][4][2], const Unit&, int, int, int, int) const {}
    __device__ __forceinline__ void after(const f32x4 (&acc)[2][2][4][2], PG8_LAS unsigned char* lds, int wr, int wc, int fr, int fq) const {
        if (wc < 2) {
#pragma unroll
            for (int ai = 0; ai < 2; ++ai)
#pragma unroll
                for (int m = 0; m < 4; ++m)
#pragma unroll
                    for (int n = 0; n < 2; ++n) *(PG8_LAS f32x4*)(lds + ((ai * HALF + wr * 64 + m * 16 + fr) * ld + wc * 32 + n * 16 + 4 * fq) * 4) = acc[ai][0][m][n];
        }
    }
};
struct EpiSwiGLU {
    static constexpr bool PERM = true, PERM2 = false, AFTER_DRAIN = false;
    bf16_t* O;
    __device__ __forceinline__ void operator()(const f32x4 (&acc)[2][2][4][2], const Unit& u, int wr, int wc, int fr, int fq) const {
        const int row0 = u.pm * BM + wr * 64 + fr, col0 = u.pn * HALF + wc * 32 + 8 * fq;
#pragma unroll
        for (int ai = 0; ai < 2; ++ai)
#pragma unroll
            for (int m = 0; m < 4; ++m) {
                bf16_t* rowp = O + (size_t)(row0 + ai * HALF + m * 16) * 256 + col0;
                float hv[8];
#pragma unroll
                for (int n = 0; n < 2; ++n)
#pragma unroll
                    for (int j = 0; j < 4; ++j) { const float a = acc[ai][0][m][n][j], g = acc[ai][1][m][n][j]; hv[n * 4 + j] = a * __builtin_amdgcn_rcpf(1.f + __expf(-a)) * g; }
                u32x4 w; w.x = cvt_pk_bf16(hv[0], hv[1]); w.y = cvt_pk_bf16(hv[2], hv[3]); w.z = cvt_pk_bf16(hv[4], hv[5]); w.w = cvt_pk_bf16(hv[6], hv[7]);
                *(u32x4*)rowp = w;
            }
    }
};
__device__ __forceinline__ unsigned pack_fp8x4(const f32x4& v) {
    const float s = 16.f;
    int w = __builtin_amdgcn_cvt_pk_fp8_f32(__builtin_amdgcn_fmed3f(v[0] * s, -448.f, 448.f), __builtin_amdgcn_fmed3f(v[1] * s, -448.f, 448.f), 0, false);
    w = __builtin_amdgcn_cvt_pk_fp8_f32(__builtin_amdgcn_fmed3f(v[2] * s, -448.f, 448.f), __builtin_amdgcn_fmed3f(v[3] * s, -448.f, 448.f), w, true);
    return (unsigned)w;
}
struct EpiRows {
    static constexpr bool PERM = true, PERM2 = true, AFTER_DRAIN = false;
    unsigned char* O; unsigned char* O2; int shared_pm0;
    __device__ __forceinline__ void operator()(const f32x4 (&acc)[2][2][4][2], const Unit& u, int wr, int wc, int fr, int fq) const {
        unsigned char* base = u.pm < shared_pm0 ? O + (size_t)u.pm * BM * 1024 : O2 + (size_t)(u.pm - shared_pm0) * BM * 1024;
        const int row0 = wr * 64 + fr, col0 = u.pn * BM + wc * 64 + 16 * fq;
#pragma unroll
        for (int ai = 0; ai < 2; ++ai)
#pragma unroll
            for (int m = 0; m < 4; ++m) {
                u32x4 w; w.x = pack_fp8x4(acc[ai][0][m][0]); w.y = pack_fp8x4(acc[ai][0][m][1]); w.z = pack_fp8x4(acc[ai][1][m][0]); w.w = pack_fp8x4(acc[ai][1][m][1]);
                *(u32x4*)(base + (size_t)(row0 + ai * HALF + m * 16) * 1024 + col0) = w;
            }
    }
};
template <bool GATHER> struct GroupedOrder {
    static constexpr bool DENSE = !GATHER;
    int nMr, nM, nN, nwg, G, c, spm0; const int* ps; const int* rows; size_t estride;
    __device__ __forceinline__ void init(const int* ps_, int nN_, int G_, int c_, const int* rows_, size_t estride_, int spm0_, int nshared) {
        ps = ps_; nMr = ps_[64] / BM; nM = nMr + nshared; nN = nN_; nwg = nM * nN; G = G_; c = c_; rows = rows_; estride = estride_; spm0 = spm0_; }
    __device__ __forceinline__ bool next(int i, Unit& u) const {
        const long L = (long)i * G + c; if (L >= nwg) return false;
        int wgid = (int)L; { const int q = nwg / NXCD, r = nwg % NXCD, xcd = wgid % NXCD, off = wgid / NXCD; wgid = (xcd < r ? xcd * (q + 1) : r * (q + 1) + (xcd - r) * q) + off; }
        const int nig = WGM * nN, gid = wgid / nig, fm = gid * WGM, gsz = (nM - fm) < WGM ? (nM - fm) : WGM;
        const int pmi = fm + ((wgid % nig) % gsz); u.pn = (wgid % nig) / gsz;
        if (pmi < nMr) { const int pj = ps[olane()];
            const int e = __popcll(__ballot(pmi * BM >= pj)) - 1; u.pm = pmi; u.boff = (size_t)e * estride; u.aux = e * 16384 + (pmi * BM - __builtin_amdgcn_readlane(pj, e)); }
        else { u.pm = spm0 + (pmi - nMr); u.boff = (size_t)64 * estride; u.aux = 0; }
        return true;
    }
    __device__ __forceinline__ unsigned arow(const Unit& u, int r) const {
        if constexpr (GATHER) { if (u.pm >= spm0) return (unsigned)((u.pm - spm0) * BM + r); const unsigned v = (unsigned)rows[u.aux + r]; return v < 16384u ? v : 0u; }
        else return (unsigned)(u.pm * BM + r);
    }
    __device__ __forceinline__ void a_ready(const Unit&) const {}
    __device__ __forceinline__ void done(const Unit&) const {}
};

template <class Epi, class Sched, bool ALIGN_EPI = false>
__device__ __forceinline__ void gemm_phase(PG8_LAS unsigned char* lds, const Gemm g, const Sched& S, const Epi& E) {
    const int wid = owave(), wr = wid >> 2, wc = wid & 3;
#define tid (wid * 64 + olane())
    int K = g.K; asm volatile("" : "+s"(K));
    const int nt = K / BK;
    unsigned voffB;
    { int R, C; stage_rc(tid * 16, R, C);
      const int Rb = Epi::PERM2 ? (64 * (R >> 5) + 16 * ((R >> 2) & 3) + 4 * ((R >> 4) & 1) + (R & 3)) : Epi::PERM ? ((R & ~31) + perm32(R & 31)) : R; voffB = (unsigned)(Rb * K + C) * 2u; }
    const size_t r64step = (size_t)(Epi::PERM2 ? 128 : 64) * K * 2;
    const size_t bhstep = Epi::PERM2 ? (size_t)8 * K * 2 : (size_t)HALF * K * 2;
    const unsigned rowbytes = (unsigned)K * 2u;
    const size_t kstep = (size_t)(BK * 2);
    const size_t hstep = (size_t)HALF * K * 2;
    const size_t tstep = 2 * hstep;
    const unsigned ldsw = (unsigned)wid * 1024u;
    int aoff, boff; { const int ln = olane(), fr = ln & 15, fq = ln >> 4; aoff = lds_byte(wr * 64 + fr, fq * 8); boff = lds_byte(wc * 32 + fr, fq * 8); }
#define PG8_SA(b, h) (((b) * 2 + (h)) * HTB)
#define PG8_SB(b, h) ((4 + (b) * 2 + (h)) * HTB)
#define PG8_STAGE(bufoff, gbase, voff) do { _Pragma("unroll") for (int _i = 0; _i < 2; ++_i) \
        __builtin_amdgcn_global_load_lds((const unsigned*)((const char*)(gbase) + (voff)[_i]), (PG8_LAS unsigned*)(lds + (bufoff) + ldsw + _i * 8192), 16, 0, 0); } while (0)
#define PG8_STAGEB(bufoff, gbase) do { _Pragma("unroll") for (int _i = 0; _i < 2; ++_i) \
        __builtin_amdgcn_global_load_lds((const unsigned*)((const char*)(gbase) + _i * r64step + voffB), (PG8_LAS unsigned*)(lds + (bufoff) + ldsw + _i * 8192), 16, 0, 0); } while (0)
#define PG8_LDA(dst, b, h) do { _Pragma("unroll") for (int m = 0; m < 4; ++m) _Pragma("unroll") for (int k = 0; k < 2; ++k) dst[m][k] = *(const PG8_LAS bf16x8*)(lds + PG8_SA(b, h) + aoff + m * 2048 + k * 1024); } while (0)
#define PG8_LDB(dst, b, h) do { _Pragma("unroll") for (int n = 0; n < 2; ++n) _Pragma("unroll") for (int k = 0; k < 2; ++k) dst[n][k] = *(const PG8_LAS bf16x8*)(lds + PG8_SB(b, h) + boff + n * 2048 + k * 1024); } while (0)
#define PG8_MMA(ai, bj, At, Bt) do { __builtin_amdgcn_s_setprio(1); _Pragma("unroll") for (int m = 0; m < 4; ++m) _Pragma("unroll") for (int n = 0; n < 2; ++n) _Pragma("unroll") for (int k = 0; k < 2; ++k) \
        acc[ai][bj][m][n] = __builtin_amdgcn_mfma_f32_16x16x32_bf16(Bt[n][k], At[m][k], acc[ai][bj][m][n], 0, 0, 0); __builtin_amdgcn_s_setprio(0); } while (0)
#define PG8_WAIT_V(n) asm volatile("s_waitcnt vmcnt(" #n ")" ::: "memory")
#define PG8_WAIT_L(n) asm volatile("s_waitcnt lgkmcnt(" #n ")" ::: "memory")
#define PG8_BAR __builtin_amdgcn_s_barrier()
#define PG8_SCHED __builtin_amdgcn_sched_barrier(0)
#define PG8_FILL(tb, u) do { int _t = tid; asm volatile("" : "+v"(_t)); if (_t < BM) rtab[(tb) * BM + _t] = S.arow(u, _t) * rowbytes; } while (0)
#define PG8_AOFF(dst, tb) do { int _t = tid; asm volatile("" : "+v"(_t)); _Pragma("unroll") for (int _i = 0; _i < 2; ++_i) { int _R, _C; stage_rc(_t * 16 + _i * 8192, _R, _C); \
        _Pragma("unroll") for (int _h = 0; _h < 2; ++_h) dst[_h][_i] = rtab[(tb) * BM + _h * HALF + _R] + (unsigned)_C * 2u; } } while (0)
    PG8_LAS unsigned* const rtab = (PG8_LAS unsigned*)(lds + STAGE_BYTES);
    unsigned voffA; { int R, C; stage_rc(tid * 16, R, C); voffA = (unsigned)(R * K + C) * 2u; }
    const size_t a64step = (size_t)64 * K * 2;
#define PG8_STAGE_A(bufoff, koff, SEL, h) do { if constexpr (Sched::DENSE) { const char* ab_ = ((SEL) ? aS2 : aCur) + (koff) + (size_t)(h) * hstep; \
        _Pragma("unroll") for (int _i = 0; _i < 2; ++_i) __builtin_amdgcn_global_load_lds((const unsigned*)(ab_ + _i * a64step + voffA), (PG8_LAS unsigned*)(lds + (bufoff) + ldsw + _i * 8192), 16, 0, 0); } \
    else { if ((SEL) && lastU) PG8_STAGE(bufoff, Ab + (koff), nvU[h]); else PG8_STAGE(bufoff, Ab + (koff), cvU[h]); } } while (0)
    Unit cur, nxt; int ui = 0, ctb = 0;
    if (!S.next(0, cur)) return;
    f32x4 acc[2][2][4][2];
#pragma unroll
    for (int a = 0; a < 2; ++a)
#pragma unroll
        for (int b = 0; b < 2; ++b)
#pragma unroll
            for (int m = 0; m < 4; ++m)
#pragma unroll
                for (int n = 0; n < 2; ++n) acc[a][b][m][n] = (f32x4){0.f, 0.f, 0.f, 0.f};
    bf16x8 At[4][2], B0[2][2], B1[2][2];
    const char* const Ab = (const char*)g.A;
    const char* cB = (const char*)g.Bt + cur.boff + (size_t)cur.pn * tstep;
    const char* aCur = Ab + (size_t)S.arow(cur, 0) * rowbytes;
    unsigned cvU[2][2], nvU[2][2]; bool lastU = false;
    if constexpr (!Sched::DENSE) { PG8_FILL(0, cur); __syncthreads(); PG8_AOFF(cvU, 0); }
    S.a_ready(cur);
    { const char* const aS2 = aCur;
    PG8_STAGEB(PG8_SB(0, 0), cB); PG8_STAGEB(PG8_SB(0, 1), cB + bhstep); PG8_STAGE_A(PG8_SA(0, 0), 0, 0, 0); PG8_STAGE_A(PG8_SA(0, 1), 0, 0, 1);
    if (wr == 1) PG8_BAR;
    PG8_WAIT_V(2); PG8_BAR;
    PG8_STAGEB(PG8_SB(1, 0), cB + kstep); PG8_STAGE_A(PG8_SA(1, 0), kstep, 0, 0); PG8_STAGEB(PG8_SB(1, 1), cB + bhstep + kstep);
    PG8_WAIT_V(6); PG8_BAR; }
    for (;;) {
        const bool has_next = S.next(ui + 1, nxt);
        const char* nB = has_next ? (const char*)g.Bt + nxt.boff + (size_t)nxt.pn * tstep : cB;
        const char* aNxt = has_next ? Ab + (size_t)S.arow(nxt, 0) * rowbytes : aCur;
        if constexpr (!Sched::DENSE) { if (has_next) PG8_FILL(ctb ^ 1, nxt); }
        for (int t = 0; t < nt; t += 2) {
            const bool last = (t == nt - 2);
            const size_t k1 = (size_t)(t + 1) * kstep, k2 = last ? (size_t)0 : (size_t)(t + 2) * kstep, k3 = k2 + kstep;
            const char* b2 = last ? nB : cB + (size_t)(t + 2) * kstep; const char* b3 = b2 + kstep;
            const char* const aS2 = last ? aNxt : aCur;
            lastU = last;
            if constexpr (!Sched::DENSE) { if (last) PG8_AOFF(nvU, has_next ? (ctb ^ 1) : ctb); }
            if (last && has_next) S.a_ready(nxt);
            PG8_LDB(B0, 0, 0); PG8_LDB(B1, 0, 1); PG8_SCHED; PG8_LDA(At, 0, 0); PG8_STAGE_A(PG8_SA(1, 1), k1, 0, 1);
            PG8_WAIT_V(8); PG8_WAIT_L(0); PG8_BAR; PG8_MMA(0, 0, At, B0); PG8_MMA(0, 1, At, B1); PG8_BAR; PG8_SCHED;
            PG8_LDA(At, 0, 1); PG8_STAGEB(PG8_SB(0, 0), b2); PG8_STAGEB(PG8_SB(0, 1), b2 + bhstep); PG8_STAGE_A(PG8_SA(0, 0), k2, 1, 0);
            PG8_WAIT_V(8); PG8_WAIT_L(0); PG8_BAR; PG8_MMA(1, 0, At, B0); PG8_MMA(1, 1, At, B1); PG8_BAR; PG8_SCHED;
            PG8_LDB(B0, 1, 0); PG8_LDB(B1, 1, 1); PG8_SCHED; PG8_LDA(At, 1, 0); PG8_STAGE_A(PG8_SA(0, 1), k2, 1, 1);
            PG8_WAIT_V(8); PG8_WAIT_L(0); PG8_BAR; PG8_MMA(0, 0, At, B0); PG8_MMA(0, 1, At, B1); PG8_BAR; PG8_SCHED;
            PG8_LDA(At, 1, 1); PG8_STAGEB(PG8_SB(1, 0), b3); PG8_STAGEB(PG8_SB(1, 1), b3 + bhstep); PG8_STAGE_A(PG8_SA(1, 0), k3, 1, 0);
            PG8_WAIT_V(8); PG8_WAIT_L(0); PG8_BAR; PG8_MMA(1, 0, At, B0); PG8_MMA(1, 1, At, B1); PG8_BAR; PG8_SCHED;
        }
        if constexpr (ALIGN_EPI) { if (wr == 0) PG8_BAR; }
        if constexpr (!Epi::AFTER_DRAIN) { const int ln = olane(); E(acc, cur, wr, wc, ln & 15, ln >> 4); } S.done(cur);
        if (!has_next) break;
#pragma unroll
        for (int a = 0; a < 2; ++a)
#pragma unroll
            for (int b = 0; b < 2; ++b)
#pragma unroll
                for (int m = 0; m < 4; ++m)
#pragma unroll
                    for (int n = 0; n < 2; ++n) acc[a][b][m][n] = (f32x4){0.f, 0.f, 0.f, 0.f};
        cur = nxt; cB = nB; aCur = aNxt; ++ui; ctb ^= 1;
        if constexpr (!Sched::DENSE) { cvU[0][0] = nvU[0][0]; cvU[0][1] = nvU[0][1]; cvU[1][0] = nvU[1][0]; cvU[1][1] = nvU[1][1]; }
        if constexpr (ALIGN_EPI) { if (wr == 1) PG8_BAR; }
    }
    PG8_WAIT_V(0);
    if constexpr (!ALIGN_EPI) { if (wr == 0) PG8_BAR; }
    PG8_BAR;
    if constexpr (Epi::AFTER_DRAIN) { const int ln = olane(); E.after(acc, lds, wr, wc, ln & 15, ln >> 4); }
#undef PG8_FILL
#undef tid
#undef PG8_SA
#undef PG8_SB
#undef PG8_STAGE
#undef PG8_STAGEB
#undef PG8_LDA
#undef PG8_LDB
#undef PG8_MMA
#undef PG8_WAIT_V
#undef PG8_WAIT_L
#undef PG8_BAR
#undef PG8_SCHED
#undef PG8_AOFF
#undef PG8_STAGE_A
}
}

struct Args { const float* in[36]; float* out; char* ws; };

constexpr size_t al256(size_t x) { return (x + 255) & ~(size_t)255; }
constexpr size_t MiB = (size_t)1 << 20;
constexpr size_t WS_CTL = 0;
constexpr size_t CTL_BYTES = 64 * 1024;
constexpr int CW_BAR = 0, CW_CNT = 8192, CW_CUR = 8192 + 64, CW_SCAN = 8192 + 256  ;
constexpr size_t WS_MOD = WS_CTL + CTL_BYTES;
constexpr size_t WS_TOPI = 512 * 1024;
constexpr size_t WS_TOPW = 1 * MiB;
constexpr size_t WS_ROWT = 1 * MiB + 512 * 1024;
constexpr size_t WS_DST = 2 * MiB + 512 * 1024;
constexpr size_t WS_SMALL = 3 * MiB + 256 * 1024;
constexpr size_t WS_WTR = 4 * MiB;
constexpr size_t WS_WTIN = 5 * MiB;
constexpr size_t WS_WTOUT = 17 * MiB;
constexpr size_t WS_WTUP = 21 * MiB;
constexpr size_t WS_WTDN = 86 * MiB;
constexpr size_t WS_HBF = 119 * MiB;
constexpr size_t WS_ARENA = 151 * MiB;
constexpr size_t WS_PROJ = WS_ARENA;
constexpr size_t WS_MIXB = WS_ARENA + 96 * MiB;
constexpr size_t WS_RW = WS_ARENA + 128 * MiB;
constexpr size_t WS_CHK = WS_ARENA + 256 * MiB;
constexpr size_t WS_GU = WS_ARENA + 256 * MiB;
constexpr size_t WS_HBB = WS_ARENA;
constexpr size_t WS_YB = WS_ARENA + 81 * MiB;
constexpr size_t WS_YS = WS_ARENA + 232 * MiB;
constexpr size_t WS_LOGIT = WS_YB;
constexpr size_t WS_ROWE = WS_ARENA + 352 * MiB;
constexpr size_t WS_BON = WS_ARENA + 357 * MiB;
constexpr size_t WS_END = WS_ARENA + 369 * MiB;
static_assert(WS_MOD + (size_t)DEPTH * BATCH * 6 * D * 4 <= WS_TOPI && WS_DST + (size_t)P * 4 <= WS_WTIN && WS_WTUP + (size_t)65 * 512 * 1024 * 2 <= WS_WTDN && WS_WTDN + (size_t)65 * 1024 * 256 * 2 <= WS_HBF, "ws map");
static_assert(WS_HBB + (size_t)(P + T) * 256 * 2 <= WS_YB && WS_YB + (size_t)P * 1024 * 2 <= WS_END, "ws map (moe)");

struct ItemDesc { const float* W; int N; bf16* WT; int K, k0, n0, drow0; };
__device__ __forceinline__ void item_load(const ItemDesc& d, float (&v)[32], int lane) {
    const float* p = d.W + (size_t)(d.k0 + (lane >> 3)) * d.N + d.n0 + 4 * (lane & 7);
#pragma unroll
    for (int j = 0; j < 8; ++j) { const float4 t = *(const float4*)(p + (size_t)(8 * j) * d.N); v[4 * j] = t.x; v[4 * j + 1] = t.y; v[4 * j + 2] = t.z; v[4 * j + 3] = t.w; }
}
__device__ __forceinline__ void item_finish(const ItemDesc& d, const float (&v)[32], float* scr, int lane) {
#pragma unroll
    for (int j = 0; j < 8; ++j) { const int k = 8 * j + (lane >> 3), sw = (8 * ((k >> 3) & 3)) ^ (4 * ((k >> 5) & 1));
        *(float4*)(scr + k * 32 + ((4 * (lane & 7)) ^ sw)) = make_float4(v[4 * j], v[4 * j + 1], v[4 * j + 2], v[4 * j + 3]); }
    asm volatile("s_waitcnt lgkmcnt(0)" ::: "memory");
    const int c = lane & 7, swc = (8 * (c & 3)) ^ (4 * (c >> 2));
#pragma unroll
    for (int j = 0; j < 4; ++j) { const int n = (lane >> 3) + 8 * j; const float* sp = scr + (8 * c) * 32 + (n ^ swc);
        uint4 o; o.x = pk2(sp[0 * 32], sp[1 * 32]); o.y = pk2(sp[2 * 32], sp[3 * 32]); o.z = pk2(sp[4 * 32], sp[5 * 32]); o.w = pk2(sp[6 * 32], sp[7 * 32]);
        *(uint4*)(d.WT + (size_t)(d.drow0 + n) * d.K + d.k0 + 8 * c) = o; }
    asm volatile("s_waitcnt lgkmcnt(0)" ::: "memory");
}
template <int CTRL> __device__ __forceinline__ float dpp_add(float v) { return v + __int_as_float(__builtin_amdgcn_update_dpp(0, __float_as_int(v), CTRL, 0xF, 0xF, false)); }
__device__ __forceinline__ float wave_sum_fast(float v) {
    v = dpp_add<0xB1>(v); v = dpp_add<0x4E>(v); v = dpp_add<0x141>(v); v = dpp_add<0x140>(v);
    const int vi = __float_as_int(v);
    return (__int_as_float(__builtin_amdgcn_readlane(vi, 0)) + __int_as_float(__builtin_amdgcn_readlane(vi, 16))) + (__int_as_float(__builtin_amdgcn_readlane(vi, 32)) + __int_as_float(__builtin_amdgcn_readlane(vi, 48)));
}
typedef unsigned u32x4n __attribute__((ext_vector_type(4)));
typedef unsigned u32x2n __attribute__((ext_vector_type(2)));
__device__ __forceinline__ uint4 nt_load16(const void* p) { const u32x4n v = __builtin_nontemporal_load((const u32x4n*)p); return make_uint4(v.x, v.y, v.z, v.w); }
__device__ __forceinline__ uint2 nt_load8(const void* p) { const u32x2n v = __builtin_nontemporal_load((const u32x2n*)p); return make_uint2(v.x, v.y); }
__device__ __forceinline__ float sq4(const float4& a) { return a.x * a.x + a.y * a.y + a.z * a.z + a.w * a.w; }
template <bool HAS_Y, bool HAS_H>
__device__ __forceinline__ void row_phase(const float* xin, const bf16* y, const float* gy, const float* gate_base, float* xout,
                                          const float* gn, const float* mod_l, int sh_idx, int sc_idx, bf16* hb) {
    const int tidx = otid(), bidx = obid(), gdim = ogdim();
    const int lane = tidx & 63, wave = tidx >> 6;
    float eps_ = 1e-6f; asm volatile("" : "+v"(eps_));
    float4 gyv[4], gnv[4];
#pragma unroll
    for (int j = 0; j < 4; ++j) { if (HAS_Y) gyv[j] = ((const float4*)gy)[lane + 64 * j]; if (HAS_H) gnv[j] = ((const float4*)gn)[lane + 64 * j]; }
#pragma unroll 1
    for (int row0 = (bidx * 8 + wave) * 4; row0 < T; row0 += gdim * 32) {
        const int b = row0 / SEQ;
        const float* m = mod_l + (size_t)b * 6 * D;
        float4 v[4][4], yv[4][4], gt[4], sc[4], sh[4];
#pragma unroll
        for (int r = 0; r < 4; ++r)
#pragma unroll
            for (int j = 0; j < 4; ++j) {
                v[r][j] = ((const float4*)(xin + (size_t)(row0 + r) * D))[lane + 64 * j];
                if (HAS_Y) { const uint2 yb_ = nt_load8((const uint2*)(y + (size_t)(row0 + r) * D) + lane + 64 * j);
                    yv[r][j] = make_float4(__uint_as_float(yb_.x << 16), __uint_as_float(yb_.x & 0xffff0000u), __uint_as_float(yb_.y << 16), __uint_as_float(yb_.y & 0xffff0000u)); }
            }
#pragma unroll
        for (int j = 0; j < 4; ++j) {
            if (HAS_Y) gt[j] = ((const float4*)(gate_base + (size_t)b * 6 * D))[lane + 64 * j];
            if (HAS_H) { sc[j] = ((const float4*)(m + sc_idx * D))[lane + 64 * j]; sh[j] = ((const float4*)(m + sh_idx * D))[lane + 64 * j]; }
        }
#pragma unroll
        for (int r = 0; r < 4; ++r) {
            const int row = row0 + r;
            if (HAS_Y) {
                const float rs = rsqrtf(wave_sum_fast((sq4(yv[r][0]) + sq4(yv[r][1])) + (sq4(yv[r][2]) + sq4(yv[r][3]))) * (1.f / D) + eps_);
#pragma unroll
                for (int j = 0; j < 4; ++j) {
                    v[r][j].x += gt[j].x * yv[r][j].x * rs * gyv[j].x; v[r][j].y += gt[j].y * yv[r][j].y * rs * gyv[j].y;
                    v[r][j].z += gt[j].z * yv[r][j].z * rs * gyv[j].z; v[r][j].w += gt[j].w * yv[r][j].w * rs * gyv[j].w;
                    ((float4*)(xout + (size_t)row * D))[lane + 64 * j] = v[r][j];
                }
            }
            if (HAS_H) {
                const float rs = rsqrtf(wave_sum_fast((sq4(v[r][0]) + sq4(v[r][1])) + (sq4(v[r][2]) + sq4(v[r][3]))) * (1.f / D) + eps_);
#pragma unroll
                for (int j = 0; j < 4; ++j) {
                    float4 o;
                    o.x = v[r][j].x * rs * gnv[j].x * (1.f + sc[j].x) + sh[j].x; o.y = v[r][j].y * rs * gnv[j].y * (1.f + sc[j].y) + sh[j].y;
                    o.z = v[r][j].z * rs * gnv[j].z * (1.f + sc[j].z) + sh[j].z; o.w = v[r][j].w * rs * gnv[j].w * (1.f + sc[j].w) + sh[j].w;
                    ((uint2*)(hb + (size_t)row * D))[lane + 64 * j] = make_uint2(pk2(o.x, o.y), pk2(o.z, o.w));
                }
            }
        }
    }
}

__device__ __forceinline__ int t5_bucket(int n) {
    if (n < 16) return n;
    int large = 16 + (int)(logf((float)n / 16.f) / logf(8.f) * 16.f);
    return large < 31 ? large : 31;
}
constexpr int BT_OFF = LDS_BYTES - 6144;
typedef float f32x16 __attribute__((ext_vector_type(16)));
typedef short bf16x8_t __attribute__((ext_vector_type(8)));
typedef short s16x4_t __attribute__((ext_vector_type(4)));
__device__ __forceinline__ unsigned cvtpk(float lo, float hi) { return pk2(lo, hi); }
#define ATT_C 0.18033688011112042f
template <bool NEAR>
__device__ __forceinline__ void att_scores(f32x16& x, const float* bt_h, int qrow, int kvb) {
#pragma unroll
    for (int r = 0; r < 16; ++r) {
        float v = x[r];
        if (NEAR) { const int dist = qrow - (kvb + (r & 3) + 8 * (r >> 2)); v += bt_h[dist < 0 ? 0 : (dist > 127 ? 127 : dist)]; if (dist < 0) v = -INFINITY; }
        x[r] = v;
    }
}

__device__ __forceinline__ void lc_dma16(const void* gsrc, unsigned lds_dst) { unsigned keep;
    asm volatile("s_mov_b32 %0, m0\n\ts_mov_b32 m0, %2\n\ts_nop 0\n\tglobal_load_lds_dwordx4 %1, off\n\ts_mov_b32 m0, %0" : "=&s"(keep) : "v"(gsrc), "s"(lds_dst) : "memory"); }
__device__ __forceinline__ void lc_dma4(const void* gsrc, unsigned lds_dst) { unsigned keep;
    asm volatile("s_mov_b32 %0, m0\n\ts_mov_b32 m0, %2\n\ts_nop 0\n\tglobal_load_lds_dword %1, off\n\ts_mov_b32 m0, %0" : "=&s"(keep) : "v"(gsrc), "s"(lds_dst) : "memory"); }
constexpr int ATT_MAXN = 3;
__device__ const unsigned short att_list[256 * ATT_MAXN] = {
2, 65535, 65535,
18, 65535, 65535,
34, 65535, 65535,
50, 65535, 65535,
66, 65535, 65535,
82, 65535, 65535,
98, 65535, 65535,
114, 65535, 65535,
130, 65535, 65535,
146, 65535, 65535,
162, 65535, 65535,
178, 65535, 65535,
194, 65535, 65535,
210, 65535, 65535,
226, 65535, 65535,
242, 65535, 65535,
258, 65535, 65535,
274, 65535, 65535,
290, 65535, 65535,
306, 65535, 65535,
322, 65535, 65535,
338, 65535, 65535,
354, 65535, 65535,
370, 65535, 65535,
386, 65535, 65535,
402, 65535, 65535,
418, 65535, 65535,
434, 65535, 65535,
450, 65535, 65535,
466, 65535, 65535,
482, 65535, 65535,
498, 65535, 65535,
15, 1, 0,
31, 17, 16,
47, 33, 32,
63, 49, 48,
79, 65, 64,
95, 81, 80,
111, 97, 96,
127, 113, 112,
143, 129, 128,
159, 145, 144,
175, 161, 160,
191, 177, 176,
207, 193, 192,
223, 209, 208,
239, 225, 224,
255, 241, 240,
271, 257, 256,
287, 273, 272,
303, 289, 288,
319, 305, 304,
335, 321, 320,
351, 337, 336,
367, 353, 352,
383, 369, 368,
399, 385, 384,
415, 401, 400,
431, 417, 416,
447, 433, 432,
463, 449, 448,
479, 465, 464,
495, 481, 480,
511, 497, 496,
14, 3, 65535,
30, 19, 65535,
46, 35, 65535,
62, 51, 65535,
78, 67, 65535,
94, 83, 65535,
110, 99, 65535,
126, 115, 65535,
142, 131, 65535,
158, 147, 65535,
174, 163, 65535,
190, 179, 65535,
206, 195, 65535,
222, 211, 65535,
238, 227, 65535,
254, 243, 65535,
270, 259, 65535,
286, 275, 65535,
302, 291, 65535,
318, 307, 65535,
334, 323, 65535,
350, 339, 65535,
366, 355, 65535,
382, 371, 65535,
398, 387, 65535,
414, 403, 65535,
430, 419, 65535,
446, 435, 65535,
462, 451, 65535,
478, 467, 65535,
494, 483, 65535,
510, 499, 65535,
13, 5, 65535,
29, 21, 65535,
45, 37, 65535,
61, 53, 65535,
77, 69, 65535,
93, 85, 65535,
109, 101, 65535,
125, 117, 65535,
141, 133, 65535,
157, 149, 65535,
173, 165, 65535,
189, 181, 65535,
205, 197, 65535,
221, 213, 65535,
237, 229, 65535,
253, 245, 65535,
269, 261, 65535,
285, 277, 65535,
301, 293, 65535,
317, 309, 65535,
333, 325, 65535,
349, 341, 65535,
365, 357, 65535,
381, 373, 65535,
397, 389, 65535,
413, 405, 65535,
429, 421, 65535,
445, 437, 65535,
461, 453, 65535,
477, 469, 65535,
493, 485, 65535,
509, 501, 65535,
12, 4, 65535,
28, 20, 65535,
44, 36, 65535,
60, 52, 65535,
76, 68, 65535,
92, 84, 65535,
108, 100, 65535,
124, 116, 65535,
140, 132, 65535,
156, 148, 65535,
172, 164, 65535,
188, 180, 65535,
204, 196, 65535,
220, 212, 65535,
236, 228, 65535,
252, 244, 65535,
268, 260, 65535,
284, 276, 65535,
300, 292, 65535,
316, 308, 65535,
332, 324, 65535,
348, 340, 65535,
364, 356, 65535,
380, 372, 65535,
396, 388, 65535,
412, 404, 65535,
428, 420, 65535,
444, 436, 65535,
460, 452, 65535,
476, 468, 65535,
492, 484, 65535,
508, 500, 65535,
11, 6, 65535,
27, 22, 65535,
43, 38, 65535,
59, 54, 65535,
75, 70, 65535,
91, 86, 65535,
107, 102, 65535,
123, 118, 65535,
139, 134, 65535,
155, 150, 65535,
171, 166, 65535,
187, 182, 65535,
203, 198, 65535,
219, 214, 65535,
235, 230, 65535,
251, 246, 65535,
267, 262, 65535,
283, 278, 65535,
299, 294, 65535,
315, 310, 65535,
331, 326, 65535,
347, 342, 65535,
363, 358, 65535,
379, 374, 65535,
395, 390, 65535,
411, 406, 65535,
427, 422, 65535,
443, 438, 65535,
459, 454, 65535,
475, 470, 65535,
491, 486, 65535,
507, 502, 65535,
10, 7, 65535,
26, 23, 65535,
42, 39, 65535,
58, 55, 65535,
74, 71, 65535,
90, 87, 65535,
106, 103, 65535,
122, 119, 65535,
138, 135, 65535,
154, 151, 65535,
170, 167, 65535,
186, 183, 65535,
202, 199, 65535,
218, 215, 65535,
234, 231, 65535,
250, 247, 65535,
266, 263, 65535,
282, 279, 65535,
298, 295, 65535,
314, 311, 65535,
330, 327, 65535,
346, 343, 65535,
362, 359, 65535,
378, 375, 65535,
394, 391, 65535,
410, 407, 65535,
426, 423, 65535,
442, 439, 65535,
458, 455, 65535,
474, 471, 65535,
490, 487, 65535,
506, 503, 65535,
9, 8, 65535,
25, 24, 65535,
41, 40, 65535,
57, 56, 65535,
73, 72, 65535,
89, 88, 65535,
105, 104, 65535,
121, 120, 65535,
137, 136, 65535,
153, 152, 65535,
169, 168, 65535,
185, 184, 65535,
201, 200, 65535,
217, 216, 65535,
233, 232, 65535,
249, 248, 65535,
265, 264, 65535,
281, 280, 65535,
297, 296, 65535,
313, 312, 65535,
329, 328, 65535,
345, 344, 65535,
361, 360, 65535,
377, 376, 65535,
393, 392, 65535,
409, 408, 65535,
425, 424, 65535,
441, 440, 65535,
457, 456, 65535,
473, 472, 65535,
489, 488, 65535,
505, 504, 65535};
__device__ __forceinline__ void attn_flash(unsigned char* ldsb, const bf16* proj, const float* lam_par, const float* subln, float lambda_init, bf16* mix, int bidx, int gdim) {
    const int wave = owave(), qg = wave >> 1, kh = wave & 1;
    float* stat = (float*)(ldsb + 98304);
    float* asc = (float*)(ldsb + 102400) + wave * 64;
    float* ftab = (float*)(ldsb + 104448) + wave * 64;
#pragma unroll 1
    for (int u = bidx; u < 256; u += gdim) {
#pragma unroll 1
        for (int half = 0; half < ATT_MAXN; ++half) {
            int code = gdim == 256 ? (int)att_list[u * ATT_MAXN + half] : (half == 0 ? (u >> 3) * 16 + 15 - (u & 7) : half == 1 ? (u >> 3) * 16 + (u & 7) : 0xffff); code = __builtin_amdgcn_readfirstlane(code);
            if (code == 0xffff) continue;
            const int b = code >> 6, h = (code >> 4) & 3;
            const float* bt_h = (const float*)(ldsb + BT_OFF) + h * 128;
            const int lane = olane(), lq = lane & 31, hi = lane >> 5;
            const int vtr = (4 * hi + ((lane & 15) >> 2)) * 64 + (16 * ((lane >> 4) & 1) + 4 * (lane & 3)) * 2;
            const int qb = code & 15, R0 = qb * 128, r0 = R0 + 32 * qg, ntile = 2 * qb + 2, qrow = r0 + lq;
            const char* kbase = (const char*)(proj + (size_t)(b * SEQ) * IN_COLS + A_WIDTH + h * 128);
            { const char* qb_ = (const char*)(proj + (size_t)(b * SEQ + r0) * IN_COLS + h * 128); const unsigned qo = (unsigned)(lq * IN_COLS + 8 * hi) * 2u;
#pragma unroll
              for (int m = 0; m < 2; ++m)
#pragma unroll
                  for (int s4 = 0; s4 < 4; ++s4) {
                      const uint4 qw = *(const uint4*)(qb_ + qo + (m * 64 + 16 * s4) * 2);
                      const unsigned qq[4] = {qw.x, qw.y, qw.z, qw.w}; union { unsigned u[4]; bf16x8_t v; } qs;
#pragma unroll
                      for (int w = 0; w < 4; ++w) qs.u[w] = cvtpk(__uint_as_float(qq[w] << 16) * ATT_C, __uint_as_float(qq[w] & 0xffff0000u) * ATT_C);
                      *(bf16x8_t*)(ldsb + 106496 + ((qg * 8 + m * 4 + s4) * 64 + lane) * 16) = qs.v; } }
            unsigned ksrc[2], vsrc[2];
#pragma unroll
            for (int i = 0; i < 2; ++i) {
                const int p = wave * 64 + i * 512 + lane, row = p >> 4, c = (p & 15) ^ (row & 15);
                ksrc[i] = (unsigned)(row * IN_COLS * 2 + c * 16);
                const int o = p * 16, eb = o >> 12, ks = (o >> 10) & 3, sub = (o >> 9) & 1, r8 = (o >> 6) & 7, c16 = (o >> 4) & 3, kv = ks * 16 + sub * 8 + r8, sc = eb * 4 + c16;
                vsrc[i] = (unsigned)(kv * IN_COLS * 2 + 1024 + sc * 16);
            }
#define ATT_DMA(kt, bufp) do { _Pragma("unroll") for (int i_ = 0; i_ < 2; ++i_) { \
                lc_dma16((kt) + ksrc[i_], (unsigned)__builtin_amdgcn_readfirstlane((int)(unsigned)(uintptr_t)((bufp) + (wave * 64 + i_ * 512) * 16))); \
                lc_dma16((kt) + vsrc[i_], (unsigned)__builtin_amdgcn_readfirstlane((int)(unsigned)(uintptr_t)((bufp) + 16384 + (wave * 64 + i_ * 512) * 16))); } } while (0)
            float m1 = -1e30f, l1 = 0.f, m2 = -1e30f, l2 = 0.f;
            f32x16 o1[4], o2[4];
#pragma unroll
            for (int e = 0; e < 4; ++e)
#pragma unroll
                for (int r = 0; r < 16; ++r) { o1[e][r] = 0.f; o2[e][r] = 0.f; }
            __syncthreads();
            ATT_DMA(kbase, ldsb);
            ATT_DMA(kbase + (size_t)64 * IN_COLS * 2, ldsb + 32768);
            asm volatile("s_waitcnt vmcnt(4)" ::: "memory");
            __syncthreads();
            int bcur = 0;
#pragma unroll 1
            for (int j = 0; j < ntile; ++j) {
                unsigned char* buf = ldsb + bcur * 32768;
                const int bnn = bcur == 0 ? 2 : bcur - 1;
                const bool more = j + 2 < ntile;
                if (more) ATT_DMA(kbase + (size_t)(64 * (j + 2)) * IN_COLS * 2, ldsb + bnn * 32768);
                bcur = bcur == 2 ? 0 : bcur + 1;
                const int kv0 = 64 * j + 32 * kh;
                if (kv0 <= r0 + 31) {
                    f32x16 st1, st2;
#pragma unroll
                    for (int r = 0; r < 16; ++r) { st1[r] = 0.f; st2[r] = 0.f; }
                    const int krow = 32 * kh + lq;
#pragma unroll
                    for (int s4 = 0; s4 < 4; ++s4) {
                        const bf16x8_t a1 = *(const bf16x8_t*)(buf + krow * 256 + (((2 * s4 + hi) ^ (krow & 15)) << 4));
                        const bf16x8_t a2 = *(const bf16x8_t*)(buf + krow * 256 + (((8 + 2 * s4 + hi) ^ (krow & 15)) << 4));
                        const bf16x8_t q1 = *(const bf16x8_t*)(ldsb + 106496 + ((qg * 8 + s4) * 64 + lane) * 16), q2 = *(const bf16x8_t*)(ldsb + 106496 + ((qg * 8 + 4 + s4) * 64 + lane) * 16);
                        st1 = __builtin_amdgcn_mfma_f32_32x32x16_bf16(a1, q1, st1, 0, 0, 0);
                        st2 = __builtin_amdgcn_mfma_f32_32x32x16_bf16(a2, q2, st2, 0, 0, 0);
                    }
                    const int kvb = kv0 + 4 * hi;
                    if (kv0 + 31 + 113 > r0) { att_scores<true>(st1, bt_h, qrow, kvb); att_scores<true>(st2, bt_h, qrow, kvb); }
                    else { att_scores<false>(st1, bt_h, qrow, kvb); att_scores<false>(st2, bt_h, qrow, kvb); }
                    float t1 = st1[0], t2 = st2[0];
#pragma unroll
                    for (int r = 1; r < 16; ++r) { t1 = fmaxf(t1, st1[r]); t2 = fmaxf(t2, st2[r]); }
                    { const auto ra = __builtin_amdgcn_permlane32_swap(__float_as_uint(t1), __float_as_uint(t1), false, false); t1 = fmaxf(__uint_as_float(ra[0]), __uint_as_float(ra[1]));
                      const auto rb = __builtin_amdgcn_permlane32_swap(__float_as_uint(t2), __float_as_uint(t2), false, false); t2 = fmaxf(__uint_as_float(rb[0]), __uint_as_float(rb[1])); }
                    if (__builtin_amdgcn_ballot_w64(t1 > m1 + 8.f || t2 > m2 + 8.f) != 0ull) {
                        const float n1 = fmaxf(m1, t1), n2 = fmaxf(m2, t2);
                        const float a1 = __builtin_amdgcn_exp2f(m1 - n1), a2 = __builtin_amdgcn_exp2f(m2 - n2);
                        l1 *= a1; l2 *= a2; m1 = n1; m2 = n2;
#pragma unroll
                        for (int e = 0; e < 4; ++e)
#pragma unroll
                            for (int r = 0; r < 16; ++r) { o1[e][r] *= a1; o2[e][r] *= a2; }
                    }
                    const unsigned char* vb = buf + 16384 + vtr + (2 * kh) * 1024;
#define ATT_PV(ST, MREF, LSUM, OACC) do { float s_ = 0.f; \
                        _Pragma("unroll") for (int r = 0; r < 16; ++r) { ST[r] = __builtin_amdgcn_exp2f(ST[r] - MREF); s_ += ST[r]; } \
                        LSUM += s_; \
                        _Pragma("unroll") for (int s2i = 0; s2i < 2; ++s2i) { \
                            union { unsigned u[4]; bf16x8_t v; } pa; \
                            _Pragma("unroll") for (int w = 0; w < 4; ++w) pa.u[w] = cvtpk(ST[8 * s2i + 2 * w], ST[8 * s2i + 2 * w + 1]); \
                            _Pragma("unroll") for (int e = 0; e < 4; ++e) { \
                                const s16x4_t lo = __builtin_bit_cast(s16x4_t, __builtin_amdgcn_ds_read_tr16_b64_v4i16((__attribute__((address_space(3))) s16x4_t*)(unsigned)(uintptr_t)(vb + e * 4096 + s2i * 1024))); \
                                const s16x4_t hh = __builtin_bit_cast(s16x4_t, __builtin_amdgcn_ds_read_tr16_b64_v4i16((__attribute__((address_space(3))) s16x4_t*)(unsigned)(uintptr_t)(vb + e * 4096 + s2i * 1024 + 512))); \
                                const bf16x8_t bv = (bf16x8_t){lo[0], lo[1], lo[2], lo[3], hh[0], hh[1], hh[2], hh[3]}; \
                                OACC[e] = __builtin_amdgcn_mfma_f32_32x32x16_bf16(bv, pa.v, OACC[e], 0, 0, 0);        \
                            } } } while (0)
                    ATT_PV(st1, m1, l1, o1);
                    ATT_PV(st2, m2, l2, o2);
#undef ATT_PV
                }
                if (more) asm volatile("s_waitcnt vmcnt(4)" ::: "memory"); else asm volatile("s_waitcnt vmcnt(0)" ::: "memory");
                __syncthreads();
            }
            { const auto ra = __builtin_amdgcn_permlane32_swap(__float_as_uint(l1), __float_as_uint(l1), false, false); l1 = __uint_as_float(ra[0]) + __uint_as_float(ra[1]);
              const auto rb = __builtin_amdgcn_permlane32_swap(__float_as_uint(l2), __float_as_uint(l2), false, false); l2 = __uint_as_float(rb[0]) + __uint_as_float(rb[1]); }
            if (hi == 0) ((float4*)stat)[wave * 32 + lq] = make_float4(m1, l1, m2, l2);
            __syncthreads();
            float lam;
            { float l01 = lam_par[lane] * lam_par[64 + lane], l23 = lam_par[128 + lane] * lam_par[192 + lane];
              l01 = wave_sum_fast(l01); l23 = wave_sum_fast(l23); lam = __expf(l01) - __expf(l23) + lambda_init; }
            {
                const float4 pb = ((const float4*)stat)[(wave ^ 1) * 32 + lq];
                const float M1 = fmaxf(m1, pb.x), M2 = fmaxf(m2, pb.z);
                const float e1 = __builtin_amdgcn_exp2f(m1 - M1), e2 = __builtin_amdgcn_exp2f(m2 - M2);
                const float L1 = l1 * e1 + pb.y * __builtin_amdgcn_exp2f(pb.x - M1), L2 = l2 * e2 + pb.w * __builtin_amdgcn_exp2f(pb.z - M2);
                const float F1 = e1 / L1, F2 = -lam * e2 / L2;
#pragma unroll
                for (int e = 0; e < 4; ++e)
#pragma unroll
                    for (int r = 0; r < 16; ++r) o1[e][r] = o1[e][r] * F1 + o2[e][r] * F2;
            }
            __syncthreads();
            float* ox = (float*)ldsb;
            if (kh == 1) {
#pragma unroll
                for (int e = 0; e < 4; ++e)
#pragma unroll
                    for (int r = 0; r < 16; ++r) ox[((qg * 4 + e) * 16 + r) * 64 + lane] = o1[e][r];
            }
            __syncthreads();
            if (kh == 0) {
                float ssq = 0.f;
#pragma unroll
                for (int e = 0; e < 4; ++e)
#pragma unroll
                    for (int r = 0; r < 16; ++r) { o1[e][r] += ox[((qg * 4 + e) * 16 + r) * 64 + lane]; ssq += o1[e][r] * o1[e][r]; }
                { const auto rs_ = __builtin_amdgcn_permlane32_swap(__float_as_uint(ssq), __float_as_uint(ssq), false, false); ssq = __uint_as_float(rs_[0]) + __uint_as_float(rs_[1]); }
                const float sc = rsqrtf(ssq * (1.f / 128.f) + 1e-6f) * (1.f - lambda_init);
                const int ln = olane(), lq2 = ln & 31, hi2 = ln >> 5;
                char* mb_ = (char*)(mix + (size_t)(b * SEQ + r0 + lq2) * D + h * 128);
#pragma unroll
                for (int e = 0; e < 4; ++e)
#pragma unroll
                    for (int p = 0; p < 2; ++p) {
                        const float4 ga = *(const float4*)(subln + e * 32 + 16 * p + 4 * hi2), gb = *(const float4*)(subln + e * 32 + 16 * p + 8 + 4 * hi2);
                        unsigned ax = pk2(o1[e][8 * p] * sc * ga.x, o1[e][8 * p + 1] * sc * ga.y), ay = pk2(o1[e][8 * p + 2] * sc * ga.z, o1[e][8 * p + 3] * sc * ga.w);
                        unsigned bx = pk2(o1[e][8 * p + 4] * sc * gb.x, o1[e][8 * p + 5] * sc * gb.y), by = pk2(o1[e][8 * p + 6] * sc * gb.z, o1[e][8 * p + 7] * sc * gb.w);
                        { const auto r0_ = __builtin_amdgcn_permlane32_swap(ax, bx, false, false); ax = r0_[0]; bx = r0_[1];
                          const auto r1_ = __builtin_amdgcn_permlane32_swap(ay, by, false, false); ay = r1_[0]; by = r1_[1]; }
                        *(uint4*)(mb_ + (e * 32 + 16 * p + (hi2 ? 8 : 0)) * 2) = make_uint4(ax, ay, bx, by);
                    }
            }
        }
    }
#undef ATT_DMA
#undef VDST
}

typedef float f32x4_t __attribute__((ext_vector_type(4)));
constexpr int PL_STRIDE = 1536 + 16, AL_STRIDE = 512 + 16;
constexpr int PREP_PL = 0, PREP_AL = 64 * PL_STRIDE, PREP_KS = PREP_AL + 64 * AL_STRIDE;
__device__ __forceinline__ void rwkv_prep_phase(unsigned char* ldsb, const bf16* proj, const float* mu, const float* w0, const bf16* w2T, const float* a0, const bf16* a2T, const bf16* g2T,
                                                const float* k_k, const float* k_a, float* RW) {
    const int tidx = otid(), bidx = obid(), gdim = ogdim();
    const int wave = tidx >> 6, lane = tidx & 63, fr = lane & 15, fq = lane >> 4;
    constexpr size_t AS = (size_t)T * 256;
#pragma unroll 1
    for (int u = bidx; u < T / 64; u += gdim) {
        const int t0 = u * 64;
        __syncthreads();
#pragma unroll 8
        for (int i = 0; i < 16; ++i) {
            const int id = tidx + 512 * i, tok = id >> 7, cc = (id & 127) ^ ((tidx & 256) >> 2), c = cc * 8, t = t0 + tok;
            const bf16* src = proj + (size_t)t * IN_COLS + A_COLS + c;
            const uint4 cu = *(const uint4*)src;
            uint4 pv = make_uint4(0u, 0u, 0u, 0u);
            if ((t & (SEQ - 1)) != 0) pv = *(const uint4*)(src - IN_COLS);
            const float4 m0 = *(const float4*)(mu + c), m1 = *(const float4*)(mu + c + 4);
            const unsigned cw[4] = {cu.x, cu.y, cu.z, cu.w}, pw[4] = {pv.x, pv.y, pv.z, pv.w};
            const float mm[8] = {m0.x, m0.y, m0.z, m0.w, m1.x, m1.y, m1.z, m1.w};
            float p[8];
#pragma unroll
            for (int j = 0; j < 4; ++j) {
                const float c0 = __uint_as_float(cw[j] << 16), c1 = __uint_as_float(cw[j] & 0xffff0000u), p0 = __uint_as_float(pw[j] << 16), p1 = __uint_as_float(pw[j] & 0xffff0000u);
                p[2 * j] = c0 + (p0 - c0) * mm[2 * j]; p[2 * j + 1] = c1 + (p1 - c1) * mm[2 * j + 1];
            }
            unsigned char* dst;
            if (c < 768) dst = ldsb + PREP_PL + tok * PL_STRIDE + c * 2;
            else {
                dst = ldsb + PREP_AL + tok * AL_STRIDE + (c - 768) * 2;
                if (c < 832) {
#pragma unroll
                    for (int j = 0; j < 8; ++j) { const float e2 = __expf(2.f * p[j]); p[j] = 1.f - 2.f * __builtin_amdgcn_rcpf(e2 + 1.f); }
                } else if (c >= 896) {
#pragma unroll
                    for (int j = 0; j < 8; ++j) p[j] = __builtin_amdgcn_rcpf(1.f + __expf(-p[j]));
                }
            }
            *(uint4*)dst = make_uint4(pk2(p[0], p[1]), pk2(p[2], p[3]), pk2(p[4], p[5]), pk2(p[6], p[7]));
        }
        __syncthreads();
        if (tidx < 256) {
            const int tok = tidx >> 2, hd = tidx & 3;
            const unsigned char* kp = ldsb + PREP_PL + tok * PL_STRIDE + (256 + hd * 64) * 2;
            float ss = 0.f;
#pragma unroll 4
            for (int j = 0; j < 64; j += 2) { const unsigned w = *(const unsigned*)(kp + j * 2); const float2 kk2 = *(const float2*)(k_k + hd * 64 + j);
                const float x0 = __uint_as_float(w << 16) * kk2.x, x1 = __uint_as_float(w & 0xffff0000u) * kk2.y; ss += x0 * x0 + x1 * x1; }
            ((float*)(ldsb + PREP_KS))[tok * 4 + hd] = ss;
        }
        __syncthreads();
        const int n0 = wave * 32, hd = wave >> 1;
        bf16x8_t bw[2][2], ba[2][2], bg[2][4];
#pragma unroll
        for (int ct = 0; ct < 2; ++ct) {
            const int n = n0 + 16 * ct + fr;
#pragma unroll
            for (int ks = 0; ks < 2; ++ks) { bw[ct][ks] = *(const bf16x8_t*)(w2T + n * 64 + 32 * ks + 8 * fq); ba[ct][ks] = *(const bf16x8_t*)(a2T + n * 64 + 32 * ks + 8 * fq); }
#pragma unroll
            for (int ks = 0; ks < 4; ++ks) bg[ct][ks] = *(const bf16x8_t*)(g2T + n * 128 + 32 * ks + 8 * fq);
        }
        float4 w04[2], a04[2], kk4[2], ka4[2];
#pragma unroll
        for (int ct = 0; ct < 2; ++ct) { const int ch0 = n0 + 16 * ct + 4 * fq; w04[ct] = *(const float4*)(w0 + ch0); a04[ct] = *(const float4*)(a0 + ch0); kk4[ct] = *(const float4*)(k_k + ch0); ka4[ct] = *(const float4*)(k_a + ch0); }
#pragma unroll 1
        for (int rt = 0; rt < 4; ++rt) {
            const unsigned char* ar = ldsb + PREP_AL + (16 * rt + fr) * AL_STRIDE + 16 * fq;
            bf16x8_t af[8];
#pragma unroll
            for (int ks = 0; ks < 8; ++ks) af[ks] = *(const bf16x8_t*)(ar + 64 * ks);
#pragma unroll
            for (int ct = 0; ct < 2; ++ct) {
                f32x4_t cw_ = {0.f, 0.f, 0.f, 0.f}, ca_ = {0.f, 0.f, 0.f, 0.f}, cg_ = {0.f, 0.f, 0.f, 0.f};
#pragma unroll
                for (int ks = 0; ks < 2; ++ks) { cw_ = __builtin_amdgcn_mfma_f32_16x16x32_bf16(bw[ct][ks], af[ks], cw_, 0, 0, 0); ca_ = __builtin_amdgcn_mfma_f32_16x16x32_bf16(ba[ct][ks], af[2 + ks], ca_, 0, 0, 0); }
#pragma unroll
                for (int ks = 0; ks < 4; ++ks) cg_ = __builtin_amdgcn_mfma_f32_16x16x32_bf16(bg[ct][ks], af[4 + ks], cg_, 0, 0, 0);
                const int ch0 = n0 + 16 * ct + 4 * fq, tok = 16 * rt + fr;
                const float w0c[4] = {w04[ct].x, w04[ct].y, w04[ct].z, w04[ct].w}, a0c[4] = {a04[ct].x, a04[ct].y, a04[ct].z, a04[ct].w}, kkc[4] = {kk4[ct].x, kk4[ct].y, kk4[ct].z, kk4[ct].w}, kac[4] = {ka4[ct].x, ka4[ct].y, ka4[ct].z, ka4[ct].w};
                const unsigned char* pr = ldsb + PREP_PL + tok * PL_STRIDE + ch0 * 2;
                const uint2 r2 = *(const uint2*)pr, k2 = *(const uint2*)(pr + 512), v2 = *(const uint2*)(pr + 1024);
                const float rr[4] = {__uint_as_float(r2.x << 16), __uint_as_float(r2.x & 0xffff0000u), __uint_as_float(r2.y << 16), __uint_as_float(r2.y & 0xffff0000u)};
                const float kq[4] = {__uint_as_float(k2.x << 16), __uint_as_float(k2.x & 0xffff0000u), __uint_as_float(k2.y << 16), __uint_as_float(k2.y & 0xffff0000u)};
                const float vq[4] = {__uint_as_float(v2.x << 16), __uint_as_float(v2.x & 0xffff0000u), __uint_as_float(v2.y << 16), __uint_as_float(v2.y & 0xffff0000u)};
                const float rs = rsqrtf(fmaxf(((const float*)(ldsb + PREP_KS))[tok * 4 + hd], 1e-24f));
                float od[4], ok[4], oa[4], ob[4];
#pragma unroll
                for (int rg = 0; rg < 4; ++rg) {
                    const float zw = w0c[rg] + cw_[rg];
                    const float sp = (-zw > 20.f) ? -zw : __logf(1.f + __expf(-zw));
                    od[rg] = __expf(-__expf(-sp - 0.5f));
                    const float a = __builtin_amdgcn_rcpf(1.f + __expf(-(a0c[rg] + ca_[rg])));
                    const float kk = kq[rg] * kkc[rg] * rs;
                    ok[rg] = kq[rg] * (1.f + (a - 1.f) * kac[rg]); oa[rg] = -kk; ob[rg] = kk * a;
                }
                float* o = RW + (size_t)(t0 + tok) * 256 + ch0;
                const size_t ob16 = (size_t)(t0 + tok) * 256 + ch0;
                *(uint2*)((bf16*)RW + ob16) = r2; *(float4*)(o + AS) = make_float4(od[0], od[1], od[2], od[3]); *(uint2*)((bf16*)(RW + 2 * AS) + ob16) = make_uint2(pk2(ok[0], ok[1]), pk2(ok[2], ok[3]));
                *(uint2*)((bf16*)(RW + 3 * AS) + ob16) = v2; *(uint2*)((bf16*)(RW + 4 * AS) + ob16) = make_uint2(pk2(oa[0], oa[1]), pk2(oa[2], oa[3])); *(uint2*)((bf16*)(RW + 5 * AS) + ob16) = make_uint2(pk2(ob[0], ob[1]), pk2(ob[2], ob[3]));
                *(uint2*)((bf16*)(RW + 6 * AS) + ob16) = make_uint2(pk2(cg_[0], cg_[1]), pk2(cg_[2], cg_[3]));
            }
        }
    }
}


template <int CTRL> __device__ __forceinline__ float dpp_f(float v) { return __int_as_float(__builtin_amdgcn_update_dpp(0, __float_as_int(v), CTRL, 0xF, 0xF, false)); }
constexpr int VT_STRIDE = 256 + 16;
__device__ __forceinline__ float gelu_fast(float x) { const float u = 1.5957691216057308f * (x + 0.044715f * x * x * x); return x / (1.f + __expf(-u)); }
__device__ __forceinline__ void gmlp_phase(unsigned char* ldsb, const bf16* proj, const float* ln_g, const float* ln_b, const bf16* wsb, const float* b_s, bf16* mix, int bidx, int gdim) {
    const int tidx = otid();
    const int wave = tidx >> 6, lane = tidx & 63, fr = lane & 15, fq = lane >> 4;
#pragma unroll 1
    for (int u = bidx; u < T / CHUNK; u += gdim) {
        const int t0 = u * CHUNK;
        __syncthreads();
        {
            const int tok = tidx >> 2, qd = tidx & 3;
            const bf16* pv = proj + (size_t)(t0 + tok) * IN_COLS + A_COLS + B_COLS + 256 + qd * 64;
            float s1 = 0.f, s2 = 0.f, gv_[64];
#pragma unroll
            for (int j = 0; j < 8; ++j) {
                const uint4 w = *(const uint4*)(pv + 8 * j);
                const unsigned ww[4] = {w.x, w.y, w.z, w.w};
#pragma unroll
                for (int i = 0; i < 4; ++i) { const float g0 = gelu_fast(__uint_as_float(ww[i] << 16)), g1 = gelu_fast(__uint_as_float(ww[i] & 0xffff0000u)); gv_[8 * j + 2 * i] = g0; gv_[8 * j + 2 * i + 1] = g1; s1 += g0 + g1; s2 += g0 * g0 + g1 * g1; }
            }
            s1 += dpp_f<0xB1>(s1); s1 += dpp_f<0x4E>(s1); s2 += dpp_f<0xB1>(s2); s2 += dpp_f<0x4E>(s2);
            const float mean = s1 * (1.f / 256.f), var = fmaxf(s2 * (1.f / 256.f) - mean * mean, 0.f), rstd = rsqrtf(var + 1e-5f);
#pragma unroll
            for (int j = 0; j < 8; ++j) {
#pragma unroll
                for (int i = 0; i < 4; ++i) {
                    const int ch = qd * 64 + 8 * j + 2 * i;
                    *(bf16*)(ldsb + ch * VT_STRIDE + tok * 2) = (bf16)f2bf((gv_[8 * j + 2 * i] - mean) * rstd * ln_g[ch] + ln_b[ch]);
                    *(bf16*)(ldsb + (ch + 1) * VT_STRIDE + tok * 2) = (bf16)f2bf((gv_[8 * j + 2 * i + 1] - mean) * rstd * ln_g[ch + 1] + ln_b[ch + 1]);
                }
            }
        }
        __syncthreads();
        const int rt = wave, nks = (16 * rt + 15) / 32 + 1;
#pragma unroll
        for (int g = 0; g < 4; ++g) {
            bf16x8_t af[4];
#pragma unroll
            for (int ks = 0; ks < 4; ++ks) if (ks < nks) af[ks] = *(const bf16x8_t*)(wsb + ((size_t)g * CHUNK + 16 * rt + fr) * CHUNK + 32 * ks + 8 * fq);
            const int t = t0 + 16 * rt + fr;
            const float bs1 = b_s[g * CHUNK + 16 * rt + fr];
            uint2 uw[4];
#pragma unroll
            for (int ct = 0; ct < 4; ++ct) uw[ct] = *(const uint2*)(proj + (size_t)t * IN_COLS + A_COLS + B_COLS + g * 64 + 16 * ct + 4 * fq);
#pragma unroll
            for (int ct = 0; ct < 4; ++ct) {
                const int ch = g * 64 + 16 * ct + fr;
                f32x4_t acc = {0.f, 0.f, 0.f, 0.f};
#pragma unroll
                for (int ks = 0; ks < 4; ++ks) if (ks < nks) {
                    const bf16x8_t bv = *(const bf16x8_t*)(ldsb + ch * VT_STRIDE + (32 * ks + 8 * fq) * 2);
                    acc = __builtin_amdgcn_mfma_f32_16x16x32_bf16(bv, af[ks], acc, 0, 0, 0);
                }
                const float o0 = gelu_fast(__uint_as_float(uw[ct].x << 16)) * (acc[0] + bs1), o1 = gelu_fast(__uint_as_float(uw[ct].x & 0xffff0000u)) * (acc[1] + bs1);
                const float o2 = gelu_fast(__uint_as_float(uw[ct].y << 16)) * (acc[2] + bs1), o3 = gelu_fast(__uint_as_float(uw[ct].y & 0xffff0000u)) * (acc[3] + bs1);
                *(uint2*)(mix + (size_t)t * D + A_WIDTH + B_WIDTH + g * 64 + 16 * ct + 4 * fq) = make_uint2(pk2(o0, o1), pk2(o2, o3));
            }
        }
    }
}

typedef float f32x4c __attribute__((ext_vector_type(4)));
constexpr size_t CK_M3 = 0, CK_N2 = 8192, CK_R2 = 16384, CK_Y2 = 18432, CK_G15 = 22528, CK_BYTES = 22784;
#define CK_SWZ0(q) ((((q) & ~7) + (((q) & 7) ^ (((q) >> 4) & 3))) * 16)
#define CK_SWZ1(q) ((((q) & ~7) + (((q) & 7) ^ (4 + (((q) >> 4) & 3)))) * 16)
__device__ __forceinline__ f32x4c mfma16(bf16x8_t a, bf16x8_t b, f32x4c c) { return __builtin_amdgcn_mfma_f32_16x16x32_bf16(a, b, c, 0, 0, 0); }
__device__ __forceinline__ bf16x8_t ldfrag(const unsigned char* p) { return *(const bf16x8_t*)p; }
constexpr int CP_RT = 0, CP_ATT = 2048, CP_VT = 4096, CP_BHT = 6144, CP_KHT = 8192, CP_AT = 10240, CP_BT = 12288, CP_KT = 14336, CP_G3I = 16384, CP_G4I = 16896, CP_WAVE = 17408;
constexpr int CP_LF = CP_AT, CP_TI = CP_AT + 1024, CP_LAKT = CP_AT + 1536, CP_CI = CP_LF;
constexpr int CP_PT = CP_BT, CP_QT = CP_KT;
__device__ __forceinline__ void chunk_prep(unsigned char* ldsb, const float* RW, unsigned char* CK, const float* r_k, float* bon) {
    const int wave = owave(), bidx = obid(), gdim = ogdim();
    unsigned char* L = ldsb + wave * CP_WAVE;
    constexpr size_t AS = (size_t)T * 256;
#define CP_DECODE(cid2v, cidv, basev) do { const int u_ = (cid2v) >> 4, wv_ = ((cid2v) >> 1) & 7, h_ = wv_ & 3, b_ = u_ >> 5, ch_ = (u_ & 31) * 4 + (wv_ >> 2) * 2 + ((cid2v) & 1); \
        cidv = (b_ * 4 + h_) * 128 + ch_; basev = RW + (size_t)(b_ * SEQ + ch_ * 16) * 256 + h_ * 64 + olane(); } while (0)
#define CP_LOAD(basev) do { const size_t eo_ = (size_t)((basev) - RW); _Pragma("unroll") for (int t = 0; t < 16; ++t) { \
        in_[t][0] = bf2f(((const bf16*)RW)[eo_ + (size_t)t * 256]); in_[t][3] = bf2f(((const bf16*)(RW + 3 * AS))[eo_ + (size_t)t * 256]); \
        in_[t][1] = (basev)[(size_t)t * 256 + AS]; in_[t][2] = bf2f(((const bf16*)(RW + 2 * AS))[eo_ + (size_t)t * 256]); in_[t][4] = bf2f(((const bf16*)(RW + 4 * AS))[eo_ + (size_t)t * 256]); in_[t][5] = bf2f(((const bf16*)(RW + 5 * AS))[eo_ + (size_t)t * 256]); } } while (0)
    float in_[16][6];
    int cid2 = bidx * 16 + wave * 2, cid = 0;
    if (cid2 >= BATCH * 4 * (SEQ / 16)) return;
    { const float* base0; CP_DECODE(cid2, cid, base0); CP_LOAD(base0); }
#pragma unroll 1
    for (;;) {
        const int lane = olane(), c = lane & 15, g = lane >> 4;
        unsigned char* ck = CK + (size_t)cid * CK_BYTES;
        float gam = 1.f, bt[16], kt[16], at[16], vt[16];
        const float rkj = r_k[(cid >> 7 & 3) * 64 + lane];
        float* bonp = bon + (size_t)((cid >> 9) * SEQ + (cid & 127) * 16) * 4 + (cid >> 7 & 3);
#pragma unroll
        for (int t = 0; t < 16; ++t) {
            const float r = in_[t][0], w = in_[t][1], k = in_[t][2], v = in_[t][3], a = in_[t][4], bb = in_[t][5];
            const float gp = gam; gam *= w;
            const float ig = __builtin_amdgcn_rcpf(gam);
            bt[t] = bb * ig; kt[t] = k * ig; at[t] = a * gp; vt[t] = v;
            { const float bs_ = wave_sum_fast(r * k * rkj); if (lane == 0) bonp[t * 4] = bs_; }
            *(bf16*)(L + CP_AT + t * 128 + lane * 2) = (bf16)f2bf(at[t]);
            *(bf16*)(L + CP_RT + t * 128 + lane * 2) = (bf16)f2bf(r * gam);
            *(bf16*)(L + CP_BT + t * 128 + lane * 2) = (bf16)f2bf(bt[t]);
            *(bf16*)(L + CP_KT + t * 128 + lane * 2) = (bf16)f2bf(kt[t]);
        }
#pragma unroll
        for (int hf = 0; hf < 2; ++hf) {
            *(uint4*)(L + CP_ATT + lane * 32 + hf * 16) = make_uint4(pk2(at[8 * hf], at[8 * hf + 1]), pk2(at[8 * hf + 2], at[8 * hf + 3]), pk2(at[8 * hf + 4], at[8 * hf + 5]), pk2(at[8 * hf + 6], at[8 * hf + 7]));
            *(uint4*)(L + CP_VT + lane * 32 + hf * 16) = make_uint4(pk2(vt[8 * hf], vt[8 * hf + 1]), pk2(vt[8 * hf + 2], vt[8 * hf + 3]), pk2(vt[8 * hf + 4], vt[8 * hf + 5]), pk2(vt[8 * hf + 6], vt[8 * hf + 7]));
            *(uint4*)(L + CP_BHT + lane * 32 + hf * 16) = make_uint4(pk2(bt[8 * hf] * gam, bt[8 * hf + 1] * gam), pk2(bt[8 * hf + 2] * gam, bt[8 * hf + 3] * gam), pk2(bt[8 * hf + 4] * gam, bt[8 * hf + 5] * gam), pk2(bt[8 * hf + 6] * gam, bt[8 * hf + 7] * gam));
            *(uint4*)(L + CP_KHT + lane * 32 + hf * 16) = make_uint4(pk2(kt[8 * hf] * gam, kt[8 * hf + 1] * gam), pk2(kt[8 * hf + 2] * gam, kt[8 * hf + 3] * gam), pk2(kt[8 * hf + 4] * gam, kt[8 * hf + 5] * gam), pk2(kt[8 * hf + 6] * gam, kt[8 * hf + 7] * gam));
        }
        *(float*)(ck + CK_G15 + lane * 4) = gam;
        const int nxt2 = cid2 + ((cid2 & 1) ? gdim * 16 - 1 : 1); const bool more = nxt2 < BATCH * 4 * (SEQ / 16); int ncid = 0;
        if (more) { const float* basen; CP_DECODE(nxt2, ncid, basen); CP_LOAD(basen); }
        asm volatile("s_waitcnt lgkmcnt(0)" ::: "memory");
        const int kq2 = g & 1;
        const bf16x8_t zero8 = {0, 0, 0, 0, 0, 0, 0, 0};
        {
            f32x4c g1 = {0.f, 0.f, 0.f, 0.f}, g2 = g1, g3 = g1, g4 = g1;
#pragma unroll
            for (int ks = 0; ks < 2; ++ks) {
                const int ko = (32 * ks + 8 * g) * 2;
                const bf16x8_t xa = ldfrag(L + CP_AT + c * 128 + ko), xr = ldfrag(L + CP_RT + c * 128 + ko), yb = ldfrag(L + CP_BT + c * 128 + ko), yk = ldfrag(L + CP_KT + c * 128 + ko);
                g1 = mfma16(xa, yb, g1); g2 = mfma16(xa, yk, g2); g3 = mfma16(xr, yb, g3); g4 = mfma16(xr, yk, g4);
            }
            asm volatile("s_waitcnt lgkmcnt(0)" ::: "memory");
            unsigned lk[2] = {0u, 0u};
#pragma unroll
            for (int rg = 0; rg < 4; ++rg) {
                const int t = 4 * g + rg;
                *(float*)(L + CP_LF + (t * 16 + c) * 4) = c < t ? g1[rg] : 0.f;
                const unsigned v2 = f2bf(c < t ? g2[rg] : 0.f); lk[rg >> 1] |= v2 << (16 * (rg & 1));
                *(bf16*)(L + CP_G3I + t * 32 + c * 2) = (bf16)f2bf(c <= t ? g3[rg] : 0.f);
                *(bf16*)(L + CP_G4I + t * 32 + c * 2) = (bf16)f2bf(c <= t ? g4[rg] : 0.f);
            }
            *(uint2*)(L + CP_LAKT + c * 32 + 4 * g * 2) = make_uint2(lk[0], lk[1]);
        }
        asm volatile("s_waitcnt lgkmcnt(0)" ::: "memory");
        {
            float tc[16];
#pragma unroll
            for (int t = 0; t < 16; ++t) {
                float acc = (t == c) ? 1.f : 0.f;
#pragma unroll
                for (int s4 = 0; s4 < t; s4 += 4) {
                    const float4 l4 = *(const float4*)(L + CP_LF + (t * 16 + s4) * 4);
                    acc += l4.x * tc[s4];
                    if (s4 + 1 < t) acc += l4.y * tc[s4 + 1];
                    if (s4 + 2 < t) acc += l4.z * tc[s4 + 2];
                    if (s4 + 3 < t) acc += l4.w * tc[s4 + 3];
                }
                tc[t] = acc;
                if (g == 0) *(bf16*)(L + CP_TI + t * 32 + c * 2) = (bf16)f2bf(acc);
            }
        }
        asm volatile("s_waitcnt lgkmcnt(0)" ::: "memory");
        const bf16x8_t aT = g < 2 ? ldfrag(L + CP_TI + c * 32 + 8 * g * 2) : zero8;
#pragma unroll
        for (int ct = 0; ct < 4; ++ct) {
            const f32x4c z = {0.f, 0.f, 0.f, 0.f};
            const f32x4c p = mfma16(aT, ldfrag(L + CP_ATT + (16 * ct + c) * 32 + 8 * kq2 * 2), z);
            *(uint2*)(L + CP_PT + (16 * ct + c) * 32 + 4 * g * 2) = make_uint2(pk2(p[0], p[1]), pk2(p[2], p[3]));
        }
        {
            const f32x4c z = {0.f, 0.f, 0.f, 0.f};
            const f32x4c cm = mfma16(aT, ldfrag(L + CP_LAKT + c * 32 + 8 * kq2 * 2), z);
#pragma unroll
            for (int rg = 0; rg < 4; ++rg) *(bf16*)(L + CP_CI + (4 * g + rg) * 32 + c * 2) = (bf16)f2bf(cm[rg]);
        }
        asm volatile("s_waitcnt lgkmcnt(0)" ::: "memory");
        {
            const bf16x8_t aC = g < 2 ? ldfrag(L + CP_CI + c * 32 + 8 * g * 2) : zero8;
#pragma unroll
            for (int ct = 0; ct < 4; ++ct) {
                const f32x4c z = {0.f, 0.f, 0.f, 0.f};
                const f32x4c q = mfma16(aC, ldfrag(L + CP_VT + (16 * ct + c) * 32 + 8 * kq2 * 2), z);
                *(uint2*)(L + CP_QT + (16 * ct + c) * 32 + 4 * g * 2) = make_uint2(pk2(q[0], q[1]), pk2(q[2], q[3]));
            }
        }
        asm volatile("s_waitcnt lgkmcnt(0)" ::: "memory");
        {
            const bf16x8_t aG3 = g < 2 ? ldfrag(L + CP_G3I + c * 32 + 8 * g * 2) : zero8;
            const bf16x8_t aG34 = g < 2 ? ldfrag(L + CP_G3I + c * 32 + 8 * g * 2) : ldfrag(L + CP_G4I + c * 32 + 8 * (g - 2) * 2);
#pragma unroll
            for (int ct = 0; ct < 4; ++ct) {
                f32x4c r2;
#pragma unroll
                for (int rg = 0; rg < 4; ++rg) r2[rg] = bf2f(*(const bf16*)(L + CP_RT + (4 * g + rg) * 128 + (16 * ct + c) * 2));
                r2 = mfma16(aG3, ldfrag(L + CP_PT + (16 * ct + c) * 32 + 8 * kq2 * 2), r2);
                const int pp = 32 * (ct >> 1) + 8 * (c >> 2) + 4 * (ct & 1) + (c & 3);
#pragma unroll
                for (int rg = 0; rg < 4; ++rg) *(bf16*)(L + CP_ATT + ((4 * g + rg) * 64 + pp) * 2) = (bf16)f2bf(r2[rg]);
                const bf16x8_t bqv = g < 2 ? ldfrag(L + CP_QT + (16 * ct + c) * 32 + 8 * g * 2) : ldfrag(L + CP_VT + (16 * ct + c) * 32 + 8 * (g - 2) * 2);
                const f32x4c z = {0.f, 0.f, 0.f, 0.f};
                const f32x4c y2 = mfma16(aG34, bqv, z);
                *(f32x4c*)(ck + CK_Y2 + (ct * 64 + lane) * 16) = y2;
            }
        }
        asm volatile("s_waitcnt lgkmcnt(0)" ::: "memory");
        { const uint4 v0 = *(const uint4*)(L + CP_ATT + lane * 16), v1 = *(const uint4*)(L + CP_ATT + 1024 + lane * 16);
          *(uint4*)(ck + CK_R2 + CK_SWZ0(lane)) = v0; *(uint4*)(ck + CK_R2 + 1024 + CK_SWZ1(lane)) = v1; }
        asm volatile("s_waitcnt lgkmcnt(0)" ::: "memory");
#pragma unroll 1
        for (int jt = 0; jt < 4; ++jt) {
            const bf16x8_t aB = g < 2 ? ldfrag(L + CP_BHT + (16 * jt + c) * 32 + 8 * g * 2) : zero8;
            const bf16x8_t aBK = g < 2 ? ldfrag(L + CP_BHT + (16 * jt + c) * 32 + 8 * g * 2) : ldfrag(L + CP_KHT + (16 * jt + c) * 32 + 8 * (g - 2) * 2);
#pragma unroll
            for (int ct = 0; ct < 4; ++ct) {
                const f32x4c z = {0.f, 0.f, 0.f, 0.f};
                const f32x4c m2 = mfma16(aB, ldfrag(L + CP_PT + (16 * ct + c) * 32 + 8 * kq2 * 2), z);
                const int pp = 32 * (ct >> 1) + 8 * (c >> 2) + 4 * (ct & 1) + (c & 3);
#pragma unroll
                for (int rg = 0; rg < 4; ++rg) *(bf16*)(L + CP_ATT + ((4 * g + rg) * 64 + pp) * 2) = (bf16)f2bf(m2[rg]);
                const bf16x8_t bqv = g < 2 ? ldfrag(L + CP_QT + (16 * ct + c) * 32 + 8 * g * 2) : ldfrag(L + CP_VT + (16 * ct + c) * 32 + 8 * (g - 2) * 2);
                const f32x4c n2 = mfma16(aBK, bqv, z);
                *(uint2*)(ck + CK_N2 + ((ct * 4 + jt) * 64 + lane) * 8) = make_uint2(pk2(n2[0], n2[1]), pk2(n2[2], n2[3]));
            }
            asm volatile("s_waitcnt lgkmcnt(0)" ::: "memory");
            { const uint4 v0 = *(const uint4*)(L + CP_ATT + lane * 16), v1 = *(const uint4*)(L + CP_ATT + 1024 + lane * 16);
              *(uint4*)(ck + CK_M3 + jt * 2048 + CK_SWZ0(lane)) = v0; *(uint4*)(ck + CK_M3 + jt * 2048 + 1024 + CK_SWZ1(lane)) = v1; }
            asm volatile("s_waitcnt lgkmcnt(0)" ::: "memory");
        }
        asm volatile("s_waitcnt lgkmcnt(0)" ::: "memory");
        if (!more) break;
        cid2 = nxt2; cid = ncid;
    }
#undef CP_DECODE
#undef CP_LOAD
}
struct CkOps { bf16x8_t am[4][2], ar[2]; f32x4c y; uint2 n2[4]; f32x4c g15[4]; };
__device__ __forceinline__ void ck_step(const CkOps& o, f32x4c (&hs)[4], float* yp, int ch, int g) {
    bf16x8_t hb[2];
#pragma unroll
    for (int ks = 0; ks < 2; ++ks) {
        union { unsigned u[4]; bf16x8_t v; } t_;
        t_.u[0] = cvtpk(hs[2 * ks][0], hs[2 * ks][1]); t_.u[1] = cvtpk(hs[2 * ks][2], hs[2 * ks][3]); t_.u[2] = cvtpk(hs[2 * ks + 1][0], hs[2 * ks + 1][1]); t_.u[3] = cvtpk(hs[2 * ks + 1][2], hs[2 * ks + 1][3]);
        hb[ks] = t_.v;
    }
    f32x4c y = mfma16(o.ar[0], hb[0], o.y); y = mfma16(o.ar[1], hb[1], y);
#pragma unroll
    for (int rg = 0; rg < 4; ++rg) yp[(size_t)(ch * 16 + 4 * g + rg) * 256] = y[rg];
#pragma unroll
    for (int jt = 0; jt < 4; ++jt) {
        f32x4c a = hs[jt] * o.g15[jt];
        a[0] += __uint_as_float(o.n2[jt].x << 16); a[1] += __uint_as_float(o.n2[jt].x & 0xffff0000u); a[2] += __uint_as_float(o.n2[jt].y << 16); a[3] += __uint_as_float(o.n2[jt].y & 0xffff0000u);
        a = mfma16(o.am[jt][0], hb[0], a); a = mfma16(o.am[jt][1], hb[1], a);
        hs[jt] = a;
    }
}


constexpr int LC_NS = 6, LC_SLOT = (int)CK_BYTES, LC_FLAGS = LC_NS * LC_SLOT;
static_assert(LC_FLAGS + 32 <= 147456 - 6144, "scan ring");
__device__ __forceinline__ void chunk_scan_lc(unsigned char* ldsb, const unsigned char* CK, float* Yout, int bh, int wv) {
    typedef volatile __attribute__((address_space(3))) unsigned vlds_u32;
    vlds_u32* flags = (vlds_u32*)(unsigned)(uintptr_t)(ldsb + LC_FLAGS);
    const unsigned ring = (unsigned)(uintptr_t)ldsb;
    const int lane = olane(), c = lane & 15, g = lane >> 4;
    const int b = bh >> 2, h = bh & 3;
    const unsigned char* ck0 = CK + (size_t)(bh * 128) * CK_BYTES;
    if (wv >= 4 && wv <= 6) {
        const int li = wv - 4;
#pragma unroll 1
        for (int ch = 0; ch < SEQ / 16; ++ch) {
            while ((int)min(min(flags[4], flags[5]), min(flags[6], flags[7])) + LC_NS <= ch) __builtin_amdgcn_s_sleep(12);
            const unsigned char* ck = ck0 + (size_t)ch * CK_BYTES + li * 8192;
            const unsigned slot = (unsigned)__builtin_amdgcn_readfirstlane((int)(ring + (unsigned)(ch % LC_NS) * LC_SLOT + (unsigned)li * 8192u));
            if (li < 2) {
#pragma unroll
                for (int i = 0; i < 8; ++i) lc_dma16(ck + i * 1024 + lane * 16, slot + i * 1024);
            } else {
#pragma unroll
                for (int i = 0; i < 6; ++i) lc_dma16(ck + i * 1024 + lane * 16, slot + i * 1024);
                lc_dma4(ck + 6144 + lane * 4, slot + 6144);
                lc_dma4(ck + 6144 + lane * 4, slot + 6144);
            }
            asm volatile("s_waitcnt vmcnt(16)" ::: "memory");
            if (ch >= 2) flags[li] = (unsigned)(ch - 1);
        }
        asm volatile("s_waitcnt vmcnt(0)" ::: "memory");
        flags[li] = (unsigned)(SEQ / 16);
    } else if (wv < 4) {
        const int it = wv;
        f32x4c hs[4];
#pragma unroll
        for (int jt = 0; jt < 4; ++jt) hs[jt] = (f32x4c){0.f, 0.f, 0.f, 0.f};
        float* yp = Yout + (size_t)(b * SEQ) * 256 + h * 64 + 16 * it + c;
#pragma unroll 1
        for (int ch = 0; ch < SEQ / 16; ++ch) {
            while ((int)flags[0] <= ch || (int)flags[1] <= ch || (int)flags[2] <= ch) __builtin_amdgcn_s_sleep(1);
            asm volatile("" ::: "memory");
            const unsigned char* sl = ldsb + (ch % LC_NS) * LC_SLOT;
            CkOps o;
#pragma unroll
            for (int ks = 0; ks < 2; ++ks) {
                o.ar[ks] = *(const bf16x8_t*)(sl + CK_R2 + c * 128 + (((4 * ks + g) ^ ((c >> 1) & 7)) << 4));
#pragma unroll
                for (int jt = 0; jt < 4; ++jt) o.am[jt][ks] = *(const bf16x8_t*)(sl + CK_M3 + (16 * jt + c) * 128 + (((4 * ks + g) ^ ((c >> 1) & 7)) << 4));
            }
            o.y = *(const f32x4c*)(sl + CK_Y2 + (it * 64 + lane) * 16);
#pragma unroll
            for (int jt = 0; jt < 4; ++jt) { o.n2[jt] = *(const uint2*)(sl + CK_N2 + ((it * 4 + jt) * 64 + lane) * 8); o.g15[jt] = *(const f32x4c*)(sl + CK_G15 + (16 * jt + 4 * g) * 4); }
            asm volatile("s_waitcnt lgkmcnt(0)" ::: "memory");
            flags[4 + it] = (unsigned)(ch + 1);
            ck_step(o, hs, yp, ch, g);
        }
    }
}

__device__ __forceinline__ float red16(float v) { v += dpp_f<0xB1>(v); v += dpp_f<0x4E>(v); v += dpp_f<0x141>(v); v += dpp_f<0x140>(v); return v; }
#define GAS __attribute__((address_space(1)))
#define WSO(off) ((char*)({ char* _w = args.ws; asm volatile("" : "+s"(_w)); (GAS char*)_w + (off); }))
#define IN(k) ((const float*)(const GAS float*)args.in[({ int _k = (k); asm volatile("" : "+s"(_k)); _k; })])
constexpr int CONV_E8A = 34, CONV_E8B = 47  , CONV_E8 = 49  ;
#define KAS __attribute__((address_space(4)))
__device__ __forceinline__ const float* karg_in(int k) { asm volatile("" : "+s"(k)); return (const float*)(const GAS float*)((const float* const KAS*)__builtin_amdgcn_kernarg_segment_ptr())[k]; }
__device__ __forceinline__ char* karg_ws(size_t off) { char* w = ((char* const KAS*)__builtin_amdgcn_kernarg_segment_ptr())[37]; asm volatile("" : "+s"(w)); return (char*)((GAS char*)w + off); }
static_assert(sizeof(Args) == 38 * 8, "Args layout");
__device__ __forceinline__ ItemDesc expert_item2(int l, int it) {
    const int e = it / 384, r = it % 384, which = r >> 7, q = r & 127;
    ItemDesc d;
    if (which < 2) { d.W = e < 64 ? karg_in(30 + which) + ((size_t)l * NE + e) * D * DE : karg_in(33 + which) + (size_t)l * D * DE;
        const int kb = q >> 3, nb = q & 7, n0 = 32 * nb; d.N = DE; d.WT = (bf16*)karg_ws(WS_WTUP) + (size_t)e * 512 * D; d.K = D; d.k0 = 64 * kb; d.n0 = n0; d.drow0 = (n0 >> 7) * 256 + which * 128 + (n0 & 127); }
    else { d.W = e < 64 ? karg_in(32) + ((size_t)l * NE + e) * DE * D : karg_in(35) + (size_t)l * DE * D; const int kb = q >> 5, nb = q & 31; d.N = D; d.WT = (bf16*)karg_ws(WS_WTDN) + (size_t)e * D * DE; d.K = DE; d.k0 = 64 * kb; d.n0 = 32 * nb; d.drow0 = 32 * nb; }
    return d;
}
template <bool UP>
__device__ __forceinline__ void convert_span(int l, int j0, int j1, int ci, int cnt, float* lds) {
    const int wv_ = owave(), ln_ = olane(), st_ = cnt * 8;
    float* scr = lds + wv_ * (64 * 32);
    float ca[32], cb[32];
#define CS_ITEM(j) (UP ? ((j) >> 8) * 384 + ((j) & 255) : ((j) >> 7) * 384 + 256 + ((j) & 127))
    const int it0 = j0 + ci * 8 + wv_;
    { const int jc = it0 < j1 ? it0 : j1 - 1; item_load(expert_item2(l, CS_ITEM(jc)), ca, ln_); }
#pragma unroll 1
    for (int it = it0; it < j1; it += 2 * st_) {
        const int i1 = it + st_, i2 = it + 2 * st_;
        { const int jc = i1 < j1 ? i1 : j1 - 1; item_load(expert_item2(l, CS_ITEM(jc)), cb, ln_); }
        item_finish(expert_item2(l, CS_ITEM(it)), ca, scr, ln_);
        { const int jc = i2 < j1 ? i2 : j1 - 1; item_load(expert_item2(l, CS_ITEM(jc)), ca, ln_); }
        if (i1 < j1) item_finish(expert_item2(l, CS_ITEM(i1)), cb, scr, ln_);
    }
#undef CS_ITEM
}
constexpr int PRO_A = 2 * 1536, PRO_B = PRO_A + 2 * 512, PRO_C = PRO_B + 2 * 32, PRO_ITEMS = PRO_C + 2 * 32;
__device__ __forceinline__ ItemDesc prologue_item(int it) {
    ItemDesc d; int kb, nb;
    if (it < PRO_A) { const int l = it / 1536, r = it % 1536; kb = r / 96; nb = r % 96; d.W = karg_in(8) + (size_t)l * D * IN_COLS; d.N = IN_COLS; d.WT = (bf16*)karg_ws(WS_WTIN) + (size_t)l * IN_COLS * D; d.K = D; }
    else if (it < PRO_B) { const int j = it - PRO_A, l = j / 512, r = j % 512; kb = r / 32; nb = r % 32; d.W = karg_in(9) + (size_t)l * D * D; d.N = D; d.WT = (bf16*)karg_ws(WS_WTOUT) + (size_t)l * D * D; d.K = D; }
    else if (it < PRO_C) { const int j = it - PRO_B, l = j / 32, r = j % 32; kb = r / 2; nb = r % 2; d.W = karg_in(28) + (size_t)l * D * NE; d.N = NE; d.WT = (bf16*)karg_ws(WS_WTR) + (size_t)l * 256 * D; d.K = D; }
    else { const int j = it - PRO_C, l = j / 32, r = j % 32; bf16* sm = (bf16*)karg_ws(WS_SMALL) + (size_t)l * 131072; d.N = 256;
        if (r < 8) { kb = 0; nb = r; d.W = karg_in(15) + (size_t)l * 64 * 256; d.WT = sm; d.K = 64; }
        else if (r < 16) { kb = 0; nb = r - 8; d.W = karg_in(17) + (size_t)l * 64 * 256; d.WT = sm + 16384; d.K = 64; }
        else { kb = (r - 16) / 8; nb = (r - 16) % 8; d.W = karg_in(18) + (size_t)l * 128 * 256; d.WT = sm + 32768; d.K = 128; } }
    d.k0 = 64 * kb; d.n0 = 32 * nb; d.drow0 = 32 * nb;
    return d;
}
__device__ __forceinline__ void prologue_span(float* lds, int j0, int j1, int ci, int cnt) {
    const int wv_ = owave(), ln_ = olane(), st_ = cnt * 8;
    float* scr = lds + wv_ * (64 * 32);
    float ca[32], cb[32];
    const int it0 = j0 + ci * 8 + wv_;
    item_load(prologue_item(it0 < j1 ? it0 : j1 - 1), ca, ln_);
#pragma unroll 1
    for (int it = it0; it < j1; it += 2 * st_) {
        const int i1 = it + st_, i2 = it + 2 * st_;
        item_load(prologue_item(i1 < j1 ? i1 : j1 - 1), cb, ln_);
        item_finish(prologue_item(it), ca, scr, ln_);
        item_load(prologue_item(i2 < j1 ? i2 : j1 - 1), ca, ln_);
        if (i1 < j1) item_finish(prologue_item(i1), cb, scr, ln_);
    }
}
constexpr int PRO_EARLY = 1408;
__device__ __forceinline__ void prologue_transposes(float* lds) {
    const int b_ = obid(), G_ = ogdim();
    if (G_ == 256) { if (b_ >= 192) prologue_span(lds, 0, PRO_EARLY, b_ - 192, 64); prologue_span(lds, PRO_EARLY, PRO_ITEMS, b_, G_); }
    else prologue_span(lds, 0, PRO_ITEMS, b_, G_);
}
typedef float f32x2_t __attribute__((ext_vector_type(2)));
__device__ __forceinline__ void rwkv_post_phase(const float* RW, const float* bon, const float* lnx_g, const float* lnx_b, bf16* mix) {
    const int tidx = otid(), bidx = obid(), gdim = ogdim();
    const int lane = tidx & 63, wave = tidx >> 6, stride = gdim * 8;
    constexpr size_t AS = (size_t)T * 256;
    const float4 lg4 = ((const float4*)lnx_g)[lane], lb4 = ((const float4*)lnx_b)[lane];
#pragma unroll 2
    for (int t0 = bidx * 8 + wave; t0 < T; t0 += 4 * stride) {
        float4 yv[4], vv[4], gv[4]; float bv[4];
#pragma unroll
        for (int i = 0; i < 4; ++i) {
            const int t = t0 + i * stride < T ? t0 + i * stride : t0;
            const float4* p = (const float4*)(RW + (size_t)t * 256) + lane;
            yv[i] = p[7 * AS / 4]; bv[i] = bon[(size_t)t * 4 + (lane >> 4)];
            { const uint2 vw = ((const uint2*)((const bf16*)(RW + 3 * AS) + (size_t)t * 256))[lane], gw = ((const uint2*)((const bf16*)(RW + 6 * AS) + (size_t)t * 256))[lane];
              vv[i] = make_float4(__uint_as_float(vw.x << 16), __uint_as_float(vw.x & 0xffff0000u), __uint_as_float(vw.y << 16), __uint_as_float(vw.y & 0xffff0000u));
              gv[i] = make_float4(__uint_as_float(gw.x << 16), __uint_as_float(gw.x & 0xffff0000u), __uint_as_float(gw.y << 16), __uint_as_float(gw.y & 0xffff0000u)); }
        }
#pragma unroll
        for (int i = 0; i < 4; ++i) {
            const int t = t0 + i * stride;
            const float mean = red16((yv[i].x + yv[i].y) + (yv[i].z + yv[i].w)) * (1.f / 64.f);
            const float4 d = make_float4(yv[i].x - mean, yv[i].y - mean, yv[i].z - mean, yv[i].w - mean);
            const float rstd = rsqrtf(red16(sq4(d)) * (1.f / 64.f) + 64e-5f);
            const float bonus = bv[i];
            const float o0 = (d.x * rstd * lg4.x + lb4.x + bonus * vv[i].x) * gv[i].x, o1 = (d.y * rstd * lg4.y + lb4.y + bonus * vv[i].y) * gv[i].y;
            const float o2 = (d.z * rstd * lg4.z + lb4.z + bonus * vv[i].z) * gv[i].z, o3 = (d.w * rstd * lg4.w + lb4.w + bonus * vv[i].w) * gv[i].w;
            if (t < T) ((uint2*)(mix + (size_t)t * D + A_WIDTH))[lane] = make_uint2(pk2(o0, o1), pk2(o2, o3));
        }
    }
}
__device__ __forceinline__ int med3i(int a, int b, int c) { int r; asm("v_med3_i32 %0, %1, %2, %3" : "=v"(r) : "v"(a), "v"(b), "v"(c)); return r; }
constexpr int RT_LD = 68;
__device__ __forceinline__ void route_topk_tok(const float* lrow, const float* lbias, int (&bi)[8], float* top_w, unsigned* hist, int t) {
    float gs[8];
#pragma unroll
    for (int i = 0; i < 8; ++i) gs[i] = 0.f;
#pragma unroll 1
    for (int g = 0; g < 8; ++g) {
        const float4 a = *(const float4*)(lrow + 8 * g), b = *(const float4*)(lrow + 8 * g + 4), ea = *(const float4*)(lbias + 8 * g), eb = *(const float4*)(lbias + 8 * g + 4);
        const float vv[8] = {a.x, a.y, a.z, a.w, b.x, b.y, b.z, b.w}, ee[8] = {ea.x, ea.y, ea.z, ea.w, eb.x, eb.y, eb.z, eb.w};
        float m1 = -INFINITY, m2 = -INFINITY;
#pragma unroll
        for (int j = 0; j < 8; ++j) { const float v = __builtin_amdgcn_rcpf(1.f + __expf(-vv[j])) + ee[j]; m2 = fmaxf(m2, fminf(m1, v)); m1 = fmaxf(m1, v); }
#pragma unroll
        for (int i = 7; i > 0; --i) gs[i] = gs[i - 1];
        gs[0] = m1 + m2;
    }
    unsigned keepmask = 0u;
#pragma unroll
    for (int g = 0; g < 8; ++g) { int rk = 0;
#pragma unroll
        for (int g2 = 0; g2 < 8; ++g2) if (g2 != g) rk += (gs[7 - g2] > gs[7 - g] || (gs[7 - g2] == gs[7 - g] && g2 < g)) ? 1 : 0;
        keepmask |= rk < 4 ? (1u << g) : 0u; }
    int L[8];
#pragma unroll
    for (int i = 0; i < 8; ++i) L[i] = (int)0x80000000;
#pragma unroll 1
    for (int g = 0; g < 8; ++g) {
        const float4 a = *(const float4*)(lrow + 8 * g), b = *(const float4*)(lrow + 8 * g + 4), ea = *(const float4*)(lbias + 8 * g), eb = *(const float4*)(lbias + 8 * g + 4);
        const float vv[8] = {a.x, a.y, a.z, a.w, b.x, b.y, b.z, b.w}, ee[8] = {ea.x, ea.y, ea.z, ea.w, eb.x, eb.y, eb.z, eb.w};
        const bool keep = (keepmask >> g) & 1u;
#pragma unroll
        for (int j = 0; j < 8; ++j) { const float v = __builtin_amdgcn_rcpf(1.f + __expf(-vv[j])) + ee[j]; const int bb = __float_as_int(v);
            int k = bb ^ ((bb >> 31) & 0x7fffffff); k = (k & ~63) | (63 - 8 * g - j); k = keep ? k : (int)0x80000000;
            int n[8]; n[0] = max(L[0], k);
#pragma unroll
            for (int i = 1; i < 8; ++i) n[i] = med3i(L[i - 1], L[i], k);
#pragma unroll
            for (int i = 0; i < 8; ++i) L[i] = n[i]; }
    }
    float sw[8]; float ssum = 0.f;
#pragma unroll
    for (int r = 0; r < 8; ++r) { bi[r] = 63 - (L[r] & 63); sw[r] = sigmoidf_(lrow[bi[r]]); ssum += sw[r]; }
    const float inv = 2.5f / (ssum + 1e-20f);
    *(float4*)(top_w + t * TOPK) = make_float4(sw[0] * inv, sw[1] * inv, sw[2] * inv, sw[3] * inv); *(float4*)(top_w + t * TOPK + 4) = make_float4(sw[4] * inv, sw[5] * inv, sw[6] * inv, sw[7] * inv);
#pragma unroll
    for (int r = 0; r < 8; ++r) atomicAdd(&hist[bi[r]], 1u);
}

typedef float f32x2c __attribute__((ext_vector_type(2)));
__device__ __forceinline__ void acc16(float (&y)[16], const uint4& v, float w) {
    const unsigned u[4] = {v.x, v.y, v.z, v.w};
#pragma unroll
    for (int i = 0; i < 4; ++i) {
        const f32x2c lo = __builtin_amdgcn_cvt_pk_f32_fp8((int)u[i], false), hi = __builtin_amdgcn_cvt_pk_f32_fp8((int)u[i], true);
        y[4 * i] += w * lo.x; y[4 * i + 1] += w * lo.y; y[4 * i + 2] += w * hi.x; y[4 * i + 3] += w * hi.y;
    }
}
template <bool NEXT>
__device__ __forceinline__ void combine_phase(const unsigned char* YB, const unsigned char* YS, const int* posi, const float* topw, const float* gy, const float* gate_base, float* x,
                                              const float* gn, const float* modn, bf16* hb) {
    const int tidx = otid(), bidx = obid(), gdim = ogdim();
    const int lane = tidx & 63, wave = tidx >> 6, stride = gdim * 8;
    int4 np0[2], np1[2]; float4 nw0[2], nw1[2];
    { const int rowa = bidx * 8 + wave;
#pragma unroll
      for (int r = 0; r < 2; ++r) { const int row = min(rowa + r * stride, T - 1);
          np0[r] = *(const int4*)(posi + row * TOPK); np1[r] = *(const int4*)(posi + row * TOPK + 4); nw0[r] = *(const float4*)(topw + row * TOPK); nw1[r] = *(const float4*)(topw + row * TOPK + 4); } }
#pragma unroll 1
    for (int row0 = bidx * 8 + wave; row0 < T; row0 += 2 * stride) {
        uint4 ys[2], yb[2][8]; float4 xv[4]; float ww[2][8];
#pragma unroll
        for (int r = 0; r < 2; ++r) {
            const int row = min(row0 + r * stride, T - 1);
            const int pp[8] = {np0[r].x, np0[r].y, np0[r].z, np0[r].w, np1[r].x, np1[r].y, np1[r].z, np1[r].w};
            ww[r][0] = nw0[r].x; ww[r][1] = nw0[r].y; ww[r][2] = nw0[r].z; ww[r][3] = nw0[r].w; ww[r][4] = nw1[r].x; ww[r][5] = nw1[r].y; ww[r][6] = nw1[r].z; ww[r][7] = nw1[r].w;
            ys[r] = nt_load16((const uint4*)(YS + (size_t)row * D) + lane);
#pragma unroll
            for (int k = 0; k < TOPK; ++k) yb[r][k] = nt_load16((const uint4*)(YB + (size_t)pp[k] * D) + lane);
            if (r == 0) {
#pragma unroll
                for (int q = 0; q < 4; ++q) xv[q] = ((const float4*)(x + (size_t)row * D))[4 * lane + q];
            }
        }
        { const int rown = row0 + 2 * stride;
#pragma unroll
          for (int r = 0; r < 2; ++r) { const int row = min(rown + r * stride, T - 1);
              np0[r] = *(const int4*)(posi + row * TOPK); np1[r] = *(const int4*)(posi + row * TOPK + 4); nw0[r] = *(const float4*)(topw + row * TOPK); nw1[r] = *(const float4*)(topw + row * TOPK + 4); } }
#pragma unroll
        for (int r = 0; r < 2; ++r) {
            const int row = row0 + r * stride;
            if (row < T) {
                const int b = row / SEQ;
                float y[16];
#pragma unroll
                for (int i = 0; i < 16; ++i) y[i] = 0.f;
                acc16(y, ys[r], 1.f / 16.f);
#pragma unroll
                for (int k = 0; k < TOPK; ++k) acc16(y, yb[r][k], ww[r][k] * (1.f / 16.f));
                float ss = 0.f;
#pragma unroll
                for (int i = 0; i < 16; ++i) ss += y[i] * y[i];
                const float rs = rsqrtf(wave_sum_fast(ss) * (1.f / D) + 1e-6f);
                float xn[16]; float s2 = 0.f;
#pragma unroll
                for (int q = 0; q < 4; ++q) {
                    const int c4 = 4 * lane + q;
                    const float4 gg = ((const float4*)gy)[c4], gt = ((const float4*)(gate_base + (size_t)b * 6 * D))[c4];
                    float4 v = r == 0 ? xv[q] : ((const float4*)(x + (size_t)row * D))[c4];
                    v.x += gt.x * y[4 * q] * rs * gg.x; v.y += gt.y * y[4 * q + 1] * rs * gg.y; v.z += gt.z * y[4 * q + 2] * rs * gg.z; v.w += gt.w * y[4 * q + 3] * rs * gg.w;
                    ((float4*)(x + (size_t)row * D))[c4] = v;
                    xn[4 * q] = v.x; xn[4 * q + 1] = v.y; xn[4 * q + 2] = v.z; xn[4 * q + 3] = v.w;
                    s2 += sq4(v);
                }
                if (NEXT) {
                    const float r2 = rsqrtf(wave_sum_fast(s2) * (1.f / D) + 1e-6f);
                    const float* m = modn + (size_t)b * 6 * D;
                    float o[16];
#pragma unroll
                    for (int q = 0; q < 4; ++q) {
                        const int c4 = 4 * lane + q;
                        const float4 gg = ((const float4*)gn)[c4], sc = ((const float4*)(m + D))[c4], sh = ((const float4*)m)[c4];
                        o[4 * q] = xn[4 * q] * r2 * gg.x * (1.f + sc.x) + sh.x; o[4 * q + 1] = xn[4 * q + 1] * r2 * gg.y * (1.f + sc.y) + sh.y;
                        o[4 * q + 2] = xn[4 * q + 2] * r2 * gg.z * (1.f + sc.z) + sh.z; o[4 * q + 3] = xn[4 * q + 3] * r2 * gg.w * (1.f + sc.w) + sh.w;
                    }
                    ((uint4*)(hb + (size_t)row * D))[2 * lane] = make_uint4(pk2(o[0], o[1]), pk2(o[2], o[3]), pk2(o[4], o[5]), pk2(o[6], o[7]));
                    ((uint4*)(hb + (size_t)row * D))[2 * lane + 1] = make_uint4(pk2(o[8], o[9]), pk2(o[10], o[11]), pk2(o[12], o[13]), pk2(o[14], o[15]));
                }
            }
        }
    }
}
__device__ __forceinline__ void build_ps(int* ps, const unsigned* counts) {
    const int tidx = otid();
    __syncthreads();
    if (tidx < NE) ps[NE + 1 + tidx] = ((int)__hip_atomic_load(&counts[tidx], __ATOMIC_RELAXED, __HIP_MEMORY_SCOPE_AGENT) + EBLK - 1) / EBLK * EBLK;
    __syncthreads();
    if (tidx <= NE) { int acc = 0;
#pragma unroll 8
        for (int e = 0; e < NE; ++e) { const int v = ps[NE + 1 + e]; acc += e < tidx ? v : 0; }
        ps[tidx] = acc; }
    __syncthreads();
}

__global__ void __launch_bounds__(NT) mk_fwd(Args args) {
    float* lds = (float*)lds_raw;
    if ((threadIdx.x & 63) == 0) *(volatile LAS int*)((LAS unsigned char*)lds_raw + WIDTAB_OFF + 4 * ((unsigned)__builtin_amdgcn_s_getreg(63492) & 63u)) = (int)(threadIdx.x >> 6);
    volatile LAS unsigned* misc = (volatile LAS unsigned*)((LAS unsigned char*)lds_raw + LDS_BYTES - 256);
    int* ps = (int*)(lds_raw + LDS_BYTES - 2048);
    if (threadIdx.x < 64) misc[threadIdx.x] = 0u;
    __syncthreads();
#define XBAR() xcd_barrier(bar)
    if (threadIdx.x < 512) { const int h_ = threadIdx.x >> 7, d_ = threadIdx.x & 127; const float* tb_ = args.in[10];
        ((float*)(lds_raw + BT_OFF))[threadIdx.x] = (tb_[t5_bucket(d_) * A_HEADS + h_] - tb_[31 * A_HEADS + h_]) * 1.4426950408889634f; }
    __syncthreads();
    unsigned* ctl = (unsigned*)(args.ws + WS_CTL);
    XcdBarrier bar = xcd_barrier_post(ctl + CW_BAR, misc);
#define CNT ((unsigned*)WSO(WS_CTL) + CW_CNT)
#define CUR ((unsigned*)WSO(WS_CTL) + CW_CUR)
#define MOD ((float*)WSO(WS_MOD))
#define TOPW ((float*)WSO(WS_TOPW))
#define ROWE ((int*)WSO(WS_ROWE))
#define DST ((int*)WSO(WS_DST))
#define RW ((float*)WSO(WS_RW))
#define Y ((float*)WSO(WS_PROJ))
#define CHK ((unsigned char*)WSO(WS_CHK))
#define HBF ((bf16*)WSO(WS_HBF))
#define WTIN ((bf16*)WSO(WS_WTIN))
#define WTR ((bf16*)WSO(WS_WTR))
#define SMALLW(l_) ((bf16*)WSO(WS_SMALL) + (size_t)(l_) * 131072)
#define LOGIT ((float*)WSO(WS_LOGIT))
#define PROJB ((bf16*)WSO(WS_PROJ))
#define WTOUT ((bf16*)WSO(WS_WTOUT))
#define MIXB ((bf16*)WSO(WS_MIXB))
#define WTUP ((bf16*)WSO(WS_WTUP))
#define WTDN ((bf16*)WSO(WS_WTDN))
#define HBB ((bf16*)WSO(WS_HBB))
#define YB ((bf16*)WSO(WS_YB))
#define YS8 ((unsigned char*)WSO(WS_YS))
#define out ((float*)(GAS float*)args.out)
#define gsz (ogdim() * NT)
#define GTID (obid() * NT + otid())

    {
        float* sl = lds; float* red = lds + 8192;
        const int t_ = otid();
        { const float* cp = IN(1);
#pragma unroll
          for (int j = 0; j < BATCH * D / NT; ++j) { const int i = t_ + j * NT; sl[(i & (D - 1)) * 8 + (i >> 10)] = siluf_(cp[i]); } }
        __syncthreads();
        const int nl = t_ & 63, kp = t_ >> 6;
#pragma unroll 1
        for (int task = obid(); task < DEPTH * 6 * D / 64; task += ogdim()) {
            const int l = task / (6 * D / 64), n0 = (task % (6 * D / 64)) * 64;
            const float* w = IN(2) + (size_t)l * D * 6 * D + (size_t)(kp * 128) * 6 * D + n0 + nl;
            float acc[8];
#pragma unroll
            for (int b = 0; b < 8; ++b) acc[b] = 0.f;
#pragma unroll 64
            for (int i = 0; i < 128; ++i) { const float wv = w[(size_t)i * 6 * D]; const float4 s0 = *(const float4*)(sl + (kp * 128 + i) * 8), s1 = *(const float4*)(sl + (kp * 128 + i) * 8 + 4);
                acc[0] += s0.x * wv; acc[1] += s0.y * wv; acc[2] += s0.z * wv; acc[3] += s0.w * wv; acc[4] += s1.x * wv; acc[5] += s1.y * wv; acc[6] += s1.z * wv; acc[7] += s1.w * wv; }
#pragma unroll
            for (int b = 0; b < 8; ++b) red[(kp * 64 + nl) * 8 + b] = acc[b];
            __syncthreads();
            { const int n2 = t_ & 63, b2 = t_ >> 6; float sum = IN(3)[l * 6 * D + n0 + n2];
#pragma unroll
              for (int k2 = 0; k2 < 8; ++k2) sum += red[(k2 * 64 + n2) * 8 + b2];
              MOD[((size_t)l * BATCH + b2) * 6 * D + n0 + n2] = sum; }
            __syncthreads();
        }
    }
    prologue_transposes(lds);
    {
    for (int l = 0; l < DEPTH; ++l) {
#pragma unroll 1
        for (int i = GTID; i < 4 * CHUNK * CHUNK; i += gsz) { const int s_ = i & 127, t_ = (i >> 7) & 127; (SMALLW(l) + 65536)[i] = (bf16)(s_ <= t_ ? f2bf((IN(26) + (size_t)l * 4 * CHUNK * CHUNK)[i]) : 0u); }
#pragma unroll 1
        for (int i = GTID; i < 192 * D / 8; i += gsz) ((uint4*)(WTR + (size_t)l * 256 * D + 64 * D))[i] = make_uint4(0u, 0u, 0u, 0u);
    }
    }
    XBAR();

#define xin (l == 0 ? IN(0) : (const float*)out)
#pragma unroll 1
    for (int l_ = 0; l_ < DEPTH; ++l_) {
        int l = l_; asm volatile("" : "+s"(l));
#define mod_l (MOD + (size_t)l * BATCH * 6 * D)
        const float lambda_init = l == 0 ? 0.2f : 0.8f - 0.6f * 0.7408182206817179f;
        if (l == 0) { row_phase<false, true>(xin, nullptr, nullptr, nullptr, nullptr, IN(4) + l * D, mod_l, 0, 1, HBF);
        XBAR(); }
        {
            pg8::Gemm g{HBF, WTIN + (size_t)l * IN_COLS * D, T, IN_COLS, D}; pg8::StaticOrder S; S.init(T, IN_COLS, ogdim(), obid());
            pg8::EpiBf16<0> E{PROJB, IN_COLS, nullptr, 0, 0, 1.f};
            pg8::gemm_phase<pg8::EpiBf16<0>, pg8::StaticOrder, true>((LAS unsigned char*)lds_raw, g, S, E);
        }
        XBAR();
        rwkv_prep_phase(lds_raw, PROJB, IN(13) + l * B_COLS, IN(14) + l * 256, SMALLW(l), IN(16) + l * 256, SMALLW(l) + 16384, SMALLW(l) + 32768, IN(19) + l * 256, IN(20) + l * 256, RW);
        __builtin_amdgcn_fence(__ATOMIC_RELEASE, "workgroup"); __syncthreads();
        chunk_prep(lds_raw, RW, CHK, IN(21) + l * 256, (float*)WSO(WS_BON));
        XBAR();
        {
            const int G_ = ogdim(), b_ = obid();
            if (b_ < 32) {
                const int wv_ = owave();
                if (otid() < 8) ((volatile LAS unsigned*)((LAS unsigned char*)lds_raw + LC_FLAGS))[otid()] = 0u;
                __syncthreads();
                if (wv_ < 7) chunk_scan_lc(lds_raw, CHK, RW + (size_t)T * 256 * 7, b_, wv_);
                asm volatile("s_waitcnt vmcnt(0)" ::: "memory");
                __syncthreads();
                if (otid() == 0) { __builtin_amdgcn_fence(__ATOMIC_RELEASE, "agent"); asm volatile("s_waitcnt vmcnt(0)" ::: "memory"); (void)xb_add((unsigned*)WSO(WS_CTL) + CW_SCAN + 32 * l, 1u); }
            }
            __syncthreads();
            attn_flash(lds_raw, PROJB, IN(11) + l * 256, IN(12) + l * 128, lambda_init, MIXB, b_, G_);
            __syncthreads();
            gmlp_phase(lds_raw, PROJB, IN(24) + l * 256, IN(25) + l * 256, SMALLW(l) + 65536, IN(27) + l * 4 * CHUNK, MIXB, b_ >= G_ / 2 ? b_ - G_ / 2 : b_ + G_ / 2, G_);
            __syncthreads();
            if (b_ >= 32 && b_ < G_ / 2) {
                convert_span<true>(l, CONV_E8 * 256, 65 * 256, b_ - 32, G_ / 2 - 32, lds);
            }
        }
        __syncthreads();
        if (otid() == 0) { unsigned* sc_ = (unsigned*)WSO(WS_CTL) + CW_SCAN + 32 * l; unsigned sp_ = 0u;
            while (xb_ld(sc_) < 32u && ++sp_ < XB_SPIN_CAP) __builtin_amdgcn_s_sleep(2);
            __builtin_amdgcn_fence(__ATOMIC_ACQUIRE, "agent"); asm volatile("s_waitcnt vmcnt(0)" ::: "memory"); }
        __syncthreads();
        rwkv_post_phase(RW, (const float*)WSO(WS_BON), IN(22) + l * 256, IN(23) + l * 256, MIXB);
        XBAR();
        {
            pg8::Gemm g{MIXB, WTOUT + (size_t)l * D * D, T, D, D}; pg8::StaticOrder S; S.init(T, D, ogdim(), obid());
            pg8::EpiBf16<0> E{(bf16*)Y, D, nullptr, 0, 0, 1.f};
            pg8::gemm_phase<pg8::EpiBf16<0>, pg8::StaticOrder, false>((LAS unsigned char*)lds_raw, g, S, E);
        }
        XBAR();
        row_phase<true, true>(xin, (const bf16*)Y, IN(5) + l * D, mod_l + 2 * D, out, IN(6) + l * D, mod_l, 3, 4, HBF);
        { const int t_ = otid(); if (obid() == 0 && t_ < NE) { CNT[t_] = 0u; CUR[t_] = 0u; } }
        XBAR();
        {
            pg8::Gemm g{HBF, WTR + (size_t)l * 256 * D, T, 256, D}; pg8::StaticOrder S; S.init(T, 256, ogdim(), obid());
            pg8::EpiLds E{RT_LD};
            pg8::gemm_phase<pg8::EpiLds, pg8::StaticOrder, false>((LAS unsigned char*)lds_raw, g, S, E);
            pg8::Unit u_;
            if (S.next(0, u_)) {
                float* ls = (float*)lds_raw; unsigned* hist = (unsigned*)(ls + 256 * RT_LD + 64); const int t_ = otid();
                if (t_ < NE) { hist[t_] = 0u; ls[256 * RT_LD + t_] = (IN(29) + l * NE)[t_]; }
                __syncthreads();
                int bi[8];
#pragma unroll
                for (int r = 0; r < 8; ++r) bi[r] = 0;
                if (t_ < 256) route_topk_tok(ls + t_ * RT_LD, ls + 256 * RT_LD, bi, TOPW, hist, u_.pm * 256 + t_);
                __syncthreads();
                unsigned* lb = hist + 64;
                if (t_ < NE) { const unsigned h_ = hist[t_]; lb[t_] = h_ ? atomicAdd(&CUR[t_], h_) : 0u; hist[t_] = 0u; }
                __syncthreads();
                if (t_ < 256) { const int tok = u_.pm * 256 + t_; int dd[8];
#pragma unroll
                    for (int r = 0; r < 8; ++r) { const int e = bi[r]; const int pos = (int)(lb[e] + atomicAdd(&hist[e], 1u)); ROWE[e * T + pos] = tok; dd[r] = (e << 16) | pos; }
                    *(int4*)(DST + tok * TOPK) = make_int4(dd[0], dd[1], dd[2], dd[3]); *(int4*)(DST + tok * TOPK + 4) = make_int4(dd[4], dd[5], dd[6], dd[7]); }
                __syncthreads();
                convert_span<true>(l, CONV_E8B * 256, CONV_E8 * 256, obid(), 64, lds);
            }
        }
        {
            const int G_ = ogdim(); int c_ = obid() - 64; if (c_ < 0) c_ += G_;
            pg8::Gemm g{HBF, WTUP + (size_t)64 * 512 * D, T, 512, D}; pg8::StaticOrder S; S.init(T, 512, G_, c_);
            pg8::EpiSwiGLU E{HBB + (size_t)P * 256};
            pg8::gemm_phase<pg8::EpiSwiGLU, pg8::StaticOrder, false>((LAS unsigned char*)lds_raw, g, S, E);
            if (c_ < 192) {
                __syncthreads();
                if (c_ >= 128) convert_span<true>(l, 0, CONV_E8A * 256, c_ - 128, 64, lds);
                else convert_span<true>(l, CONV_E8A * 256, CONV_E8B * 256, c_, 128, lds);
            }
        }
        XBAR();
        {
            build_ps(ps, CUR);
#pragma unroll 1
            for (int i = GTID; i < T * TOPK; i += gsz) { const int v = DST[i]; DST[i] = ps[v >> 16] + (v & 0xffff); }
            pg8::Gemm g{HBF, WTUP, 0, 512, D}; pg8::GroupedOrder<true> S; S.init(ps, 2, ogdim(), obid(), ROWE, (size_t)512 * D * 2, NBLK, 0);
            pg8::EpiSwiGLU E{HBB};
            pg8::gemm_phase<pg8::EpiSwiGLU, pg8::GroupedOrder<true>, true>((LAS unsigned char*)lds_raw, g, S, E);
            {
                const int G_ = ogdim(), c_ = obid(), rem_ = S.nwg % G_, nidle_ = rem_ ? G_ - rem_ : 0;
                __syncthreads();
                if (nidle_ >= 64) { if (c_ >= rem_) convert_span<false>(l, 0, 65 * 128, c_ - rem_, nidle_, lds); }
                else convert_span<false>(l, 0, 65 * 128, c_, G_, lds);
            }
        }
        XBAR();
        {
            pg8::Gemm g{HBB, WTDN, 0, D, DE}; pg8::GroupedOrder<false> S; S.init(ps, 4, ogdim(), obid(), nullptr, (size_t)D * DE * 2, NBLK, T / 256);
            pg8::EpiRows E{(unsigned char*)YB, YS8, NBLK};
            pg8::gemm_phase<pg8::EpiRows, pg8::GroupedOrder<false>, true>((LAS unsigned char*)lds_raw, g, S, E);
        }
        XBAR();
        if (l + 1 < DEPTH) combine_phase<true>((const unsigned char*)YB, YS8, DST, TOPW, IN(7) + l * D, mod_l + 5 * D, out, IN(4) + (l + 1) * D, MOD + (size_t)(l + 1) * BATCH * 6 * D, HBF);
        else combine_phase<false>((const unsigned char*)YB, YS8, DST, TOPW, IN(7) + l * D, mod_l + 5 * D, out, nullptr, nullptr, nullptr);
        if (l + 1 < DEPTH) XBAR();
    }
}
#undef out
}

extern "C" void kernel_launch(void* const* d_in, const int* in_sizes, int n_in, void* d_out, int out_size, void* d_ws, size_t ws_size, hipStream_t stream) {
    static int grid = 0;
    if (grid == 0) {
        if (n_in != 36 || ws_size < WS_END) { fprintf(stderr, "kernel_launch: need 36 inputs and %zu bytes of workspace; got %d, %zu\n", (size_t)WS_END, n_in, ws_size); grid = -1; return; }
        int dev = 0, cus = 0, per_cu = 0;
        if (hipGetDevice(&dev) != hipSuccess || hipDeviceGetAttribute(&cus, hipDeviceAttributeMultiprocessorCount, dev) != hipSuccess) { grid = -1; return; }
        if (hipFuncSetAttribute((const void*)mk_fwd, hipFuncAttributeMaxDynamicSharedMemorySize, LDS_BYTES) != hipSuccess) { fprintf(stderr, "kernel_launch: hipFuncSetAttribute failed\n"); grid = -1; return; }
        if (hipOccupancyMaxActiveBlocksPerMultiprocessor(&per_cu, (const void*)mk_fwd, NT, LDS_BYTES) != hipSuccess || per_cu < 1) { fprintf(stderr, "kernel_launch: occupancy query says %d\n", per_cu); per_cu = 1; }
        (void)hipGetLastError();
        grid = cus;
        fprintf(stderr, "kernel_launch: grid %d (occupancy query %d per CU)\n", grid, per_cu);
    }
    if (grid < 0) return;
    (void)hipMemsetAsync((char*)d_ws + WS_CTL, 0, CTL_BYTES, stream);
    Args a{};
    for (int i = 0; i < 36; ++i) a.in[i] = (const float*)d_in[i];
    a.out = (float*)d_out; a.ws = (char*)d_ws;
    hipLaunchKernelGGL(mk_fwd, dim3(grid), dim3(NT), LDS_BYTES, stream, a);
}
```
